# Optimizing an MI355X kernel written in HIP

```python
import jax, jax.numpy as jnp
from jax import lax
import numpy as np

D_MODEL = 1024
BATCH = 4
SEQ = 4096
DEPTH = 1

MLA_HEADS = 8
MLA_Q_RANK = 256
MLA_KV_RANK = 128
MLA_NOPE_DIM = 64
MLA_ROPE_DIM = 32
MLA_QK_DIM = MLA_NOPE_DIM + MLA_ROPE_DIM
MLA_V_DIM = 64
MLA_WIDTH = MLA_HEADS * MLA_V_DIM
DSA_HEADS = 8
DSA_KV_HEADS = 2
DSA_HEAD_DIM = 64
DSA_WIDTH = DSA_HEADS * DSA_HEAD_DIM
DSA_ROT_DIM = DSA_HEAD_DIM // 4
IDX_HEADS = 8
IDX_DIM = 32
IDX_ROT_DIM = IDX_DIM // 4
INDEX_TOPK_MAX = 256
ROPE_THETA = 500000.0
Q_BLOCK = 128
NORM_EPS = 1e-6

IN_SPLITS = (
    MLA_Q_RANK, MLA_KV_RANK, MLA_ROPE_DIM, MLA_WIDTH,
    DSA_HEADS * DSA_HEAD_DIM, DSA_KV_HEADS * DSA_HEAD_DIM,
    DSA_KV_HEADS * DSA_HEAD_DIM, DSA_WIDTH,
    IDX_HEADS * IDX_DIM, IDX_DIM, IDX_HEADS,
    D_MODEL, D_MODEL,
)
D_IN = sum(IN_SPLITS)

kernel_name = 'hybrid_mla_dsa_gated_block'


def rms_norm(x, gain):
    xf = x.astype(jnp.float32)
    y = xf * lax.rsqrt(jnp.mean(xf * xf, axis=-1, keepdims=True) + NORM_EPS)
    return (y * gain.astype(jnp.float32)).astype(x.dtype)


def rope_angles(positions, rot_dim):
    inv_freq = ROPE_THETA ** (-jnp.arange(0, rot_dim, 2, dtype=jnp.float32) / rot_dim)
    ang = positions.astype(jnp.float32)[..., None] * inv_freq
    return jnp.cos(ang), jnp.sin(ang)


def apply_rope(x, cos, sin):
    xf = x.astype(jnp.float32)
    half = xf.shape[-1] // 2
    x1, x2 = xf[..., :half], xf[..., half:]
    c, s = cos[:, :, None, :], sin[:, :, None, :]
    return jnp.concatenate([x1 * c - x2 * s, x2 * c + x1 * s], axis=-1).astype(x.dtype)


def partial_rope(x, cos, sin, rot_dim):
    return jnp.concatenate([apply_rope(x[..., :rot_dim], cos, sin), x[..., rot_dim:]], axis=-1)


def to_blocks(a):
    b, s = a.shape[0], a.shape[1]
    a = a.reshape((b, s // Q_BLOCK, Q_BLOCK) + a.shape[2:])
    return jnp.moveaxis(a, 1, 0)


def from_blocks(a):
    a = jnp.moveaxis(a, 0, 1)
    return a.reshape((a.shape[0], a.shape[1] * a.shape[2]) + a.shape[3:])


def mla_attention(q, k, v):
    s_len = q.shape[1]
    scale = MLA_QK_DIM ** -0.5
    key_pos = jnp.arange(s_len, dtype=jnp.int32)
    starts = jnp.arange(s_len // Q_BLOCK, dtype=jnp.int32) * Q_BLOCK

    def one_block(args):
        qb, start = args
        qpos = start + jnp.arange(Q_BLOCK, dtype=jnp.int32)
        sc = jnp.einsum('bqhd,bkhd->bhqk', qb, k).astype(jnp.float32) * scale
        causal = key_pos[None, :] <= qpos[:, None]
        sc = jnp.where(causal[None, None], sc, -jnp.inf)
        p = jax.nn.softmax(sc, axis=-1).astype(v.dtype)
        return jnp.einsum('bhqk,bkhd->bqhd', p, v)

    return from_blocks(lax.map(one_block, (to_blocks(q), starts)))


def dsa_attention(q, k, v, q_idx, k_idx, w_idx, k_top):
    bsz, s_len, n_heads, hd = q.shape
    n_kv = k.shape[2]
    grp = n_heads // n_kv
    scale = hd ** -0.5
    key_pos = jnp.arange(s_len, dtype=jnp.int32)
    starts = jnp.arange(s_len // Q_BLOCK, dtype=jnp.int32) * Q_BLOCK
    gather = jax.vmap(lambda kb, ib: kb[ib])

    def one_block(args):
        qb, qib, wb, start = args
        qpos = start + jnp.arange(Q_BLOCK, dtype=jnp.int32)
        rel = jax.nn.relu(jnp.einsum('bqhd,bsd->bqhs', qib, k_idx).astype(jnp.float32))
        score = jnp.einsum('bqhs,bqh->bqs', rel, wb.astype(jnp.float32))
        causal = key_pos[None, None, :] <= qpos[None, :, None]
        score = jnp.where(causal, score, -jnp.inf)
        _, sel = lax.top_k(score, k_top)
        valid = sel <= qpos[None, :, None]
        kg = gather(k, sel)
        vg = gather(v, sel)
        qg = qb.reshape(bsz, Q_BLOCK, n_kv, grp, hd)
        sc = jnp.einsum('bqkgd,bqjkd->bqkgj', qg, kg).astype(jnp.float32) * scale
        sc = jnp.where(valid[:, :, None, None, :], sc, -jnp.inf)
        p = jax.nn.softmax(sc, axis=-1).astype(v.dtype)
        o = jnp.einsum('bqkgj,bqjkd->bqkgd', p, vg)
        return o.reshape(bsz, Q_BLOCK, n_heads, hd)

    out = lax.map(one_block, (to_blocks(q), to_blocks(q_idx), to_blocks(w_idx), starts))
    return from_blocks(out)


def setup_inputs(seed: int = 0) -> dict:
    key = jax.random.key(seed)
    ks = jax.random.split(key, 20)
    f32 = jnp.float32

    def w(k, shape, fan_in):
        return jax.random.normal(k, shape, f32) * fan_in ** -0.5

    def g(k, n):
        return 1.0 + 0.01 * jax.random.normal(k, (DEPTH, n), f32)

    x = jax.random.normal(ks[0], (BATCH, SEQ, D_MODEL), f32)
    positions = jnp.broadcast_to(jnp.arange(SEQ, dtype=jnp.int32)[None, :], (BATCH, SEQ))
    return {
        'x': x,
        'positions': positions,
        'norm_gain': g(ks[1], D_MODEL),
        'w_in': w(ks[2], (DEPTH, D_MODEL, D_IN), D_MODEL),
        'b_merge': 0.01 * jax.random.normal(ks[3], (DEPTH, 2, D_MODEL), f32),
        'mla_q_norm': g(ks[4], MLA_Q_RANK),
        'mla_w_uq': w(ks[5], (DEPTH, MLA_Q_RANK, MLA_HEADS * MLA_QK_DIM), MLA_Q_RANK),
        'mla_kv_norm': g(ks[6], MLA_KV_RANK),
        'mla_w_ukv': w(ks[7], (DEPTH, MLA_KV_RANK, MLA_HEADS * (MLA_NOPE_DIM + MLA_V_DIM)), MLA_KV_RANK),
        'mla_q_gain': g(ks[8], MLA_QK_DIM),
        'mla_k_gain': g(ks[9], MLA_QK_DIM),
        'dsa_q_gain': g(ks[10], DSA_HEAD_DIM),
        'dsa_k_gain': g(ks[11], DSA_HEAD_DIM),
        'w_branch_mla': w(ks[12], (DEPTH, MLA_WIDTH, D_MODEL), MLA_WIDTH),
        'w_branch_dsa': w(ks[13], (DEPTH, DSA_WIDTH, D_MODEL), DSA_WIDTH),
        'w_out': w(ks[14], (DEPTH, D_MODEL, D_MODEL), D_MODEL),
    }


def reference(x, positions, norm_gain, w_in, b_merge, mla_q_norm, mla_w_uq, mla_kv_norm, mla_w_ukv,
              mla_q_gain, mla_k_gain, dsa_q_gain, dsa_k_gain, w_branch_mla, w_branch_dsa, w_out):
    bsz, s_len, _ = x.shape
    k_top = min(INDEX_TOPK_MAX, s_len // 4)
    offsets = [int(o) for o in np.cumsum(IN_SPLITS)[:-1]]
    cos_m, sin_m = rope_angles(positions, MLA_ROPE_DIM)
    cos_d, sin_d = rope_angles(positions, DSA_ROT_DIM)
    cos_i, sin_i = rope_angles(positions, IDX_ROT_DIM)

    for l in range(DEPTH):
        h = rms_norm(x, norm_gain[l])
        proj = h @ w_in[l]
        (c_q, c_kv, k_pe, gate_a, q_b, k_b, v_b, gate_b,
         q_i, k_i, w_i, m_a, m_b) = jnp.split(proj, offsets, axis=-1)

        q_a = (rms_norm(c_q, mla_q_norm[l]) @ mla_w_uq[l]).reshape(bsz, s_len, MLA_HEADS, MLA_QK_DIM)
        kv_a = (rms_norm(c_kv, mla_kv_norm[l]) @ mla_w_ukv[l]).reshape(
            bsz, s_len, MLA_HEADS, MLA_NOPE_DIM + MLA_V_DIM)
        k_nope, v_a = kv_a[..., :MLA_NOPE_DIM], kv_a[..., MLA_NOPE_DIM:]
        k_rope = jnp.broadcast_to(k_pe[:, :, None, :], (bsz, s_len, MLA_HEADS, MLA_ROPE_DIM))
        k_a = jnp.concatenate([k_nope, k_rope], axis=-1)
        q_a = rms_norm(q_a, mla_q_gain[l])
        k_a = rms_norm(k_a, mla_k_gain[l])
        q_a = jnp.concatenate([q_a[..., :MLA_NOPE_DIM], apply_rope(q_a[..., MLA_NOPE_DIM:], cos_m, sin_m)], axis=-1)
        k_a = jnp.concatenate([k_a[..., :MLA_NOPE_DIM], apply_rope(k_a[..., MLA_NOPE_DIM:], cos_m, sin_m)], axis=-1)
        o_a = mla_attention(q_a, k_a, v_a).reshape(bsz, s_len, MLA_WIDTH) * jax.nn.silu(gate_a)

        q_b = rms_norm(q_b.reshape(bsz, s_len, DSA_HEADS, DSA_HEAD_DIM), dsa_q_gain[l])
        k_b = rms_norm(k_b.reshape(bsz, s_len, DSA_KV_HEADS, DSA_HEAD_DIM), dsa_k_gain[l])
        v_b = v_b.reshape(bsz, s_len, DSA_KV_HEADS, DSA_HEAD_DIM)
        q_b = partial_rope(q_b, cos_d, sin_d, DSA_ROT_DIM)
        k_b = partial_rope(k_b, cos_d, sin_d, DSA_ROT_DIM)
        q_i = partial_rope(q_i.reshape(bsz, s_len, IDX_HEADS, IDX_DIM), cos_i, sin_i, IDX_ROT_DIM)
        k_i = partial_rope(k_i[:, :, None, :], cos_i, sin_i, IDX_ROT_DIM)[:, :, 0, :]
        w_i = w_i * (IDX_HEADS ** -0.5 * IDX_DIM ** -0.5)
        o_b = dsa_attention(q_b, k_b, v_b, q_i, k_i, w_i, k_top).reshape(bsz, s_len, DSA_WIDTH)
        o_b = o_b * jax.nn.silu(gate_b)

        merged = (jax.nn.sigmoid(m_a + b_merge[l, 0]) * (o_a @ w_branch_mla[l])
                  + jax.nn.sigmoid(m_b + b_merge[l, 1]) * (o_b @ w_branch_dsa[l]))
        x = x + merged @ w_out[l]
    return x
```

```cpp
#include <hip/hip_runtime.h>
#include <cstdio>

typedef unsigned short bf16_t;
typedef unsigned int u32;
typedef unsigned long long u64;

constexpr int NB = 4, SEQ = 4096, NT = NB * SEQ, DM = 1024, DIN = 4552, NP = 4608;
constexpr int C_CQ = 0, C_CKV = 256, C_KPE = 384, C_KI = 416, C_WI = 448, C_GA = 512, C_QB = 1024, C_KB = 1536, C_VB = 1664,
              C_GB = 1792, C_QI = 2304, C_MA = 2560, C_MB = 3584;
constexpr size_t MiB = 1u << 20;
constexpr size_t OFF_WIN = 0, OFF_WUQ = 9 * MiB, OFF_WUKV = 9 * MiB + 512 * 1024, OFF_WBR = 10 * MiB, OFF_WOUT = 12 * MiB,
                 OFF_ROPE = 14 * MiB, OFF_WI = 17 * MiB + 512 * 1024, OFF_H = 18 * MiB, OFF_AO = 18 * MiB, OFF_PROJ = 50 * MiB,
                 OFF_KVA = 206 * MiB, OFF_MERGED = 206 * MiB, OFF_MASK = 238 * MiB, OFF_KI = 246 * MiB;
constexpr int BAR_WORDS = 3776, BAR_DONE = 3520;
constexpr int BAR_QSEL = 3632, BAR_QATT = 3648;
constexpr int BAR_P1 = 3536, BAR_P2B = 3552, BAR_SEL = 3568;
__device__ unsigned g_bar[BAR_WORDS];
constexpr int LDS_MISC = 131072 + 512;
constexpr int LDS_XCH = 131072 + 1024;
constexpr size_t OUT_QA = 0, OUT_KA = 24 * MiB;
constexpr int LDS_BYTES = 147456;
constexpr int NTHREADS = 512;

struct Params {
    const float* x; const int* pos; const float* norm_gain; const float* w_in; const float* b_merge;
    const float* mla_q_norm; const float* w_uq; const float* mla_kv_norm; const float* w_ukv;
    const float* mla_q_gain; const float* mla_k_gain; const float* dsa_q_gain; const float* dsa_k_gain;
    const float* w_br_mla; const float* w_br_dsa; const float* w_out;
    float* out; unsigned char* ws;
};

__device__ const float c_inv_freq[28] = {
    1.000000000e+00f, 4.403665960e-01f, 1.939227432e-01f, 8.539710194e-02f, 3.760603070e-02f, 1.656044088e-02f, 7.292664610e-03f, 3.211446106e-03f,
    1.414213562e-03f, 6.227724371e-04f, 2.742481884e-04f, 1.207697351e-04f, 5.318295734e-05f, 2.341999971e-05f, 1.031338525e-05f, 4.541670478e-06f,
    1.000000000e+00f, 1.939227432e-01f, 3.760603070e-02f, 7.292664610e-03f, 1.414213562e-03f, 2.742481884e-04f, 5.318295734e-05f, 1.031338525e-05f,
    1.000000000e+00f, 3.760603070e-02f, 1.414213562e-03f, 5.318295734e-05f};

__device__ __forceinline__ void wg_signal(unsigned* ctr, unsigned inc) {
    asm volatile("s_waitcnt vmcnt(0)" ::: "memory");
    __syncthreads();
    if (threadIdx.x == 0) { __builtin_amdgcn_fence(__ATOMIC_RELEASE, "agent"); asm volatile("s_waitcnt vmcnt(0)" ::: "memory");
        __hip_atomic_fetch_add(ctr, inc, __ATOMIC_RELAXED, __HIP_MEMORY_SCOPE_AGENT); }
}
__device__ __forceinline__ void wg_wait(unsigned* ctr, unsigned target) {
    if (threadIdx.x == 0) { unsigned sp = 0u;
        while (__hip_atomic_load(ctr, __ATOMIC_RELAXED, __HIP_MEMORY_SCOPE_AGENT) < target) { __builtin_amdgcn_s_sleep(2); if (++sp > (1u << 24)) break; }
        __builtin_amdgcn_fence(__ATOMIC_ACQUIRE, "agent"); asm volatile("s_waitcnt vmcnt(0)" ::: "memory"); }
    __syncthreads();
}
__device__ __forceinline__ int wg_ticket(unsigned* ctr, unsigned limit, volatile __attribute__((address_space(3))) unsigned* slot) {
    __syncthreads();
    if (threadIdx.x == 0) *slot = __hip_atomic_fetch_add(ctr, 1u, __ATOMIC_RELAXED, __HIP_MEMORY_SCOPE_AGENT);
    __syncthreads();
    const unsigned v = (unsigned)__builtin_amdgcn_readfirstlane((int)*slot);
    return v < limit ? (int)v : -1;
}
__device__ __forceinline__ int opaque_tid() { int t = threadIdx.x; asm volatile("" : "+v"(t)); return t; }
__device__ __forceinline__ float bf2f(bf16_t v) { return __uint_as_float(((u32)v) << 16); }
__device__ __forceinline__ bf16_t f2bf(float f) { u32 u = __float_as_uint(f); return (bf16_t)((u + 0x7fffu + ((u >> 16) & 1u)) >> 16); }
__device__ __forceinline__ float wave_sum(float v) {
#pragma unroll
    for (int o = 1; o < 64; o <<= 1) v += __shfl_xor(v, o);
    return v;
}
__device__ __forceinline__ float wave_max(float v) {
#pragma unroll
    for (int o = 1; o < 64; o <<= 1) v = fmaxf(v, __shfl_xor(v, o));
    return v;
}
__device__ __forceinline__ int oldcol(int n) {
    if (n < 416) return n;
    if (n < 448) return 2464 + (n - 416);
    if (n < 456) return 2496 + (n - 448);
    if (n < 512) return -1;
    if (n < 1024) return 416 + (n - 512);
    if (n < 1536) return 928 + (n - 1024);
    if (n < 1664) return 1440 + (n - 1536);
    if (n < 1792) return 1568 + (n - 1664);
    if (n < 2304) return 1696 + (n - 1792);
    if (n < 2560) return 2208 + (n - 2304);
    if (n < 3584) return 2504 + (n - 2560);
    return 3528 + (n - 3584);
}
__device__ __forceinline__ void sincos_d(double x, double& s, double& c) {
    const double two_over_pi = 0.63661977236758134308, pio2_hi = 1.57079632679489655800e+00, pio2_lo = 6.12323399573676603587e-17;
    const double q = rint(x * two_over_pi);
    double r = fma(-q, pio2_hi, x); r = fma(-q, pio2_lo, r);
    const double r2 = r * r;
    double sp = 1.0 / 1307674368000.0;
    sp = fma(sp, r2, -1.0 / 6227020800.0);
    sp = fma(sp, r2, 1.0 / 39916800.0);
    sp = fma(sp, r2, -1.0 / 362880.0);
    sp = fma(sp, r2, 1.0 / 5040.0);
    sp = fma(sp, r2, -1.0 / 120.0);
    sp = fma(sp, r2, 1.0 / 6.0);
    sp = fma(sp, -r2, 1.0);
    const double sr = sp * r;
    double cp = 1.0 / 20922789888000.0;
    cp = fma(cp, r2, -1.0 / 87178291200.0);
    cp = fma(cp, r2, 1.0 / 479001600.0);
    cp = fma(cp, r2, -1.0 / 3628800.0);
    cp = fma(cp, r2, 1.0 / 40320.0);
    cp = fma(cp, r2, -1.0 / 720.0);
    cp = fma(cp, r2, 1.0 / 24.0);
    cp = fma(cp, r2, -0.5);
    const double cr = fma(cp, r2, 1.0);
    const int n = ((int)q) & 3;
    s = (n == 0) ? sr : (n == 1) ? cr : (n == 2) ? -sr : -cr;
    c = (n == 0) ? cr : (n == 1) ? -sr : (n == 2) ? -cr : sr;
}

__device__ __forceinline__ void unpack8(const uint4 w, float (&f)[8]) {
    f[0] = __uint_as_float(w.x << 16); f[1] = __uint_as_float(w.x & 0xffff0000u);
    f[2] = __uint_as_float(w.y << 16); f[3] = __uint_as_float(w.y & 0xffff0000u);
    f[4] = __uint_as_float(w.z << 16); f[5] = __uint_as_float(w.z & 0xffff0000u);
    f[6] = __uint_as_float(w.w << 16); f[7] = __uint_as_float(w.w & 0xffff0000u);
}

namespace pg8 {
#define PG8_LAS __attribute__((address_space(3)))
typedef unsigned short bf16_t;
typedef short bf16x8 __attribute__((ext_vector_type(8)));
typedef float f32x4 __attribute__((ext_vector_type(4)));
typedef unsigned u32x4 __attribute__((ext_vector_type(4)));
constexpr int BM = 256, BK = 64, HALF = 128, HTB = HALF * BK * 2  , STAGE_BYTES = 8 * HTB, NXCD = 8, WGM = 8;

__host__ __device__ __forceinline__ int lds_byte(int r, int c) { const int st = (r >> 4) * 2 + (c >> 5), rr = r & 15, cc = c & 31, ob = rr * 64 + cc * 2; return st * 1024 + (ob ^ (((ob >> 9) & 1) << 5)); }
__host__ __device__ __forceinline__ void stage_rc(int b, int& R, int& C) { const int st = b / 1024, sb = b % 1024, swz = sb ^ (((sb >> 9) & 1) << 5); R = (st >> 1) * 16 + swz / 64; C = (st & 1) * 32 + (swz % 64) / 2; }
__host__ __device__ __forceinline__ int perm32(int rho) { const int n = rho >> 4, i = rho & 15; return 8 * (i >> 2) + 4 * n + (i & 3); }

struct Unit { int pm, pn; };
struct Gemm { const bf16_t* A; const bf16_t* Bt; int M, N, K, lda, ldb; };

struct StaticOrder {
    int nM, nN, nwg, G, c;
    __host__ __device__ void init(int M, int N, int G_, int c_) { nM = M / BM; nN = N / BM; nwg = nM * nN; G = G_; c = c_; }
    __host__ __device__ bool next(int i, Unit& u) const {
        const long L = (long)i * G + c; if (L >= nwg) return false;
        int wgid = (int)L; { const int q = nwg / NXCD, r = nwg % NXCD, xcd = wgid % NXCD, off = wgid / NXCD; wgid = (xcd < r ? xcd * (q + 1) : r * (q + 1) + (xcd - r) * q) + off; }
        const int nig = WGM * nN, gid = wgid / nig, fm = gid * WGM, gsz = (nM - fm) < WGM ? (nM - fm) : WGM;
        u.pm = fm + ((wgid % nig) % gsz); u.pn = (wgid % nig) / gsz; return true;
    }
    __device__ __forceinline__ void a_ready(const Unit&) const {}
    __device__ __forceinline__ void done(const Unit&) const {}
};
struct ProjOrder : StaticOrder {
    unsigned* ctr;
    __device__ __forceinline__ void done(const Unit& u) const { if (ctr && u.pn >= 8 && u.pn < 12) wg_signal(ctr, 1u); }
};
struct ListOrder {
    int nM, nN, G, c, id0, id1;
    __host__ __device__ bool next(int i, Unit& u) const {
        int L; if (G > 0) { L = i * G + c; if (L >= nM * nN) return false; } else { L = i == 0 ? id0 : (i == 1 ? id1 : -1); if (L < 0) return false; }
        u.pm = L / nN; u.pn = L % nN; return true;
    }
    __device__ __forceinline__ void a_ready(const Unit&) const {}
    __device__ __forceinline__ void done(const Unit&) const {}
};


__device__ __forceinline__ unsigned cvt_pk_bf16(float lo, float hi) { unsigned r; asm volatile("v_cvt_pk_bf16_f32 %0, %1, %2" : "=v"(r) : "v"(lo), "v"(hi)); return r; }
struct EpiBf16 {
    static constexpr bool PERM = true, AFTER_DRAIN = false, MID = false;
    bf16_t* O; int ldc;
    __device__ __forceinline__ void operator()(const f32x4 (&acc)[2][2][4][2], const Unit& u, int wr, int wc, int fr, int fq) const {
        const int row0 = u.pm * BM + wr * 64 + fr, col0 = u.pn * BM + wc * 32 + 8 * fq;
#pragma unroll
        for (int ai = 0; ai < 2; ++ai)
#pragma unroll
            for (int m = 0; m < 4; ++m) { bf16_t* rowp = O + (size_t)(row0 + ai * HALF + m * 16) * ldc + col0;
#pragma unroll
                for (int bj = 0; bj < 2; ++bj) { const f32x4 v0 = acc[ai][bj][m][0], v1 = acc[ai][bj][m][1];
                    u32x4 w; w.x = cvt_pk_bf16(v0[0], v0[1]); w.y = cvt_pk_bf16(v0[2], v0[3]); w.z = cvt_pk_bf16(v1[0], v1[1]); w.w = cvt_pk_bf16(v1[2], v1[3]);
                    *(u32x4*)(rowp + bj * HALF) = w; } }
    }
};
struct EpiProj {
    static constexpr bool PERM = true, AFTER_DRAIN = false, MID = false;
    bf16_t* proj; bf16_t* kic; float* wi; const float* rope; const float* gq; const float* gkv; const float* gkb; PG8_LAS float* xch;
    __device__ __forceinline__ static void st8v(bf16_t* p, const f32x4 a, const f32x4 b) {
        u32x4 w; w.x = cvt_pk_bf16(a[0], a[1]); w.y = cvt_pk_bf16(a[2], a[3]); w.z = cvt_pk_bf16(b[0], b[1]); w.w = cvt_pk_bf16(b[2], b[3]); *(u32x4*)p = w; }
    __device__ __forceinline__ void operator()(const f32x4 (&acc)[2][2][4][2], const Unit& u, int wr, int wc, int fr, int fq) const {
        const int pn = u.pn; const int rowb = u.pm * BM + wr * 64 + fr;
        const bool normt = (pn == 0) | (pn == 1) | (pn == 6);
        if (normt) {
#pragma unroll
            for (int ai = 0; ai < 2; ++ai)
#pragma unroll
                for (int m = 0; m < 4; ++m) {
                    float s = 0.f;
#pragma unroll
                    for (int n = 0; n < 2; ++n)
#pragma unroll
                        for (int j = 0; j < 4; ++j) { s = __builtin_fmaf(acc[ai][0][m][n][j], acc[ai][0][m][n][j], s); if (pn == 0) s = __builtin_fmaf(acc[ai][1][m][n][j], acc[ai][1][m][n][j], s); }
                    s += __shfl_xor(s, 16); s += __shfl_xor(s, 32);
                    if (fq == 0) xch[(ai * HALF + wr * 64 + m * 16 + fr) * 4 + wc] = s;
                }
            asm volatile("s_waitcnt lgkmcnt(0)" ::: "memory"); __builtin_amdgcn_s_barrier(); asm volatile("" ::: "memory");
        }
#pragma unroll
        for (int ai = 0; ai < 2; ++ai)
#pragma unroll
            for (int m = 0; m < 4; ++m) {
                const int rl = ai * HALF + wr * 64 + m * 16 + fr; const size_t row = (size_t)(rowb + ai * HALF + m * 16);
                bf16_t* prow = proj + row * NP; const float* cs = rope + row * 56;
                f32x4 a0 = acc[ai][0][m][0], a1 = acc[ai][0][m][1], b0 = acc[ai][1][m][0], b1 = acc[ai][1][m][1];
                const int c = wc * 32 + 8 * fq;
                if (pn == 0) {
                    const f32x4 pp = *(const PG8_LAS f32x4*)(xch + rl * 4); const float r = rsqrtf(((pp[0] + pp[1]) + (pp[2] + pp[3])) * (1.f / 256.f) + 1e-6f);
                    const f32x4 g0 = *(const f32x4*)(gq + c), g1 = *(const f32x4*)(gq + c + 4), g2 = *(const f32x4*)(gq + 128 + c), g3 = *(const f32x4*)(gq + 128 + c + 4);
                    st8v(prow + C_CQ + c, a0 * r * g0, a1 * r * g1); st8v(prow + C_CQ + 128 + c, b0 * r * g2, b1 * r * g3);
                } else if (pn == 1) {
                    const f32x4 pp = *(const PG8_LAS f32x4*)(xch + rl * 4); const float r = rsqrtf(((pp[0] + pp[1]) + (pp[2] + pp[3])) * (1.f / 128.f) + 1e-6f);
                    const f32x4 g0 = *(const f32x4*)(gkv + c), g1 = *(const f32x4*)(gkv + c + 4);
                    st8v(prow + C_CKV + c, a0 * r * g0, a1 * r * g1);
                    if (wc == 0) st8v(prow + C_KPE + 8 * fq, b0, b1);
                    else if (wc == 1) {
                        if (fq == 0) { const f32x4 c0 = *(const f32x4*)(cs + 48), c1 = *(const f32x4*)(cs + 52);
                            const f32x4 x1 = b0, x2 = b1;
                            b0[0] = x1[0] * c0[0] - x2[0] * c0[1]; b1[0] = x2[0] * c0[0] + x1[0] * c0[1]; b0[1] = x1[1] * c0[2] - x2[1] * c0[3]; b1[1] = x2[1] * c0[2] + x1[1] * c0[3];
                            b0[2] = x1[2] * c1[0] - x2[2] * c1[1]; b1[2] = x2[2] * c1[0] + x1[2] * c1[1]; b0[3] = x1[3] * c1[2] - x2[3] * c1[3]; b1[3] = x2[3] * c1[2] + x1[3] * c1[3]; }
                        st8v(kic + row * 32 + 8 * fq, b0, b1);
                    } else if (wc == 2 && fq == 0) { *(f32x4*)(wi + row * 8) = b0 * 0.0625f; *(f32x4*)(wi + row * 8 + 4) = b1 * 0.0625f; }
                } else if (pn == 6) {
                    const f32x4 pp = *(const PG8_LAS f32x4*)(xch + rl * 4); const float tot = (wc & 2) ? (pp[2] + pp[3]) : (pp[0] + pp[1]); const float r = rsqrtf(tot * (1.f / 64.f) + 1e-6f);
                    const int d = (wc & 1) * 32 + 8 * fq;
                    const f32x4 g0 = *(const f32x4*)(gkb + d), g1 = *(const f32x4*)(gkb + d + 4);
                    a0 = a0 * r * g0; a1 = a1 * r * g1;
                    {
                        f32x4 p0, p1;
#pragma unroll
                        for (int j = 0; j < 4; ++j) { p0[j] = __shfl_xor(a0[j], 16); p1[j] = __shfl_xor(a1[j], 16); }
                        if ((wc & 1) == 0 && fq < 2) {
                            const f32x4 c0 = *(const f32x4*)(cs + 32), c1 = *(const f32x4*)(cs + 36), c2 = *(const f32x4*)(cs + 40), c3 = *(const f32x4*)(cs + 44);
                            const float sg = fq == 0 ? -1.f : 1.f;
                            a0[0] = a0[0] * c0[0] + sg * p0[0] * c0[1]; a0[1] = a0[1] * c0[2] + sg * p0[1] * c0[3]; a0[2] = a0[2] * c1[0] + sg * p0[2] * c1[1]; a0[3] = a0[3] * c1[2] + sg * p0[3] * c1[3];
                            a1[0] = a1[0] * c2[0] + sg * p1[0] * c2[1]; a1[1] = a1[1] * c2[2] + sg * p1[1] * c2[3]; a1[2] = a1[2] * c3[0] + sg * p1[2] * c3[1]; a1[3] = a1[3] * c3[2] + sg * p1[3] * c3[3];
                        }
                    }
                    st8v(prow + C_KB + (wc >> 1) * 64 + d, a0, a1);
                    st8v(prow + C_VB + c, b0, b1);
                } else if (pn == 9) {
                    if (fq == 0) { const f32x4 c0 = *(const f32x4*)(cs + 48), c1 = *(const f32x4*)(cs + 52);
#pragma unroll
                        for (int hb = 0; hb < 2; ++hb) { f32x4& x1r = hb ? b0 : a0; f32x4& x2r = hb ? b1 : a1; const f32x4 x1 = x1r, x2 = x2r;
                            x1r[0] = x1[0] * c0[0] - x2[0] * c0[1]; x2r[0] = x2[0] * c0[0] + x1[0] * c0[1]; x1r[1] = x1[1] * c0[2] - x2[1] * c0[3]; x2r[1] = x2[1] * c0[2] + x1[1] * c0[3];
                            x1r[2] = x1[2] * c1[0] - x2[2] * c1[1]; x2r[2] = x2[2] * c1[0] + x1[2] * c1[1]; x1r[3] = x1[3] * c1[2] - x2[3] * c1[3]; x2r[3] = x2[3] * c1[2] + x1[3] * c1[3]; } }
                    st8v(prow + C_QI + c, a0, a1); st8v(prow + C_QI + 128 + c, b0, b1);
                } else {
                    st8v(prow + pn * 256 + c, a0, a1); st8v(prow + pn * 256 + 128 + c, b0, b1);
                }
            }
    }
};
struct EpiKV {
    static constexpr bool PERM = true, AFTER_DRAIN = false, MID = false;
    bf16_t* ka; bf16_t* kva; const bf16_t* proj; const float* rope; const float* gk; PG8_LAS float* xch;
    __device__ __forceinline__ void operator()(const f32x4 (&acc)[2][2][4][2], const Unit& u, int wr, int wc, int fr, int fq) const {
        const int pn = u.pn; const int rowb = u.pm * BM + wr * 64 + fr;
#pragma unroll
        for (int ai = 0; ai < 2; ++ai)
#pragma unroll
            for (int m = 0; m < 4; ++m) {
                const int rl = ai * HALF + wr * 64 + m * 16 + fr; const size_t row = (size_t)(rowb + ai * HALF + m * 16);
                if (wc < 2) {
#pragma unroll
                    for (int bj = 0; bj < 2; ++bj) { float s = 0.f;
#pragma unroll
                        for (int n = 0; n < 2; ++n)
#pragma unroll
                            for (int j = 0; j < 4; ++j) s = __builtin_fmaf(acc[ai][bj][m][n][j], acc[ai][bj][m][n][j], s);
                        s += __shfl_xor(s, 16); s += __shfl_xor(s, 32);
                        if (fq == 0) xch[(rl * 2 + bj) * 4 + wc] = s; }
                } else if (wc == 2) {
                    const u32x4 w = *(const u32x4*)(proj + row * NP + C_KPE + 8 * fq);
                    const f32x4 q0 = (f32x4){__uint_as_float(w.x << 16), __uint_as_float(w.x & 0xffff0000u), __uint_as_float(w.y << 16), __uint_as_float(w.y & 0xffff0000u)};
                    const f32x4 q1 = (f32x4){__uint_as_float(w.z << 16), __uint_as_float(w.z & 0xffff0000u), __uint_as_float(w.w << 16), __uint_as_float(w.w & 0xffff0000u)};
                    float s = 0.f;
#pragma unroll
                    for (int j = 0; j < 4; ++j) { s = __builtin_fmaf(q0[j], q0[j], s); s = __builtin_fmaf(q1[j], q1[j], s); }
                    s += __shfl_xor(s, 16); s += __shfl_xor(s, 32);
                    if (fq == 0) { xch[(rl * 2 + 0) * 4 + 2] = s; xch[(rl * 2 + 1) * 4 + 2] = s; }
                }
            }
        asm volatile("s_waitcnt lgkmcnt(0)" ::: "memory"); __builtin_amdgcn_s_barrier(); asm volatile("" ::: "memory");
#pragma unroll
        for (int ai = 0; ai < 2; ++ai)
#pragma unroll
            for (int m = 0; m < 4; ++m) {
                const int rl = ai * HALF + wr * 64 + m * 16 + fr; const size_t row = (size_t)(rowb + ai * HALF + m * 16);
                f32x4 pe0 = {0.f, 0.f, 0.f, 0.f}, pe1 = {0.f, 0.f, 0.f, 0.f};
                if (wc == 2) {
                    const u32x4 w = *(const u32x4*)(proj + row * NP + C_KPE + 8 * fq);
                    pe0 = (f32x4){__uint_as_float(w.x << 16), __uint_as_float(w.x & 0xffff0000u), __uint_as_float(w.y << 16), __uint_as_float(w.y & 0xffff0000u)};
                    pe1 = (f32x4){__uint_as_float(w.z << 16), __uint_as_float(w.z & 0xffff0000u), __uint_as_float(w.w << 16), __uint_as_float(w.w & 0xffff0000u)};
                }
#pragma unroll
                for (int bj = 0; bj < 2; ++bj) {
                    const int h = 2 * pn + bj;
                    const f32x4 a0 = acc[ai][bj][m][0], a1 = acc[ai][bj][m][1];
                    if (wc >= 2) EpiProj::st8v(kva + row * 1024 + h * 128 + 64 + (wc - 2) * 32 + 8 * fq, a0, a1);
                    if (wc <= 2) {
                        const f32x4 pp = *(const PG8_LAS f32x4*)(xch + (rl * 2 + bj) * 4); const float r = rsqrtf((pp[0] + pp[1] + pp[2]) * (1.f / 96.f) + 1e-6f);
                        if (wc < 2) { const int d = wc * 32 + 8 * fq; const f32x4 g0 = *(const f32x4*)(gk + d), g1 = *(const f32x4*)(gk + d + 4);
                            EpiProj::st8v(ka + row * 768 + h * 96 + d, a0 * r * g0, a1 * r * g1);
                        } else {
                            const int d = 64 + 8 * fq; const f32x4 g0 = *(const f32x4*)(gk + d), g1 = *(const f32x4*)(gk + d + 4);
                            f32x4 y0 = pe0 * r * g0, y1 = pe1 * r * g1, p0, p1;
#pragma unroll
                            for (int j = 0; j < 4; ++j) { p0[j] = __shfl_xor(y0[j], 32); p1[j] = __shfl_xor(y1[j], 32); }
                            const float* cs = rope + row * 56 + (fq & 1) * 16;
                            const f32x4 c0 = *(const f32x4*)(cs), c1 = *(const f32x4*)(cs + 4), c2 = *(const f32x4*)(cs + 8), c3 = *(const f32x4*)(cs + 12);
                            const float sg = fq < 2 ? -1.f : 1.f;
                            y0[0] = y0[0] * c0[0] + sg * p0[0] * c0[1]; y0[1] = y0[1] * c0[2] + sg * p0[1] * c0[3]; y0[2] = y0[2] * c1[0] + sg * p0[2] * c1[1]; y0[3] = y0[3] * c1[2] + sg * p0[3] * c1[3];
                            y1[0] = y1[0] * c2[0] + sg * p1[0] * c2[1]; y1[1] = y1[1] * c2[2] + sg * p1[1] * c2[3]; y1[2] = y1[2] * c3[0] + sg * p1[2] * c3[1]; y1[3] = y1[3] * c3[2] + sg * p1[3] * c3[3];
                            EpiProj::st8v(ka + row * 768 + h * 96 + d, y0, y1);
                        }
                    }
                }
            }
    }
};
__device__ __forceinline__ float expneg_c(float v) { return __expf(-__builtin_fminf(__builtin_fmaxf(v, -80.f), 80.f)); }
struct EpiGate2 {
    static constexpr bool PERM = true, AFTER_DRAIN = false, MID = true;
    bf16_t* O; const bf16_t* proj; const float* bias;
    __device__ __forceinline__ void mid(f32x4 (&acc)[2][2][4][2], const Unit& u, int wr, int wc, int fr, int fq) const {
        int row0 = u.pm * BM + wr * 64 + fr, col0 = u.pn * BM + wc * 32 + 8 * fq;
        asm volatile("" : "+v"(row0), "+v"(col0));
#pragma unroll
        for (int bj = 0; bj < 2; ++bj) { const int col = col0 + bj * HALF;
            f32x4 ba[2], bb[2];
#pragma unroll
            for (int n = 0; n < 2; ++n) { ba[n] = *(const f32x4*)(bias + col + 4 * n); bb[n] = *(const f32x4*)(bias + 1024 + col + 4 * n); }
#pragma unroll
            for (int ai = 0; ai < 2; ++ai) {
                u32x4 wa[4], wb[4];
#pragma unroll
                for (int m = 0; m < 4; ++m) { const size_t row = (size_t)(row0 + ai * HALF + m * 16); wa[m] = *(const u32x4*)(proj + row * NP + C_MA + col); wb[m] = *(const u32x4*)(proj + row * NP + C_MB + col); }
#pragma unroll
                for (int m = 0; m < 4; ++m) {
#pragma unroll
                    for (int e = 0; e < 4; ++e) {
                        const float ea0 = expneg_c(__uint_as_float(wa[m][e] << 16) + ba[e >> 1][(2 * e) & 3]), ea1 = expneg_c(__uint_as_float(wa[m][e] & 0xffff0000u) + ba[e >> 1][(2 * e + 1) & 3]);
                        const float eb0 = expneg_c(__uint_as_float(wb[m][e] << 16) + bb[e >> 1][(2 * e) & 3]), eb1 = expneg_c(__uint_as_float(wb[m][e] & 0xffff0000u) + bb[e >> 1][(2 * e + 1) & 3]);
                        acc[ai][bj][m][e >> 1][(2 * e) & 3] *= (1.f + eb0) * __builtin_amdgcn_rcpf(1.f + ea0);
                        acc[ai][bj][m][e >> 1][(2 * e + 1) & 3] *= (1.f + eb1) * __builtin_amdgcn_rcpf(1.f + ea1);
                    } }
                asm volatile("" ::: "memory"); }
        }
    }
    __device__ __forceinline__ void operator()(const f32x4 (&acc)[2][2][4][2], const Unit& u, int wr, int wc, int fr, int fq) const {
        const int row0 = u.pm * BM + wr * 64 + fr, col0 = u.pn * BM + wc * 32 + 8 * fq;
#pragma unroll
        for (int bj = 0; bj < 2; ++bj) { const int col = col0 + bj * HALF;
            f32x4 bb[2];
#pragma unroll
            for (int n = 0; n < 2; ++n) bb[n] = *(const f32x4*)(bias + 1024 + col + 4 * n);
            u32x4 wbq[8];
#pragma unroll
            for (int q = 0; q < 8; ++q) { const size_t row = (size_t)(row0 + (q >> 2) * HALF + (q & 3) * 16); wbq[q] = *(const u32x4*)(proj + row * NP + C_MB + col); }
#pragma unroll
            for (int q = 0; q < 8; ++q) { const size_t row = (size_t)(row0 + (q >> 2) * HALF + (q & 3) * 16); const u32x4 wb = wbq[q]; u32x4 w;
#pragma unroll
                    for (int e = 0; e < 4; ++e) {
                        const float g0 = __builtin_amdgcn_rcpf(1.f + expneg_c(__uint_as_float(wb[e] << 16) + bb[e >> 1][(2 * e) & 3])), g1 = __builtin_amdgcn_rcpf(1.f + expneg_c(__uint_as_float(wb[e] & 0xffff0000u) + bb[e >> 1][(2 * e + 1) & 3]));
                        w[e] = cvt_pk_bf16(acc[q >> 2][bj][q & 3][e >> 1][(2 * e) & 3] * g0, acc[q >> 2][bj][q & 3][e >> 1][(2 * e + 1) & 3] * g1);
                    }
                    *(u32x4*)(O + row * 1024 + col) = w; }
        }
    }
};
struct EpiResid {
    static constexpr bool PERM = true, AFTER_DRAIN = false, MID = false;
    float* out; const float* x;
    __device__ __forceinline__ void operator()(const f32x4 (&acc)[2][2][4][2], const Unit& u, int wr, int wc, int fr, int fq) const {
        const int row0 = u.pm * BM + wr * 64 + fr, col0 = u.pn * BM + wc * 32 + 8 * fq;
#pragma unroll
        for (int ai = 0; ai < 2; ++ai)
#pragma unroll
            for (int m = 0; m < 4; ++m) { const size_t row = (size_t)(row0 + ai * HALF + m * 16);
#pragma unroll
                for (int bj = 0; bj < 2; ++bj) { const size_t o = row * 1024 + col0 + bj * HALF;
                    *(f32x4*)(out + o) = *(const f32x4*)(x + o) + acc[ai][bj][m][0];
                    *(f32x4*)(out + o + 4) = *(const f32x4*)(x + o + 4) + acc[ai][bj][m][1]; } }
    }
};

template <class Epi, class Sched, bool ALIGN_EPI = false, bool SP2 = false>
__device__ __forceinline__ void gemm_phase(PG8_LAS unsigned char* lds, const Gemm g, const Sched& S, const Epi& E) {
    const int tid = opaque_tid(), wid = __builtin_amdgcn_readfirstlane(tid >> 6), lane = tid & 63, wr = wid >> 2, wc = wid & 3, fr = lane & 15, fq = lane >> 4;
    int K = g.K; asm volatile("" : "+s"(K));
    const int nt = K / BK;
    unsigned voffA[2], voffB[2];
#pragma unroll
    for (int i = 0; i < 2; ++i) { int R, C; stage_rc(tid * 16 + i * 8192, R, C); const int Rb = Epi::PERM ? ((R & ~31) + perm32(R & 31)) : R;
        voffA[i] = (unsigned)(R * g.lda + C) * 2u; voffB[i] = (unsigned)(Rb * g.ldb + C) * 2u; }
    const size_t kstep = (size_t)(BK * 2);
    const size_t hstepA = (size_t)HALF * g.lda * 2, hstepB = (size_t)HALF * g.ldb * 2;
    const size_t tstepA = 2 * hstepA, tstepB = 2 * hstepB;
    const unsigned ldsw = (unsigned)wid * 1024u;
    const int aoff = lds_byte(wr * 64 + fr, fq * 8), boff = lds_byte(wc * 32 + fr, fq * 8);
#define PG8_SA(b, h) (((b) * 2 + (h)) * HTB)
#define PG8_SB(b, h) ((4 + (b) * 2 + (h)) * HTB)
#define PG8_STAGE(bufoff, gbase, voff) do { _Pragma("unroll") for (int _i = 0; _i < 2; ++_i) \
        __builtin_amdgcn_global_load_lds((const unsigned*)((const char*)(gbase) + (voff)[_i]), (PG8_LAS unsigned*)(lds + (bufoff) + ldsw + _i * 8192), 16, 0, 0); } while (0)
#define PG8_LDA(dst, b, h) do { _Pragma("unroll") for (int m = 0; m < 4; ++m) _Pragma("unroll") for (int k = 0; k < 2; ++k) dst[m][k] = *(const PG8_LAS bf16x8*)(lds + PG8_SA(b, h) + aoff + m * 2048 + k * 1024); } while (0)
#define PG8_LDB(dst, b, h) do { _Pragma("unroll") for (int n = 0; n < 2; ++n) _Pragma("unroll") for (int k = 0; k < 2; ++k) dst[n][k] = *(const PG8_LAS bf16x8*)(lds + PG8_SB(b, h) + boff + n * 2048 + k * 1024); } while (0)
#define PG8_MMA(ai, bj, At, Bt) do { __builtin_amdgcn_s_setprio(1); _Pragma("unroll") for (int m = 0; m < 4; ++m) _Pragma("unroll") for (int n = 0; n < 2; ++n) _Pragma("unroll") for (int k = 0; k < 2; ++k) \
        acc[ai][bj][m][n] = __builtin_amdgcn_mfma_f32_16x16x32_bf16(Bt[n][k], At[m][k], acc[ai][bj][m][n], 0, 0, 0); __builtin_amdgcn_s_setprio(0); } while (0)
#define PG8_WAIT_V(n) asm volatile("s_waitcnt vmcnt(" #n ")" ::: "memory")
#define PG8_WAIT_L(n) asm volatile("s_waitcnt lgkmcnt(" #n ")" ::: "memory")
#define PG8_BAR __builtin_amdgcn_s_barrier()
#define PG8_SCHED __builtin_amdgcn_sched_barrier(0)
    Unit cur, nxt; int ui = 0;
    if (!S.next(0, cur)) return;
    f32x4 acc[2][2][4][2];
#pragma unroll
    for (int a = 0; a < 2; ++a)
#pragma unroll
        for (int b = 0; b < 2; ++b)
#pragma unroll
            for (int m = 0; m < 4; ++m)
#pragma unroll
                for (int n = 0; n < 2; ++n) acc[a][b][m][n] = (f32x4){0.f, 0.f, 0.f, 0.f};
    bf16x8 At[4][2], B0[2][2], B1[2][2];
    const char* cA = (const char*)g.A + (size_t)cur.pm * tstepA; const char* cB = (const char*)g.Bt + (size_t)cur.pn * tstepB;
    S.a_ready(cur);
    if constexpr (SP2) {
        PG8_STAGE(PG8_SB(0, 0), cB, voffB); PG8_STAGE(PG8_SB(0, 1), cB + hstepB, voffB); PG8_STAGE(PG8_SA(0, 0), cA, voffA); PG8_STAGE(PG8_SA(0, 1), cA + hstepA, voffA);
        if (wr == 1) PG8_BAR;
        PG8_WAIT_V(2); PG8_BAR;
        PG8_STAGE(PG8_SB(1, 0), cB + kstep, voffB); PG8_STAGE(PG8_SA(1, 0), cA + kstep, voffA); PG8_STAGE(PG8_SB(1, 1), cB + hstepB + kstep, voffB);
        PG8_WAIT_V(6); PG8_BAR;
    } else {
        PG8_STAGE(PG8_SB(0, 0), cB, voffB); PG8_STAGE(PG8_SA(0, 0), cA, voffA); PG8_STAGE(PG8_SB(0, 1), cB + hstepB, voffB); PG8_STAGE(PG8_SA(0, 1), cA + hstepA, voffA);
        if (wr == 1) PG8_BAR;
        PG8_WAIT_V(4); PG8_BAR;
        PG8_STAGE(PG8_SB(1, 0), cB + kstep, voffB); PG8_STAGE(PG8_SA(1, 0), cA + kstep, voffA); PG8_STAGE(PG8_SB(1, 1), cB + hstepB + kstep, voffB);
        PG8_WAIT_V(6); PG8_BAR;
    }
    for (;;) {
        const bool has_next = S.next(ui + 1, nxt);
        const char* nA = has_next ? (const char*)g.A + (size_t)nxt.pm * tstepA : cA; const char* nB = has_next ? (const char*)g.Bt + (size_t)nxt.pn * tstepB : cB;
        for (int t = 0; t < nt; t += 2) {
            if constexpr (Epi::MID) { if (t == (nt >> 1)) E.mid(acc, cur, wr, wc, fr, fq); }
            const bool last = (t == nt - 2);
            const char* a1 = cA + (size_t)(t + 1) * kstep;
            const char* a2 = last ? nA : cA + (size_t)(t + 2) * kstep; const char* b2 = last ? nB : cB + (size_t)(t + 2) * kstep;
            const char* a3 = a2 + kstep; const char* b3 = b2 + kstep;
            if (last && has_next) S.a_ready(nxt);
            if constexpr (SP2) {
            PG8_LDB(B0, 0, 0); PG8_LDB(B1, 0, 1); PG8_SCHED; PG8_LDA(At, 0, 0); PG8_STAGE(PG8_SA(1, 1), a1 + hstepA, voffA);
            PG8_WAIT_V(8); PG8_WAIT_L(0); PG8_BAR; PG8_MMA(0, 0, At, B0); PG8_MMA(0, 1, At, B1); PG8_BAR; PG8_SCHED;
            PG8_LDA(At, 0, 1); PG8_STAGE(PG8_SB(0, 0), b2, voffB); PG8_STAGE(PG8_SB(0, 1), b2 + hstepB, voffB); PG8_STAGE(PG8_SA(0, 0), a2, voffA);
            PG8_WAIT_V(8); PG8_WAIT_L(0); PG8_BAR; PG8_MMA(1, 0, At, B0); PG8_MMA(1, 1, At, B1); PG8_BAR; PG8_SCHED;
            PG8_LDB(B0, 1, 0); PG8_LDB(B1, 1, 1); PG8_SCHED; PG8_LDA(At, 1, 0); PG8_STAGE(PG8_SA(0, 1), a2 + hstepA, voffA);
            PG8_WAIT_V(8); PG8_WAIT_L(0); PG8_BAR; PG8_MMA(0, 0, At, B0); PG8_MMA(0, 1, At, B1); PG8_BAR; PG8_SCHED;
            PG8_LDA(At, 1, 1); PG8_STAGE(PG8_SB(1, 0), b3, voffB); PG8_STAGE(PG8_SB(1, 1), b3 + hstepB, voffB); PG8_STAGE(PG8_SA(1, 0), a3, voffA);
            PG8_WAIT_V(8); PG8_WAIT_L(0); PG8_BAR; PG8_MMA(1, 0, At, B0); PG8_MMA(1, 1, At, B1); PG8_BAR; PG8_SCHED;
            } else {
            PG8_LDB(B0, 0, 0); PG8_SCHED; PG8_LDA(At, 0, 0); PG8_STAGE(PG8_SA(1, 1), a1 + hstepA, voffA);
            PG8_WAIT_L(8); PG8_BAR; PG8_WAIT_L(0); PG8_MMA(0, 0, At, B0); PG8_BAR; PG8_SCHED;
            PG8_LDB(B1, 0, 1); PG8_STAGE(PG8_SB(0, 0), b2, voffB);
            PG8_BAR; PG8_WAIT_L(0); PG8_MMA(0, 1, At, B1); PG8_BAR;
            PG8_LDA(At, 0, 1); PG8_STAGE(PG8_SA(0, 0), a2, voffA);
            PG8_BAR; PG8_WAIT_L(0); PG8_MMA(1, 0, At, B0); PG8_BAR; PG8_SCHED;
            PG8_STAGE(PG8_SB(0, 1), b2 + hstepB, voffB);
            PG8_WAIT_V(6); PG8_BAR; PG8_MMA(1, 1, At, B1); PG8_BAR;
            PG8_LDB(B0, 1, 0); PG8_SCHED; PG8_LDA(At, 1, 0); PG8_STAGE(PG8_SA(0, 1), a2 + hstepA, voffA);
            PG8_WAIT_L(8); PG8_BAR; PG8_WAIT_L(0); PG8_MMA(0, 0, At, B0); PG8_BAR; PG8_SCHED;
            PG8_LDB(B1, 1, 1); PG8_STAGE(PG8_SB(1, 0), b3, voffB);
            PG8_BAR; PG8_WAIT_L(0); PG8_MMA(0, 1, At, B1); PG8_BAR;
            PG8_LDA(At, 1, 1); PG8_STAGE(PG8_SA(1, 0), a3, voffA);
            PG8_BAR; PG8_WAIT_L(0); PG8_MMA(1, 0, At, B0); PG8_BAR; PG8_SCHED;
            PG8_STAGE(PG8_SB(1, 1), b3 + hstepB, voffB);
            PG8_WAIT_V(6); PG8_BAR; PG8_MMA(1, 1, At, B1); PG8_BAR;
            }
        }
        if constexpr (ALIGN_EPI) { if (wr == 0) PG8_BAR; }
        if constexpr (!Epi::AFTER_DRAIN) { E(acc, cur, wr, wc, fr, fq); S.done(cur); }
        if (!has_next) break;
#pragma unroll
        for (int a = 0; a < 2; ++a)
#pragma unroll
            for (int b = 0; b < 2; ++b)
#pragma unroll
                for (int m = 0; m < 4; ++m)
#pragma unroll
                    for (int n = 0; n < 2; ++n) acc[a][b][m][n] = (f32x4){0.f, 0.f, 0.f, 0.f};
        cur = nxt; cA = nA; cB = nB; ++ui;
        if constexpr (ALIGN_EPI) { if (wr == 1) PG8_BAR; }
    }
    PG8_WAIT_V(0);
    if constexpr (!ALIGN_EPI) { if (wr == 0) PG8_BAR; }
    PG8_BAR;
    if constexpr (Epi::AFTER_DRAIN) { E.fused(acc, cur, wr, wc, fr, fq, lds, wid, lane); S.done(cur); }
#undef PG8_SA
#undef PG8_SB
#undef PG8_STAGE
#undef PG8_LDA
#undef PG8_LDB
#undef PG8_MMA
#undef PG8_WAIT_V
#undef PG8_WAIT_L
#undef PG8_BAR
#undef PG8_SCHED
}
}

namespace att {
typedef short bf16x8 __attribute__((ext_vector_type(8)));
typedef short s16x4 __attribute__((ext_vector_type(4)));
typedef float f32x16 __attribute__((ext_vector_type(16)));
typedef unsigned u32x4 __attribute__((ext_vector_type(4)));
typedef float f32x2_t __attribute__((ext_vector_type(2))); typedef __bf16 bf16x2_t __attribute__((ext_vector_type(2)));
typedef __attribute__((address_space(3))) const char* lds_cptr;
typedef short v4i16_t __attribute__((ext_vector_type(4)));
#define ASBAR() __builtin_amdgcn_sched_barrier(0)
#define APIN(x) asm volatile("" : "+v"(x))
#define AMFMA(a, b, c) __builtin_amdgcn_mfma_f32_32x32x16_bf16(a, b, c, 0, 0, 0)
#define AWAIT_BAR(N) asm volatile("s_waitcnt vmcnt(" #N ") lgkmcnt(0)\n\ts_barrier" ::: "memory")
#define AMX3(a, b, c) __builtin_fmaxf(__builtin_fmaxf((a), (b)), (c))
__device__ __forceinline__ int crow(int r, int hi) { return (r & 3) + 8 * (r >> 2) + 4 * hi; }
__device__ __forceinline__ void glds16(const void* gsrc, unsigned lds_dst) { unsigned keep;
    asm volatile("s_mov_b32 %0, m0\n\ts_mov_b32 m0, %2\n\ts_nop 0\n\tglobal_load_lds_dwordx4 %1, off\n\ts_mov_b32 m0, %0" : "=&s"(keep) : "v"(gsrc), "s"(lds_dst) : "memory"); }
__device__ __forceinline__ unsigned cvtpk_s(float lo, float hi) { f32x2_t v = {lo, hi}; bf16x2_t b = __builtin_convertvector(v, bf16x2_t); return __builtin_bit_cast(unsigned, b); }
__device__ __forceinline__ void kload2(bf16x8* kf, lds_cptr kp, int j) { kf[2 * j] = *(const __attribute__((address_space(3))) bf16x8*)(kp + j * 2048); kf[2 * j + 1] = *(const __attribute__((address_space(3))) bf16x8*)(kp + j * 2048 + 512); }
__device__ __forceinline__ bf16x8 kfrag(lds_cptr kp, int f) { return *(const __attribute__((address_space(3))) bf16x8*)(kp + (f >> 1) * 2048 + (f & 1) * 512); }
__device__ __forceinline__ s16x4 vtr(lds_cptr p) { return __builtin_bit_cast(s16x4, __builtin_amdgcn_ds_read_tr16_b64_v4i16((__attribute__((address_space(3))) v4i16_t*)p)); }
__device__ __forceinline__ void wait_bar_n(int n) {
    if (n <= 0) AWAIT_BAR(0); else if (n == 1) AWAIT_BAR(1); else if (n == 2) AWAIT_BAR(2); else if (n == 3) AWAIT_BAR(3); else if (n == 4) AWAIT_BAR(4); else AWAIT_BAR(5);
}
__device__ __forceinline__ void cmask(f32x16& p0, f32x16& p1, int jb, int qrel, int hi) {
    const int kb = 64 * jb + 4 * hi;
#pragma unroll
    for (int r = 0; r < 16; ++r) { const int kv = kb + (r & 3) + 8 * (r >> 2); if (kv > qrel) p0[r] = -INFINITY; if (kv + 32 > qrel) p1[r] = -INFINITY; } }
__device__ __forceinline__ float silu_f(float g) { return g / (1.f + __expf(-g)); }

template <int DQK> struct Geo {
    static constexpr int ND0 = DQK / 16, NKF = 2 * ND0, KSLOT = (DQK / 8) * 1024, VSLOT = 8192;
    static constexpr int LDS_K = 0, LDS_V = 4 * KSLOT, LDS_WS = LDS_V + 3 * VSLOT, LDS_OST = LDS_WS + 2048, LDS_BYTES = LDS_OST + 8 * 4096;
};
typedef const __attribute__((address_space(4))) u64* cu64p;
#define exp2_msel2(A, B, MA, MB) do { float a_ = (A), b_ = (B); \
    asm("v_exp_f32 %0, %0\n\tv_exp_f32 %1, %1\n\tv_cndmask_b32 %0, 0, %0, %2\n\tv_cndmask_b32 %1, 0, %1, %3" : "+v"(a_), "+v"(b_) : "s"(MA), "s"(MB)); (A) = a_; (B) = b_; } while (0)
template <int DQK, int PQ, int PK, int PV, int PO, int PG, int MODE>
__device__ __forceinline__ void attn_unit(const int qb, const bf16_t* Qb, const bf16_t* Kb, const bf16_t* Vb, bf16_t* Ob, const bf16_t* Gb, char* shm, const u64* Mb, const float* rope_b, const float* qgain,
                                          bf16x8 (&qpre)[6], const bool use_pre, const bf16_t* qnext, const int pqn, const int nd0n) {
    typedef Geo<DQK> G;
    constexpr int ND0 = G::ND0, KSLOT = G::KSLOT, VSLOT = G::VSLOT, LDS_K = G::LDS_K, LDS_V = G::LDS_V, LDS_WS = G::LDS_WS, LDS_OST = G::LDS_OST;
    constexpr float THRL = 8.f;
    int tid = threadIdx.x; asm volatile("" : "+v"(tid));
    const int lane = tid & 63, r32 = lane & 31, hi = lane >> 5; const int wid = __builtin_amdgcn_readfirstlane(tid >> 6);
    const int q0 = qb * 256, NT = (q0 + 256) / 64;
    const bf16_t* Qw = Qb + (long)(q0 + wid * 32) * PQ;
    const unsigned lds0 = (unsigned)(uintptr_t)shm;
    float* wsf = (float*)(shm + LDS_WS) + wid * 64;
    const int nkp = (DQK == 96 && wid < 4) ? 2 : 1;
    const bf16_t* ksrc = Kb + (long)lane * PK + wid * 8;
    const bf16_t* vsrc = Vb + (long)(16 * (wid & 3) + (lane >> 2)) * PV + (wid >> 2) * 32 + (lane & 3) * 8;
    const unsigned kdst = lds0 + LDS_K + wid * 1024, vdst = lds0 + LDS_V + wid * 1024;
#define DMA_K(t, sl) do { glds16(ksrc + (long)(t) * 64 * PK, (unsigned)__builtin_amdgcn_readfirstlane(kdst + (sl) * KSLOT)); \
        if (nkp == 2) glds16(ksrc + (long)(t) * 64 * PK + 64, (unsigned)__builtin_amdgcn_readfirstlane(kdst + (sl) * KSLOT + 8192)); } while (0)
#define DMA_V(t, sl) glds16(vsrc + (long)(t) * 64 * PV, (unsigned)__builtin_amdgcn_readfirstlane(vdst + (sl) * VSLOT))
    const lds_cptr shm3 = (lds_cptr)shm;
    const lds_cptr kp0 = shm3 + LDS_K + hi * 1024 + r32 * 16;
    const lds_cptr vp0 = shm3 + LDS_V + ((lane >> 4) & 1) * 32 + (lane & 3) * 8 + (4 * hi + ((lane & 15) >> 2)) * 64;
    DMA_K(0, 0); DMA_V(0, 0); DMA_K(1, 1);
    bf16x8 qr[ND0];
#pragma unroll
    for (int d0 = 0; d0 < ND0; ++d0) qr[d0] = use_pre ? qpre[d0] : *reinterpret_cast<const bf16x8*>(&Qw[(long)r32 * PQ + d0 * 16 + hi * 8]);
    {
        float v[ND0][8]; float ss = 0.f;
#pragma unroll
        for (int d0 = 0; d0 < ND0; ++d0)
#pragma unroll
            for (int e = 0; e < 8; ++e) { v[d0][e] = __uint_as_float(((unsigned)(unsigned short)qr[d0][e]) << 16); ss = __builtin_fmaf(v[d0][e], v[d0][e], ss); }
        ss += __shfl_xor(ss, 32);
        const float rn = rsqrtf(ss * (1.f / DQK) + 1e-6f);
        constexpr float QS = (DQK == 96) ? 0.14724445f : 0.18033688f;
#pragma unroll
        for (int d0 = 0; d0 < ND0; ++d0)
#pragma unroll
            for (int e = 0; e < 8; ++e) v[d0][e] = v[d0][e] * rn * qgain[16 * d0 + 8 * hi + e] * QS;
        const float* cs = rope_b + (size_t)(q0 + wid * 32 + r32) * 56;
        if (DQK == 96) {
            float4 c4[4];
#pragma unroll
            for (int i = 0; i < 4; ++i) c4[i] = *(const float4*)(cs + hi * 16 + 4 * i);
            const float cc[8] = {c4[0].x, c4[0].z, c4[1].x, c4[1].z, c4[2].x, c4[2].z, c4[3].x, c4[3].z}, sn[8] = {c4[0].y, c4[0].w, c4[1].y, c4[1].w, c4[2].y, c4[2].w, c4[3].y, c4[3].w};
#pragma unroll
            for (int e = 0; e < 8; ++e) { const float a = v[ND0 - 2][e], bb = v[ND0 - 1][e]; v[ND0 - 2][e] = a * cc[e] - bb * sn[e]; v[ND0 - 1][e] = bb * cc[e] + a * sn[e]; }
        } else {
            float4 c4[4];
#pragma unroll
            for (int i = 0; i < 4; ++i) c4[i] = *(const float4*)(cs + 32 + 4 * i);
            const float cc[8] = {c4[0].x, c4[0].z, c4[1].x, c4[1].z, c4[2].x, c4[2].z, c4[3].x, c4[3].z}, sn[8] = {c4[0].y, c4[0].w, c4[1].y, c4[1].w, c4[2].y, c4[2].w, c4[3].y, c4[3].w};
#pragma unroll
            for (int e = 0; e < 8; ++e) { const float pr = __shfl_xor(v[0][e], 32); v[0][e] = hi == 0 ? v[0][e] * cc[e] - pr * sn[e] : v[0][e] * cc[e] + pr * sn[e]; }
        }
#pragma unroll
        for (int d0 = 0; d0 < ND0; ++d0)
#pragma unroll
            for (int e = 0; e < 8; e += 2) { const unsigned pk = cvtpk_s(v[d0][e], v[d0][e + 1]); qr[d0][e] = (short)(pk & 0xffffu); qr[d0][e + 1] = (short)(pk >> 16); }
    }
    float mhat = 0.f, l_reg = 0.f; f32x16 o[2], negm;
    { float z = 0.f; asm volatile("" : "+v"(z));
#pragma unroll
      for (int r = 0; r < 16; ++r) { o[0][r] = z; o[1][r] = z; negm[r] = z; } asm volatile("" : "+v"(negm)); }
    const int qrel = wid * 32 + r32; bool resc = false;
    const cu64p mwave = (cu64p)(uintptr_t)(Mb + (size_t)(qb * 8 + wid) * 16);
#define MLOAD(m0, m1, t) do { if (MODE == 1) { const cu64p mp_ = mwave + (size_t)(2 * (t)) * 2048; \
        _Pragma("unroll") for (int r = 0; r < 16; ++r) { m0[r] = mp_[r]; m1[r] = mp_[2048 + r]; } } } while (0)
    f32x16 pA0, pA1, pB0, pB1; bf16x8 kf[2 * ND0]; s16x4 vlo[8], vhi[8]; u32x4 pw[4];
    int sl_prev = 0, sl_cur = 0, sl_next = 1;
#define ROT() do { sl_prev = sl_cur; sl_cur = sl_next; sl_next = (sl_next == 2) ? 0 : sl_next + 1; } while (0)
#define RESC() do { if (resc) { asm volatile("s_waitcnt lgkmcnt(0)" ::: "memory"); \
        _Pragma("unroll") for (int d_ = 0; d_ < 2; ++d_) _Pragma("unroll") for (int r = 0; r < 16; ++r) o[d_][r] *= wsf[crow(r, hi)]; } } while (0)
#define CMASKT(C0, C1, t) do { if (MODE == 0) { const int jb_ = (t) - (NT - 4); if (jb_ >= 0) cmask(C0, C1, jb_, qrel, hi); } } while (0)
#define DECIDE(C0, C1) do { float a_ = AMX3(C0[0], C0[1], C1[0]), b_ = AMX3(C0[2], C0[3], C1[1]); a_ = AMX3(a_, C1[2], C1[3]); \
        _Pragma("unroll") for (int r = 4; r < 16; r += 4) { a_ = AMX3(a_, C0[r], C0[r + 1]); b_ = AMX3(b_, C0[r + 2], C0[r + 3]); a_ = AMX3(a_, C1[r], C1[r + 1]); b_ = AMX3(b_, C1[r + 2], C1[r + 3]); } \
        float rm_ = __builtin_fmaxf(a_, b_); { auto rr_ = __builtin_amdgcn_permlane32_swap(__float_as_uint(rm_), __float_as_uint(rm_), false, false); rm_ = __builtin_fmaxf(__uint_as_float(rr_[0]), __uint_as_float(rr_[1])); } \
        resc = false; \
        if (__builtin_expect(__any(rm_ > THRL), 0)) { const float dl_ = __builtin_fmaxf(rm_, 0.f); mhat += dl_; \
            _Pragma("unroll") for (int r = 0; r < 16; ++r) { C0[r] -= dl_; C1[r] -= dl_; } \
            _Pragma("unroll") for (int r = 0; r < 16; ++r) negm[r] = -mhat; asm volatile("" : "+v"(negm)); \
            const float f_ = __builtin_amdgcn_exp2f(-dl_); l_reg *= f_; if (hi == 0) wsf[r32] = f_; resc = true; } } while (0)
    DMA_K(2, 2);
    wait_bar_n(1 + 2 * nkp);
    {
        const lds_cptr kb = kp0;
#pragma unroll
        for (int d0 = 0; d0 < ND0; ++d0) {
            const bf16x8 b0 = *(const __attribute__((address_space(3))) bf16x8*)(kb + d0 * 2048);
            const bf16x8 b1 = *(const __attribute__((address_space(3))) bf16x8*)(kb + d0 * 2048 + 512);
            if (d0 == 0) { pA0 = AMFMA(b0, qr[0], negm); pA1 = AMFMA(b1, qr[0], negm); }
            else { pA0 = AMFMA(b0, qr[d0], pA0); pA1 = AMFMA(b1, qr[d0], pA1); }
        }
    }
    CMASKT(pA0, pA1, 0);
    DECIDE(pA0, pA1);
    if (MODE == 1) { u64 m0[16], m1[16]; MLOAD(m0, m1, 0);
#pragma unroll
        for (int r = 0; r < 16; r += 2) { exp2_msel2(pA0[r], pA0[r + 1], m0[r], m0[r + 1]); exp2_msel2(pA1[r], pA1[r + 1], m1[r], m1[r + 1]); } }
    else {
#pragma unroll
        for (int r = 0; r < 16; ++r) { pA0[r] = __builtin_amdgcn_exp2f(pA0[r]); pA1[r] = __builtin_amdgcn_exp2f(pA1[r]); } }
    wait_bar_n(0);
    RESC();
    DMA_K(3, 3); DMA_V(1, 1);
    ROT();
#pragma unroll
    for (int f = 0; f < 4; ++f) kf[f] = kfrag(kp0 + 1 * KSLOT, f);
#define PELM(P0, P1, i) (((i) < 16) ? P0[(i) & 15] : P1[(i) & 15])
#define VFR(i) (bf16x8){vlo[i][0], vlo[i][1], vlo[i][2], vlo[i][3], vhi[i][0], vhi[i][1], vhi[i][2], vhi[i][3]}
#define VRD(i) do { vlo[i] = vtr(vp_ + (((i) >> 2) * 4096 + ((i) & 3) * 1024)); vhi[i] = vtr(vp_ + (((i) >> 2) * 4096 + ((i) & 3) * 1024 + 512)); } while (0)
#define STEP(C0, C1, P0, P1, t, GK, GV, GL) do { ASBAR(); \
        const lds_cptr vp_ = vp0 + sl_prev * VSLOT; const lds_cptr kpc_ = kp0 + ((t) & 3) * KSLOT; const lds_cptr kpn_ = kp0 + (((t) + 1) & 3) * KSLOT; \
        float sacc = P0[0] + P0[1]; u64 m0_[16], m1_[16]; MLOAD(m0_, m1_, t); \
        _Pragma("unroll") for (int g = 0; g < 2 * ND0; ++g) { \
            if (g < 8) { VRD(((g) >> 1) + 4 * ((g) & 1)); } \
            if (g + 4 < 2 * ND0) { kf[g + 4] = kfrag(kpc_, g + 4); } \
            ASBAR(); \
            if ((g & 1) == 0) { C0 = AMFMA(kf[g], qr[g >> 1], (g < 2) ? negm : C0); } else { C1 = AMFMA(kf[g], qr[g >> 1], (g < 2) ? negm : C1); } \
            if (g < 8) { sacc += PELM(P0, P1, 4 * g + 2); sacc += PELM(P0, P1, 4 * g + 3); if (g < 7) { sacc += PELM(P0, P1, 4 * g + 4); sacc += PELM(P0, P1, 4 * g + 5); } APIN(sacc); \
                pw[g >> 1][2 * (g & 1)] = cvtpk_s(PELM(P0, P1, 4 * g), PELM(P0, P1, 4 * g + 1)); pw[g >> 1][2 * (g & 1) + 1] = cvtpk_s(PELM(P0, P1, 4 * g + 2), PELM(P0, P1, 4 * g + 3)); APIN(pw[g >> 1]); } \
            ASBAR(); } \
        l_reg += sacc; \
        if (GK) { DMA_K((t) + 3, ((t) + 3) & 3); } if (GV) { DMA_V((t) + 1, sl_next); } \
        CMASKT(C0, C1, t); \
        DECIDE(C0, C1); \
        ASBAR(); \
        _Pragma("unroll") for (int i = 0; i < 8; ++i) { \
            if ((GL) && i >= 4) { kf[i - 4] = kfrag(kpn_, i - 4); ASBAR(); } \
            o[i & 1] = AMFMA(__builtin_bit_cast(bf16x8, pw[i >> 1]), VFR((i >> 1) + 4 * (i & 1)), o[i & 1]); \
            if (MODE == 1) { if (i < 4) { exp2_msel2(C0[4 * i], C0[4 * i + 1], m0_[4 * i], m0_[4 * i + 1]); exp2_msel2(C0[4 * i + 2], C0[4 * i + 3], m0_[4 * i + 2], m0_[4 * i + 3]); APIN(C0); } \
                             else { exp2_msel2(C1[4 * i - 16], C1[4 * i - 15], m1_[4 * i - 16], m1_[4 * i - 15]); exp2_msel2(C1[4 * i - 14], C1[4 * i - 13], m1_[4 * i - 14], m1_[4 * i - 13]); APIN(C1); } } \
            else if (i < 4) { _Pragma("unroll") for (int e = 0; e < 4; ++e) { C0[4 * i + e] = __builtin_amdgcn_exp2f(C0[4 * i + e]); } APIN(C0); } \
            else { _Pragma("unroll") for (int e = 0; e < 4; ++e) { C1[4 * i - 16 + e] = __builtin_amdgcn_exp2f(C1[4 * i - 16 + e]); } APIN(C1); } \
            ASBAR(); } \
    } while (0)
#define ENDW(tt) do { if ((tt) + 3 < NT) wait_bar_n(nkp + 1); else if ((tt) + 2 < NT) wait_bar_n(1); else wait_bar_n(0); } while (0)
    int t = 1;
    for (; t + 5 < NT; t += 2) {
        STEP(pB0, pB1, pA0, pA1, t, true, true, true);     wait_bar_n(nkp + 1); RESC(); ROT();
        STEP(pA0, pA1, pB0, pB1, t + 1, true, true, true); wait_bar_n(nkp + 1); RESC(); ROT();
    }
    for (; t + 1 < NT; t += 2) {
        STEP(pB0, pB1, pA0, pA1, t, (t + 3 < NT), (t + 1 < NT), (t + 1 < NT));       ENDW(t);     RESC(); ROT();
        STEP(pA0, pA1, pB0, pB1, t + 1, (t + 4 < NT), (t + 2 < NT), (t + 2 < NT));   ENDW(t + 1); RESC(); ROT();
    }
    STEP(pB0, pB1, pA0, pA1, NT - 1, false, false, false); RESC();
    if (qnext) { const bf16_t* qn_ = qnext + (long)(wid * 32 + r32) * pqn + hi * 8;
#pragma unroll
        for (int d0 = 0; d0 < 6; ++d0) if (d0 < nd0n) qpre[d0] = *reinterpret_cast<const bf16x8*>(qn_ + d0 * 16); }
    u32x4 gq[4];
    { const bf16_t* Gw_ = Gb + (long)(q0 + wid * 32) * PG;
#pragma unroll
      for (int i = 0; i < 4; ++i) gq[i] = *(const u32x4*)(Gw_ + (long)(i * 8 + (lane >> 3)) * PG + (lane & 7) * 8); }
    {
        float sacc = pB0[0] + pB0[1];
#pragma unroll
        for (int r = 2; r < 16; ++r) sacc += pB0[r];
#pragma unroll
        for (int r = 0; r < 16; ++r) sacc += pB1[r];
        l_reg += sacc;
#pragma unroll
        for (int g = 0; g < 8; ++g) { pw[g >> 1][2 * (g & 1)] = cvtpk_s(PELM(pB0, pB1, 4 * g), PELM(pB0, pB1, 4 * g + 1)); pw[g >> 1][2 * (g & 1) + 1] = cvtpk_s(PELM(pB0, pB1, 4 * g + 2), PELM(pB0, pB1, 4 * g + 3)); }
        const lds_cptr vp_ = vp0 + sl_cur * VSLOT;
#pragma unroll
        for (int i = 0; i < 8; ++i) VRD(i);
#pragma unroll
        for (int i = 0; i < 8; ++i) o[i & 1] = AMFMA(__builtin_bit_cast(bf16x8, pw[i >> 1]), VFR((i >> 1) + 4 * (i & 1)), o[i & 1]);
    }
    { auto rr = __builtin_amdgcn_permlane32_swap(__float_as_uint(l_reg), __float_as_uint(l_reg), false, false); l_reg = __uint_as_float(rr[0]) + __uint_as_float(rr[1]); }
    if (hi == 0) wsf[32 + r32] = l_reg; asm volatile("s_waitcnt lgkmcnt(0)" ::: "memory");
    float rli[16];
#pragma unroll
    for (int r = 0; r < 16; ++r) rli[r] = __builtin_amdgcn_rcpf(wsf[32 + crow(r, hi)]);
    {
        bf16_t* stg = (bf16_t*)(shm + LDS_OST) + wid * 2048;
#pragma unroll
        for (int r = 0; r < 16; ++r) { const int orow = crow(r, hi);
#pragma unroll
            for (int d0 = 0; d0 < 2; ++d0) stg[orow * 64 + d0 * 32 + r32] = f2bf(o[d0][r] * rli[r]); }
        asm volatile("s_waitcnt lgkmcnt(0)" ::: "memory");
        bf16_t* Ow = Ob + (long)(q0 + wid * 32) * PO;
#pragma unroll
        for (int i = 0; i < 4; ++i) { const int row = i * 8 + (lane >> 3), ch = lane & 7;
            const u32x4 v = *(const u32x4*)(stg + row * 64 + ch * 8); const u32x4 g = gq[i]; u32x4 w;
#pragma unroll
            for (int e = 0; e < 4; ++e) { const float lo = __uint_as_float(v[e] << 16) * silu_f(__uint_as_float(g[e] << 16)), hh = __uint_as_float(v[e] & 0xffff0000u) * silu_f(__uint_as_float(g[e] & 0xffff0000u)); w[e] = cvtpk_s(lo, hh); }
            *(u32x4*)(Ow + (long)row * PO + ch * 8) = w; }
    }
    asm volatile("s_waitcnt lgkmcnt(0)\n\ts_barrier" ::: "memory");
#undef MLOAD
#undef DMA_K
#undef DMA_V
#undef ROT
#undef RESC
#undef CMASKT
#undef DECIDE
#undef PELM
#undef VFR
#undef VRD
#undef STEP
#undef ENDW
}
}

namespace sel {
typedef short bf16x8 __attribute__((ext_vector_type(8)));
typedef float f32x16 __attribute__((ext_vector_type(16)));
constexpr int CAP = 64;
constexpr int L_HIST = 0, L_CS = 65536, L_CI = 73728, L_MASK = 81920, L_STAT = 98304, L_SEG = 100352, L_B = 102400, L_QUOTA = 102528, L_ABOVE = 102656, L_TLO = 102784, L_THI = 102912,
              L_CC = 103040, L_FAIL = 103168  , L_QI = 103424  , L_W = 104448  , L_BYTES = 104480;
__device__ __forceinline__ int crow(int r, int hi) { return (r & 3) + 8 * (r >> 2) + 4 * hi; }
__device__ __forceinline__ void score_tile_k(f32x16& sc, const bf16x8 (&qf)[8][2], const float (&w)[8], const bf16x8 k0, const bf16x8 k1) {
#pragma unroll
    for (int r = 0; r < 16; ++r) sc[r] = 0.f;
#pragma unroll
    for (int hh = 0; hh < 8; hh += 4) {
        f32x16 x[4];
#pragma unroll
        for (int h = 0; h < 4; ++h) { x[h] = __builtin_amdgcn_mfma_f32_32x32x16_bf16(k0, qf[hh + h][0], (f32x16){}, 0, 0, 0); x[h] = __builtin_amdgcn_mfma_f32_32x32x16_bf16(k1, qf[hh + h][1], x[h], 0, 0, 0); }
#pragma unroll
        for (int h = 0; h < 4; ++h)
#pragma unroll
            for (int r = 0; r < 16; ++r) { const float xv = x[h][r]; const int xi = __float_as_int(xv); sc[r] = __builtin_fmaf(w[hh + h], __int_as_float(xi > 0 ? xi : 0), sc[r]); }
        __builtin_amdgcn_sched_barrier(0);
    }
}
__device__ __forceinline__ void score_tile(f32x16& sc, const bf16x8 (&qf)[8][2], const float (&w)[8], const bf16_t* kig, int r32, int hi) {
    const bf16x8 k0 = *(const bf16x8*)(kig + r32 * 32 + hi * 8), k1 = *(const bf16x8*)(kig + r32 * 32 + 16 + hi * 8);
    score_tile_k(sc, qf, w, k0, k1);
}
#define SEL_GLOOP_BEGIN() { const bf16_t* kp_ = kib + (size_t)wid * 1024 + r32 * 32 + hi * 8; bf16x8 kn0_ = *(const bf16x8*)kp_, kn1_ = *(const bf16x8*)(kp_ + 16); \
    for (int g = wid; g <= qblk; g += 8) { const bf16x8 kc0_ = kn0_, kc1_ = kn1_; kp_ += 8 * 1024; if (g + 8 <= qblk) { kn0_ = *(const bf16x8*)kp_; kn1_ = *(const bf16x8*)(kp_ + 16); } \
        score_tile_k(sc, qf, w, kc0_, kc1_);
#define SEL_GLOOP_END() } }
__device__ __forceinline__ int key18_of(float s, float iw, float c0) { const float f = __builtin_amdgcn_fmed3f(__builtin_fmaf(s, iw, c0), 0.f, 262143.f); return (int)f; }
__device__ __forceinline__ int bin10_of(float s, float iw1, float c1) { const float f = __builtin_amdgcn_fmed3f(__builtin_fmaf(s, iw1, c1), 0.f, 1023.99609375f); return (int)f; }
__device__ __forceinline__ void scan_top(const unsigned short* h16, int nseg, int* seg_s, const int* cum0_s, int* B_out, int* above_out, int* cnt_out, int tid) {
    { const int q = tid & 31, seg = tid >> 5; if (seg < nseg) { int s = 0;
#pragma unroll 8
        for (int i = 0; i < 64; ++i) s += h16[((seg * 64 + i) * 32) + q];
        seg_s[q * 16 + seg] = s; } }
    __syncthreads();
    if (tid < 32) {
        int cum = cum0_s ? cum0_s[tid] : 0;
        int cseg[16];
#pragma unroll
        for (int i = 0; i < 16; ++i) cseg[i] = (i < nseg) ? seg_s[tid * 16 + i] : 0;
        int sg = 0; bool found = false;
#pragma unroll
        for (int i = 15; i >= 1; --i) { if (i < nseg) { const bool hit = !found && (cum + cseg[i] >= 256); if (hit) { sg = i; found = true; } if (!found) cum += cseg[i]; } }
        int bb = -1, cb = 0; bool fb = false;
#pragma unroll 1
        for (int ch = 3; ch >= 0; --ch) {
            int cv[16];
#pragma unroll
            for (int i = 0; i < 16; ++i) cv[i] = h16[(sg * 64 + ch * 16 + i) * 32 + tid];
#pragma unroll
            for (int i = 15; i >= 0; --i) { const bool hit = !fb && (cum + cv[i] >= 256); if (hit) { bb = sg * 64 + ch * 16 + i; cb = cv[i]; fb = true; } if (!fb) cum += cv[i]; }
        }
        B_out[tid] = bb; above_out[tid] = cum; cnt_out[tid] = cb;
    }
    __syncthreads();
}

__device__ __forceinline__ void sel_unit(const int b, const int qblk, const bf16_t* proj, const bf16_t* ki, const float* wi, u64* M64, unsigned char* smem) {
    unsigned* hist = (unsigned*)(smem + L_HIST); float* cs = (float*)(smem + L_CS); int* ci = (int*)(smem + L_CI); u64* mask = (u64*)(smem + L_MASK); unsigned* mask32 = (unsigned*)(smem + L_MASK);
    float* stat = (float*)(smem + L_STAT); int* seg_s = (int*)(smem + L_SEG); int* B_s = (int*)(smem + L_B); int* quota_s = (int*)(smem + L_QUOTA); int* above_s = (int*)(smem + L_ABOVE);
    int* tlo_s = (int*)(smem + L_TLO); int* thi_s = (int*)(smem + L_THI); unsigned* cc = (unsigned*)(smem + L_CC); int* flag_s = (int*)(smem + L_FAIL); int* failq = (int*)(smem + L_FAIL + 16);
    int* cnt_s = (int*)(smem + L_STAT);
    int tid = threadIdx.x; asm volatile("" : "+v"(tid));
    const int lane = tid & 63, r32 = lane & 31, hi = lane >> 5; const int wid = __builtin_amdgcn_readfirstlane(tid >> 6);
    const size_t trow = (size_t)b * SEQ + qblk * 32 + r32;
    const bf16_t* kib = ki + (size_t)b * SEQ * 32;
    const int gend = (qblk | 7) + 1;
    const bool topk = qblk >= 8;
    for (int i = tid; i < gend * 32; i += NTHREADS) mask32[i] = 0u;
    unsigned zz = 0u; asm volatile("" : "+v"(zz));
    if (topk) for (int i = tid; i < 4096; i += NTHREADS) ((uint4*)hist)[i] = make_uint4(zz, zz, zz, zz);
    if (tid < 32) { cc[tid] = 0u; failq[tid] = 0; }
    if (tid < 4) flag_s[tid] = 0;
    bf16x8 qf[8][2]; float w[8];
#pragma unroll
    for (int h = 0; h < 8; ++h) { qf[h][0] = *(const bf16x8*)(proj + trow * NP + C_QI + h * 32 + hi * 8); qf[h][1] = *(const bf16x8*)(proj + trow * NP + C_QI + h * 32 + 16 + hi * 8); w[h] = wi[trow * 8 + h]; }
    float iw = 0.f, c0 = 0.f; int Tlo = 0x7fffffff, Thi = -1;
    f32x16 sc;
    const unsigned hadd = (r32 & 1) ? 0x10000u : 1u; const unsigned hoff = (unsigned)(r32 >> 1) * 4u;
    if (topk) {
        score_tile(sc, qf, w, kib + (size_t)wid * 32 * 32, r32, hi);
        float s1 = 0.f, s2 = 0.f;
#pragma unroll
        for (int r = 0; r < 16; ++r) { s1 += sc[r]; s2 = __builtin_fmaf(sc[r], sc[r], s2); }
        s1 += __shfl_xor(s1, 32); s2 += __shfl_xor(s2, 32);
        if (hi == 0) { stat[(wid * 32 + r32) * 2] = s1; stat[(wid * 32 + r32) * 2 + 1] = s2; }
        __syncthreads();
        { float a1 = 0.f, a2 = 0.f;
#pragma unroll
          for (int ww = 0; ww < 8; ++ww) { a1 += stat[(ww * 32 + r32) * 2]; a2 += stat[(ww * 32 + r32) * 2 + 1]; }
          const float mu = a1 * (1.f / 256.f); float var = a2 * (1.f / 256.f) - mu * mu; var = __builtin_fmaxf(var, 0.f);
          const float sd = __builtin_sqrtf(var); const float lo = mu - 6.f * sd; iw = sd > 0.f ? 262144.f / (12.f * sd) : 0.f; c0 = -lo * iw; }
        const float iw1 = iw * (1.f / 256.f), c1 = c0 * (1.f / 256.f);
        SEL_GLOOP_BEGIN()
            if (g == qblk) {
#pragma unroll
                for (int r = 0; r < 16; ++r) { const int bin = bin10_of(sc[r], iw1, c1); if (crow(r, hi) <= r32) atomicAdd((unsigned*)((unsigned char*)hist + (bin << 6) + hoff), hadd); }
            } else {
#pragma unroll
                for (int r = 0; r < 16; ++r) { const int bin = bin10_of(sc[r], iw1, c1); atomicAdd((unsigned*)((unsigned char*)hist + (bin << 6) + hoff), hadd); }
            }
        SEL_GLOOP_END()
        __syncthreads();
        scan_top((const unsigned short*)hist, 16, seg_s, nullptr, B_s, above_s, cnt_s, tid);
        if (tid < 32) {
            const int Bf = B_s[tid];
            quota_s[tid] = 256 - above_s[tid]; tlo_s[tid] = Bf * 256; thi_s[tid] = Bf * 256 + 255;
            if (Bf <= 0 || Bf >= 1023) { failq[tid] = 1; flag_s[1] = 1; }
            else if (cnt_s[tid] > CAP) flag_s[0] = 1;
        }
        __syncthreads();
        if (flag_s[0] != 0) {
            const int Bq = B_s[r32];
            __syncthreads();
            for (int i = tid; i < 1024; i += NTHREADS) ((uint4*)hist)[i] = make_uint4(zz, zz, zz, zz);
            __syncthreads();
            SEL_GLOOP_BEGIN()
                const bool diag = (g == qblk);
#pragma unroll
                for (int r = 0; r < 16; ++r) {
                    const bool valid = !diag || (crow(r, hi) <= r32);
                    const int k18 = key18_of(sc[r], iw, c0); const int sub = k18 & 255;
                    if (valid && (k18 >> 8) == Bq) atomicAdd((unsigned*)((unsigned char*)hist + (sub << 6) + hoff), hadd);
                }
            SEL_GLOOP_END()
            __syncthreads();
            scan_top((const unsigned short*)hist, 4, seg_s, above_s, tlo_s  , quota_s  , cnt_s, tid);
            if (tid < 32 && failq[tid] == 0) {
                const int B2 = tlo_s[tid], ab = quota_s[tid];
                if (B2 < 0 || cnt_s[tid] > CAP) { failq[tid] = 1; flag_s[1] = 1; }
                quota_s[tid] = 256 - ab; tlo_s[tid] = B_s[tid] * 256 + B2; thi_s[tid] = B_s[tid] * 256 + B2;
            }
            __syncthreads();
        }
        Tlo = tlo_s[r32]; Thi = thi_s[r32];
        if (failq[r32] != 0) { Tlo = 0x7fffffff; Thi = 0x7fffffff; }
    } else { __syncthreads(); }
    const unsigned twid = (unsigned)(Thi - Tlo);
#define SEL_P2_BODY(VALID) do { \
        _Pragma("unroll") for (int r = 0; r < 16; ++r) { \
            const int k16 = topk ? key18_of(sc[r], iw, c0) : 0; \
            const u64 m = __ballot((VALID) && k16 > Thi); \
            if (lane == r) mine = m; \
            if ((VALID) && (unsigned)(k16 - Tlo) <= twid) { const unsigned slot = atomicAdd(&cc[r32], 1u); if (slot < (unsigned)CAP) { cs[r32 * CAP + slot] = sc[r]; ci[r32 * CAP + slot] = g * 32 + crow(r, hi); } } \
        } } while (0)
    SEL_GLOOP_BEGIN()
        u64 mine = 0ull;
        if (g == qblk) SEL_P2_BODY(crow(r, hi) <= r32); else SEL_P2_BODY(true);
        if (lane < 16) mask[g * 16 + lane] = mine;
    SEL_GLOOP_END()
#undef SEL_P2_BODY
    __syncthreads();
    if (topk) {
        for (int qq = 0; qq < 4; ++qq) {
            const int q = wid * 4 + qq; int c = (int)cc[q]; c = c < CAP ? c : CAP; const int quo = quota_s[q];
            const float si = lane < c ? cs[q * CAP + lane] : 0.f; const int ii = lane < c ? ci[q * CAP + lane] : 0; int rank = 0;
            for (int j = 0; j < c; ++j) { const float sj = cs[q * CAP + j]; const int ij = ci[q * CAP + j]; rank += (sj > si || (sj == si && ij < ii)) ? 1 : 0; }
            if (lane < c && rank < quo) { const int g = ii >> 5, ko = ii & 31, r = (ko & 3) + 4 * (ko >> 3), hh = (ko >> 2) & 1; atomicOr(&mask32[(g * 16 + r) * 2 + hh], 1u << q); }
        }
        if (flag_s[1] != 0) {
            u64* keys = (u64*)smem; float* qi_s = (float*)(smem + L_QI); float* w_s = (float*)(smem + L_W);
            for (int qq = 0; qq < 32; ++qq) {
                if (failq[qq] == 0) continue;
                const size_t t = (size_t)b * SEQ + qblk * 32 + qq; const int n = qblk * 32 + qq + 1;
                __syncthreads();
                if (tid < 256) qi_s[tid] = bf2f(proj[t * NP + C_QI + tid]);
                if (tid < 8) w_s[tid] = wi[t * 8 + tid];
                __syncthreads();
                int Npad = 512; while (Npad < n) Npad <<= 1;
                for (int s = tid; s < Npad; s += NTHREADS) {
                    u64 key = 0;
                    if (s < n) {
                        const bf16_t* kr = kib + (size_t)s * 32; float kv[32];
#pragma unroll
                        for (int d = 0; d < 32; d += 8) { float f[8]; unpack8(*(const uint4*)(kr + d), f);
#pragma unroll
                            for (int i = 0; i < 8; ++i) kv[d + i] = f[i]; }
                        float scv = 0.f;
#pragma unroll
                        for (int h = 0; h < 8; ++h) { float d = 0.f;
#pragma unroll
                            for (int i = 0; i < 32; ++i) d = fmaf(qi_s[h * 32 + i], kv[i], d);
                            scv = fmaf(w_s[h], fmaxf(d, 0.f), scv); }
                        u32 ub = __float_as_uint(scv); ub = (ub & 0x80000000u) ? ~ub : (ub | 0x80000000u);
                        key = ((u64)ub << 32) | (u64)(0xFFFFFFFFu - (u32)s);
                    }
                    keys[s] = key;
                }
                __syncthreads();
                for (int kk = 2; kk <= Npad; kk <<= 1)
                    for (int j = kk >> 1; j > 0; j >>= 1) {
                        for (int i = tid; i < Npad; i += NTHREADS) {
                            const int ixj = i ^ j;
                            if (ixj > i) { const u64 a = keys[i], c = keys[ixj]; const bool desc = (i & kk) == 0; if (desc ? (a < c) : (a > c)) { keys[i] = c; keys[ixj] = a; } }
                        }
                        __syncthreads();
                    }
                if (tid < 256) { const int ii = (int)(0xFFFFFFFFu - (u32)(keys[tid] & 0xFFFFFFFFull)); const int g = ii >> 5, ko = ii & 31, r = (ko & 3) + 4 * (ko >> 3), hh = (ko >> 2) & 1; atomicOr(&mask32[(g * 16 + r) * 2 + hh], 1u << qq); }
            }
        }
    }
    __syncthreads();
    u64* dst = M64 + (size_t)b * 128 * 128 * 16;
    for (int i = tid; i < gend * 16; i += NTHREADS) { const int g = i >> 4, r = i & 15; dst[((size_t)g * 128 + qblk) * 16 + r] = mask[i]; }
    __syncthreads();
}
}

#define GAS __attribute__((address_space(1)))
#define LAS __attribute__((address_space(3)))
typedef GAS unsigned gu32;
typedef GAS unsigned long long gu64;
#define RLX_AGENT __ATOMIC_RELAXED, __HIP_MEMORY_SCOPE_AGENT
#define XB_TMO      128
#define XB_XCNT(j)  (256  + 64 * (j))
#define XB_XSUB(j)  (1280 + 64 * (j))
#define XB_XGEN(j)  (2304 + 64 * (j))
#define XB_TOP      3328
#define XB_TOPGEN   3392
#define XCD_BAR_WORDS 3456
#define XB_SPIN_CAP (1u << 18)

__device__ __forceinline__ unsigned xb_ld(unsigned* p)              { return __hip_atomic_load(p, __ATOMIC_RELAXED, __HIP_MEMORY_SCOPE_AGENT); }
__device__ __forceinline__ unsigned xb_add(unsigned* p, unsigned v) { return __hip_atomic_fetch_add(p, v, __ATOMIC_RELAXED, __HIP_MEMORY_SCOPE_AGENT); }
__device__ __forceinline__ unsigned xb_xcc_id() { return (unsigned)__builtin_amdgcn_s_getreg((3 << 11) | 20) & 0xFu; }
#define XB_SPIN(cond, bar) do { unsigned _sp = 0; while (cond) { __builtin_amdgcn_s_sleep(1); \
    if ((++_sp & 255u) == 0u) { if (xb_ld(&(bar)[XB_TMO])) break; if (_sp > XB_SPIN_CAP) { atomicAdd(&(bar)[XB_TMO], 1u); break; } } } } while (0)

struct XcdBarrier {
    unsigned* bar; unsigned x;
    volatile LAS unsigned* st;
};

__device__ __forceinline__ XcdBarrier xcd_barrier_post(unsigned* bar, volatile LAS unsigned* st) {
    XcdBarrier b; b.bar = bar; b.x = xb_xcc_id(); b.st = st;
    if (threadIdx.x == 0) (void)xb_add(&bar[XB_XCNT(b.x)], 1u);
    return b;
}
__device__ __forceinline__ void xcd_barrier_complete(unsigned* bar, unsigned x, unsigned& nloc, unsigned& nx) {
    const unsigned G = gridDim.x * gridDim.y * gridDim.z;
    unsigned sum, cnt, mine, sp = 0u;
    for (;;) {
        sum = 0u; cnt = 0u; mine = 0u;
#pragma unroll
        for (unsigned j = 0; j < 16; ++j) { const unsigned c = xb_ld(&bar[XB_XCNT(j)]); sum += c; cnt += (c > 0u) ? 1u : 0u; mine = (j == x) ? c : mine; }
        if (sum == G) break;
        __builtin_amdgcn_s_sleep(1);
        if ((++sp & 255u) == 0u) { if (xb_ld(&bar[XB_TMO])) break; if (sp > XB_SPIN_CAP) { atomicAdd(&bar[XB_TMO], 1u); break; } }
    }
    nloc = mine > 0u ? mine : 1u; nx = cnt > 0u ? cnt : 1u;
}

__device__ __forceinline__ void xcd_barrier(const XcdBarrier& b) {
    asm volatile("s_waitcnt vmcnt(0)" ::: "memory");
    __syncthreads();
    if (threadIdx.x == 0) {
        unsigned* bar = b.bar;
        __builtin_amdgcn_s_waitcnt(0);
        unsigned nloc = b.st[0], nx = b.st[1];
        if (nloc == 0u) { xcd_barrier_complete(bar, b.x, nloc, nx); b.st[0] = nloc; b.st[1] = nx; }
        const unsigned old = xb_add(&bar[XB_XSUB(b.x)], 1u);
        const unsigned gen = old / nloc;
        if (old + 1u == (gen + 1u) * nloc) {
            __builtin_amdgcn_fence(__ATOMIC_RELEASE, "agent");
            asm volatile("s_waitcnt vmcnt(0)" ::: "memory");
            const unsigned og = xb_add(&bar[XB_TOP], 1u);
            const unsigned tg = og / nx;
            if (og + 1u == (tg + 1u) * nx) xb_add(&bar[XB_TOPGEN], 1u);
            else XB_SPIN(xb_ld(&bar[XB_TOPGEN]) == tg, bar);
            __builtin_amdgcn_fence(__ATOMIC_ACQUIRE, "agent");
            xb_add(&bar[XB_XGEN(b.x)], 1u);
            asm volatile("s_waitcnt vmcnt(0)" ::: "memory");
        } else {
            XB_SPIN(xb_ld(&bar[XB_XGEN(b.x)]) == gen, bar);
            __builtin_amdgcn_fence(__ATOMIC_ACQUIRE, "agent");
            asm volatile("s_waitcnt vmcnt(0)" ::: "memory");
        }
    }
    __syncthreads();
}


template <bool PERMUTE>
__device__ __forceinline__ void transpose_item(const float* W, int ldw, int N, bf16_t* WT, int ldt, int koff, float* scr, int item, int lane) {
    const int nblk = N / 32, kb = item / nblk, nb = item % nblk, k0 = 64 * kb, n0 = 32 * nb;
    const int nn = n0 + (lane & 31); const int sc = PERMUTE ? oldcol(nn) : nn;
    float wv_[32];
#pragma unroll
    for (int i = 0; i < 32; ++i) { const int kk = 2 * i + (lane >> 5); wv_[i] = sc >= 0 ? W[(size_t)(k0 + kk) * ldw + sc] : 0.f; }
#pragma unroll
    for (int i = 0; i < 32; ++i) { const int kk = 2 * i + (lane >> 5); scr[kk * 33 + (lane & 31)] = wv_[i]; }
    asm volatile("s_waitcnt lgkmcnt(0)" ::: "memory");
    const int c = lane & 7;
#pragma unroll
    for (int j = 0; j < 4; ++j) { const int n = (lane >> 3) + 8 * j; const float* s = scr + (8 * c) * 33 + n;
        uint4 o; o.x = (u32)f2bf(s[0 * 33]) | ((u32)f2bf(s[1 * 33]) << 16); o.y = (u32)f2bf(s[2 * 33]) | ((u32)f2bf(s[3 * 33]) << 16);
        o.z = (u32)f2bf(s[4 * 33]) | ((u32)f2bf(s[5 * 33]) << 16); o.w = (u32)f2bf(s[6 * 33]) | ((u32)f2bf(s[7 * 33]) << 16);
        *(uint4*)(WT + (size_t)(n0 + n) * ldt + koff + k0 + 8 * c) = o; }
    asm volatile("s_waitcnt lgkmcnt(0)" ::: "memory");
}
__device__ __forceinline__ void late_weights(const Params& p, unsigned char* smem, int wg, int nwg) {
    const int tidx = opaque_tid(); const int lane_ = tidx & 63, wv = tidx >> 6;
    float* scr = (float*)(smem + wv * 8704);
    constexpr int I_BR = 8 * 32, I_OUT = 16 * 32, I_ALL = 2 * I_BR + I_OUT;
    for (int it = wg * 8 + wv; it < I_ALL; it += nwg * 8) {
        int r = it;
        if (r < I_BR) { transpose_item<false>(p.w_br_mla, 1024, 1024, (bf16_t*)(p.ws + OFF_WBR), 1024, 0, scr, r, lane_); continue; } r -= I_BR;
        if (r < I_BR) { transpose_item<false>(p.w_br_dsa, 1024, 1024, (bf16_t*)(p.ws + OFF_WBR), 1024, 512, scr, r, lane_); continue; } r -= I_BR;
        transpose_item<false>(p.w_out, 1024, 1024, (bf16_t*)(p.ws + OFF_WOUT), 1024, 0, scr, r, lane_);
    }
}
__device__ __forceinline__ void ph0(const Params& p, unsigned char* smem) {
    const int tidx = opaque_tid(); const int gtid = blockIdx.x * blockDim.x + tidx, gsz = gridDim.x * blockDim.x;
    const int lane = tidx & 63, gw = gtid >> 6, nw = gsz >> 6;
    float4 va[4][4], vb[4][4];
#define PH0_LOAD(V, t_) do { _Pragma("unroll") for (int u = 0; u < 4; ++u) { const float4* xr = (const float4*)(p.x + (size_t)((t_) + u) * DM); \
        _Pragma("unroll") for (int j = 0; j < 4; ++j) V[u][j] = xr[j * 64 + lane]; } } while (0)
    const int st = nw * 4; int t = gw * 4;
    if (t < NT) PH0_LOAD(va, t);
    if (t + st < NT) PH0_LOAD(vb, t + st);
    {
        const int wv = tidx >> 6;
        float* scr = (float*)(smem + wv * 8704);
        constexpr int I_IN = 16 * 144, I_UQ = 4 * 24, I_UKV = 2 * 32;
        for (int it = gw; it < I_IN + I_UQ + I_UKV; it += nw) {
            if (it < I_IN) transpose_item<true>(p.w_in, DIN, NP, (bf16_t*)(p.ws + OFF_WIN), DM, 0, scr, it, lane);
            else if (it < I_IN + I_UQ) transpose_item<false>(p.w_uq, 768, 768, (bf16_t*)(p.ws + OFF_WUQ), 256, 0, scr, it - I_IN, lane);
            else transpose_item<false>(p.w_ukv, 1024, 1024, (bf16_t*)(p.ws + OFF_WUKV), 128, 0, scr, it - I_IN - I_UQ, lane);
        }
    }
    float* rope = (float*)(p.ws + OFF_ROPE);
    for (int i = gtid; i < NT * 28; i += gsz) {
        const int tt = i / 28, j = i % 28;
        const float ang = (float)p.pos[tt] * c_inv_freq[j];
        double s, c; sincos_d((double)ang, s, c);
        *(float2*)(rope + 2 * i) = make_float2((float)c, (float)s);
    }
    bf16_t* H = (bf16_t*)(p.ws + OFF_H);
    float4 g[4];
#pragma unroll
    for (int j = 0; j < 4; ++j) g[j] = *(const float4*)(p.norm_gain + (j * 64 + lane) * 4);
#define PH0_PROC(V, t_) do { _Pragma("unroll") for (int u = 0; u < 4; ++u) { float ss = 0.f; \
        _Pragma("unroll") for (int j = 0; j < 4; ++j) ss += V[u][j].x * V[u][j].x + V[u][j].y * V[u][j].y + V[u][j].z * V[u][j].z + V[u][j].w * V[u][j].w; \
        ss = wave_sum(ss); const float r = rsqrtf(ss * (1.f / DM) + 1e-6f); \
        _Pragma("unroll") for (int j = 0; j < 4; ++j) { \
            uint2 o; o.x = (u32)f2bf(V[u][j].x * r * g[j].x) | ((u32)f2bf(V[u][j].y * r * g[j].y) << 16); o.y = (u32)f2bf(V[u][j].z * r * g[j].z) | ((u32)f2bf(V[u][j].w * r * g[j].w) << 16); \
            *(uint2*)(H + (size_t)((t_) + u) * DM + (j * 64 + lane) * 4) = o; } } } while (0)
    for (;;) {
        if (t >= NT) break;
        PH0_PROC(va, t); if (t + 2 * st < NT) PH0_LOAD(va, t + 2 * st); t += st;
        if (t >= NT) break;
        PH0_PROC(vb, t); if (t + 2 * st < NT) PH0_LOAD(vb, t + 2 * st); t += st;
    }
#undef PH0_LOAD
#undef PH0_PROC
}
__device__ __forceinline__ void ph1(const Params& p, PG8_LAS unsigned char* lds, unsigned* ctr) {
    pg8::Gemm g{(const bf16_t*)(p.ws + OFF_H), (const bf16_t*)(p.ws + OFF_WIN), NT, NP, DM, DM, DM}; pg8::ProjOrder S; S.init(NT, NP, gridDim.x, blockIdx.x); S.ctr = ctr;
    pg8::EpiProj E{(bf16_t*)(p.ws + OFF_PROJ), (bf16_t*)(p.ws + OFF_KI), (float*)(p.ws + OFF_WI), (const float*)(p.ws + OFF_ROPE), p.mla_q_norm, p.mla_kv_norm, p.dsa_k_gain,
                   (PG8_LAS float*)(lds + LDS_XCH)};
    pg8::gemm_phase<pg8::EpiProj, pg8::ProjOrder, true, true>(lds, g, S, E);
}
__device__ __forceinline__ void ph2b(const Params& p, PG8_LAS unsigned char* lds, const bool df) {
    const int bx = blockIdx.x, a = bx - 128;
    { pg8::Gemm g{(const bf16_t*)(p.ws + OFF_PROJ) + C_CQ, (const bf16_t*)(p.ws + OFF_WUQ), NT, 768, 256, NP, 256};
      pg8::ListOrder S{NT / 256, 3, df ? 0 : (int)gridDim.x, bx, a >= 0 ? a : -1, (a >= 0 && a < 64) ? 128 + a : -1};
      pg8::EpiBf16 E{(bf16_t*)((unsigned char*)p.out + OUT_QA), 768};
      pg8::gemm_phase<pg8::EpiBf16, pg8::ListOrder, true, true>(lds, g, S, E); }
    { pg8::Gemm g{(const bf16_t*)(p.ws + OFF_PROJ) + C_CKV, (const bf16_t*)(p.ws + OFF_WUKV), NT, 1024, 128, NP, 128};
      pg8::ListOrder S{NT / 256, 4, df ? 0 : (int)gridDim.x, bx, a >= 0 ? a : (bx < 64 ? 192 + bx : -1), a >= 64 ? 64 + a : -1};
      pg8::EpiKV E{(bf16_t*)((unsigned char*)p.out + OUT_KA), (bf16_t*)(p.ws + OFF_KVA), (const bf16_t*)(p.ws + OFF_PROJ), (const float*)(p.ws + OFF_ROPE), p.mla_k_gain, (PG8_LAS float*)(lds + LDS_XCH)};
      pg8::gemm_phase<pg8::EpiKV, pg8::ListOrder, true, true>(lds, g, S, E); }
}
__device__ __forceinline__ void ph3_sel(const Params& p, unsigned char* smem, volatile __attribute__((address_space(3))) unsigned* slot) {
    const bf16_t* proj = (const bf16_t*)(p.ws + OFF_PROJ); const bf16_t* ki = (const bf16_t*)(p.ws + OFF_KI); const float* wi = (const float*)(p.ws + OFF_WI); u64* M64 = (u64*)(p.ws + OFF_MASK);
    unsigned cnt = 0u;
#pragma unroll 1
    for (;;) {
        const int t = wg_ticket(&g_bar[BAR_QSEL], 512u, slot); if (t < 0) break;
        const int b = t & 3, qblk = 127 - (t >> 2);
        sel::sel_unit(b, qblk, proj, ki, wi, M64, smem); cnt += 1u << (8 * b);
    }
    asm volatile("s_waitcnt vmcnt(0)" ::: "memory");
    __syncthreads();
    if (threadIdx.x == 0) { __builtin_amdgcn_fence(__ATOMIC_RELEASE, "agent"); asm volatile("s_waitcnt vmcnt(0)" ::: "memory");
#pragma unroll
        for (int b = 0; b < 4; ++b) { const unsigned c = (cnt >> (8 * b)) & 255u; if (c) __hip_atomic_fetch_add(&g_bar[BAR_SEL + 16 * b], c, __ATOMIC_RELAXED, __HIP_MEMORY_SCOPE_AGENT); } }
}
__device__ __forceinline__ int attn_next(int& k, const int kmax, volatile __attribute__((address_space(3))) unsigned* slot) {
    while (k < kmax) { const int q = ((int)blockIdx.x + k) & 7; const int t = wg_ticket(&g_bar[BAR_QATT + 16 * q], 128u, slot); if (t >= 0) return q * 128 + t; ++k; }
    return -1;
}
__device__ __forceinline__ void ph_attn(const Params& p, char* shm, const bool df, volatile __attribute__((address_space(3))) unsigned* slot) {
    const bf16_t* qa = (const bf16_t*)((unsigned char*)p.out + OUT_QA); const bf16_t* ka = (const bf16_t*)((unsigned char*)p.out + OUT_KA);
    const bf16_t* kva = (const bf16_t*)(p.ws + OFF_KVA); const bf16_t* proj = (const bf16_t*)(p.ws + OFF_PROJ); bf16_t* ao = (bf16_t*)(p.ws + OFF_AO); const float* rope = (const float*)(p.ws + OFF_ROPE);
    const u64* M64 = (const u64*)(p.ws + OFF_MASK);
    const int kmax = (gridDim.x % 8 == 0) ? 1 : 8; int k = 0;
    att::bf16x8 qpre[6];
    bool pre = false, p2ok = !df; unsigned selok = df ? 0u : 15u;
    int cur = attn_next(k, kmax, slot);
#pragma unroll 1
    while (cur >= 0) {
        const int nxt = attn_next(k, kmax, slot);
        const int ql = cur >> 7, i_ = cur & 127, type = i_ >> 6, qb = 15 - ((i_ & 63) >> 2), b = ql >> 1, kvh = ql & 1, h = 4 * kvh + (i_ & 3); const size_t r0 = (size_t)b * SEQ;
        const bf16_t* qn = nullptr; int pqn = 768, nd0n = 6;
        if (nxt >= 0) { const int qln = nxt >> 7, in_ = nxt & 127, qbn = 15 - ((in_ & 63) >> 2), bn = qln >> 1, hn = 4 * (qln & 1) + (in_ & 3); const size_t rn = (size_t)bn * SEQ + (size_t)qbn * 256;
            if ((in_ >> 6) == 0) { qn = qa + rn * 768 + hn * 96; pqn = 768; nd0n = 6; } else { qn = proj + rn * NP + C_QB + hn * 64; pqn = NP; nd0n = 4; } }
        if (!p2ok) { wg_wait(&g_bar[BAR_P2B], gridDim.x); p2ok = true; }
        if (type == 0) {
            att::attn_unit<96, 768, 768, 1024, 1024, NP, 0>(qb, qa + r0 * 768 + h * 96, ka + r0 * 768 + h * 96, kva + r0 * 1024 + h * 128 + 64,
                                                            ao + r0 * 1024 + h * 64, proj + r0 * NP + C_GA + h * 64, shm, nullptr, rope + r0 * 56, p.mla_q_gain,
                                                            qpre, pre, qn, pqn, nd0n);
        } else {
            if (!((selok >> b) & 1u)) { wg_wait(&g_bar[BAR_SEL + 16 * b], 128u); selok |= 1u << b; }
            att::attn_unit<64, NP, NP, NP, 1024, NP, 1>(qb, proj + r0 * NP + C_QB + h * 64, proj + r0 * NP + C_KB + kvh * 64, proj + r0 * NP + C_VB + kvh * 64,
                                                        ao + r0 * 1024 + 512 + h * 64, proj + r0 * NP + C_GB + h * 64, shm, M64 + (size_t)b * 128 * 128 * 16, rope + r0 * 56, p.dsa_q_gain,
                                                        qpre, pre, qn, pqn, nd0n);
        }
        pre = nxt >= 0; cur = nxt;
    }
}
__device__ __forceinline__ void ph5(const Params& p, PG8_LAS unsigned char* lds) {
    const bf16_t* ao = (const bf16_t*)(p.ws + OFF_AO); const bf16_t* wbr = (const bf16_t*)(p.ws + OFF_WBR);
    pg8::Gemm g{ao, wbr, NT, DM, DM, 1024, 1024}; pg8::StaticOrder S; S.init(NT, DM, gridDim.x, blockIdx.x);
    pg8::EpiGate2 E{(bf16_t*)(p.ws + OFF_MERGED), (const bf16_t*)(p.ws + OFF_PROJ), p.b_merge};
    pg8::gemm_phase<pg8::EpiGate2, pg8::StaticOrder, true, true>(lds, g, S, E);
}
__device__ __forceinline__ void ph6(const Params& p, PG8_LAS unsigned char* lds) {
    pg8::Gemm g{(const bf16_t*)(p.ws + OFF_MERGED), (const bf16_t*)(p.ws + OFF_WOUT), NT, DM, DM, DM, DM}; pg8::StaticOrder S; S.init(NT, DM, gridDim.x, blockIdx.x);
    pg8::EpiResid E{p.out, p.x};
    pg8::gemm_phase<pg8::EpiResid, pg8::StaticOrder, true, true>(lds, g, S, E);
}

__global__ void __launch_bounds__(NTHREADS, 2) fwd_kernel(Params p) {
    extern __shared__ __attribute__((aligned(16))) unsigned char smem[];
    PG8_LAS unsigned char* lds = (PG8_LAS unsigned char*)smem;
    volatile LAS unsigned* misc = (volatile LAS unsigned*)(lds + LDS_MISC);
    if (threadIdx.x < 2) misc[threadIdx.x] = 0u;
    __syncthreads();
    const XcdBarrier bar = xcd_barrier_post(g_bar, misc);
    ph0(p, smem); xcd_barrier(bar);
    const bool df = gridDim.x == 256;
    ph1(p, lds, df ? &g_bar[BAR_P1] : nullptr);
    { const int lw = df ? (int)blockIdx.x - 128 : (int)blockIdx.x; if (lw >= 0) late_weights(p, smem, lw, df ? 128 : (int)gridDim.x); }
    if (df) wg_wait(&g_bar[BAR_P1], gridDim.x); else xcd_barrier(bar);
    ph2b(p, lds, df); if (df) wg_signal(&g_bar[BAR_P2B], 1u);
    ph3_sel(p, smem, misc + 4);
    if (!df) xcd_barrier(bar);
    ph_attn(p, (char*)smem, df, misc + 4); xcd_barrier(bar);
    ph5(p, lds); xcd_barrier(bar);
    ph6(p, lds);
    __syncthreads();
    if (threadIdx.x == 0) { const unsigned d = __hip_atomic_fetch_add(&g_bar[BAR_DONE], 1u, __ATOMIC_RELAXED, __HIP_MEMORY_SCOPE_AGENT); misc[2] = (d + 1u == gridDim.x) ? 1u : 0u; }
    __syncthreads();
    if (misc[2] != 0u) for (int i = threadIdx.x; i < BAR_WORDS; i += NTHREADS) __hip_atomic_store(&g_bar[i], 0u, __ATOMIC_RELAXED, __HIP_MEMORY_SCOPE_AGENT);
}

extern "C" void kernel_launch(void* const* d_in, const int* in_sizes, int n_in, void* d_out, int out_size, void* d_ws, size_t ws_size, hipStream_t stream) {
    static int grid_blocks = 0;
    if (!grid_blocks) {
        int dev = 0, cus = 0, per_cu = 0;
        hipGetDevice(&dev);
        hipDeviceGetAttribute(&cus, hipDeviceAttributeMultiprocessorCount, dev);
        hipFuncSetAttribute((const void*)fwd_kernel, hipFuncAttributeMaxDynamicSharedMemorySize, LDS_BYTES);
        hipOccupancyMaxActiveBlocksPerMultiprocessor(&per_cu, (const void*)fwd_kernel, NTHREADS, LDS_BYTES);
        if (per_cu < 1) per_cu = 1;
        grid_blocks = cus * per_cu;
    }
    Params p{};
    p.x = (const float*)d_in[0]; p.pos = (const int*)d_in[1]; p.norm_gain = (const float*)d_in[2]; p.w_in = (const float*)d_in[3]; p.b_merge = (const float*)d_in[4];
    p.mla_q_norm = (const float*)d_in[5]; p.w_uq = (const float*)d_in[6]; p.mla_kv_norm = (const float*)d_in[7]; p.w_ukv = (const float*)d_in[8];
    p.mla_q_gain = (const float*)d_in[9]; p.mla_k_gain = (const float*)d_in[10]; p.dsa_q_gain = (const float*)d_in[11]; p.dsa_k_gain = (const float*)d_in[12];
    p.w_br_mla = (const float*)d_in[13]; p.w_br_dsa = (const float*)d_in[14]; p.w_out = (const float*)d_in[15];
    p.out = (float*)d_out; p.ws = (unsigned char*)d_ws;
    void* args[] = {&p};
    hipError_t e = hipLaunchCooperativeKernel((const void*)fwd_kernel, dim3(grid_blocks), dim3(NTHREADS), args, LDS_BYTES, stream);
    if (e != hipSuccess) fprintf(stderr, "cooperative launch failed: %s (grid %d)\n", hipGetErrorString(e), grid_blocks);
}
```

```cpp
#include <hip/hip_runtime.h>
#include <cstdio>

typedef unsigned short bf16_t;
typedef unsigned int u32;
typedef unsigned long long u64;

constexpr int NB = 4, SEQ = 4096, NT = NB * SEQ, DM = 1024, DIN = 4552, NP = 4608;
constexpr int C_CQ = 0, C_CKV = 256, C_KPE = 384, C_KI = 416, C_WI = 448, C_GA = 512, C_QB = 1024, C_KB = 1536, C_VB = 1664,
              C_GB = 1792, C_QI = 2304, C_MA = 2560, C_MB = 3584;
constexpr size_t MiB = 1u << 20;
constexpr size_t OFF_WIN = 0, OFF_WUQ = 9 * MiB, OFF_WUKV = 9 * MiB + 512 * 1024, OFF_WBR = 10 * MiB, OFF_WOUT = 12 * MiB,
                 OFF_ROPE = 14 * MiB, OFF_WI = 17 * MiB + 512 * 1024, OFF_H = 18 * MiB, OFF_AO = 18 * MiB, OFF_PROJ = 50 * MiB,
                 OFF_KVA = 206 * MiB, OFF_MERGED = 206 * MiB, OFF_MASK = 238 * MiB, OFF_KI = 246 * MiB;
constexpr int BAR_WORDS = 3776, BAR_DONE = 3520;
constexpr int BAR_QSEL = 3632, BAR_QATT = 3648;
constexpr int BAR_P1 = 3536, BAR_P2B = 3552, BAR_SEL = 3568;
__device__ unsigned g_bar[BAR_WORDS];
constexpr int LDS_MISC = 131072 + 512;
constexpr int LDS_XCH = 131072 + 1024;
constexpr size_t OUT_QA = 0, OUT_KA = 24 * MiB;
constexpr int LDS_BYTES = 147456;
constexpr int NTHREADS = 512;

struct Params {
    const float* x; const int* pos; const float* norm_gain; const float* w_in; const float* b_merge;
    const float* mla_q_norm; const float* w_uq; const float* mla_kv_norm; const float* w_ukv;
    const float* mla_q_gain; const float* mla_k_gain; const float* dsa_q_gain; const float* dsa_k_gain;
    const float* w_br_mla; const float* w_br_dsa; const float* w_out;
    float* out; unsigned char* ws;
};

__device__ const float c_inv_freq[28] = {
    1.000000000e+00f, 4.403665960e-01f, 1.939227432e-01f, 8.539710194e-02f, 3.760603070e-02f, 1.656044088e-02f, 7.292664610e-03f, 3.211446106e-03f,
    1.414213562e-03f, 6.227724371e-04f, 2.742481884e-04f, 1.207697351e-04f, 5.318295734e-05f, 2.341999971e-05f, 1.031338525e-05f, 4.541670478e-06f,
    1.000000000e+00f, 1.939227432e-01f, 3.760603070e-02f, 7.292664610e-03f, 1.414213562e-03f, 2.742481884e-04f, 5.318295734e-05f, 1.031338525e-05f,
    1.000000000e+00f, 3.760603070e-02f, 1.414213562e-03f, 5.318295734e-05f};

__device__ __forceinline__ void wg_signal(unsigned* ctr, unsigned inc) {
    asm volatile("s_waitcnt vmcnt(0)" ::: "memory");
    __syncthreads();
    if (threadIdx.x == 0) { __builtin_amdgcn_fence(__ATOMIC_RELEASE, "agent"); asm volatile("s_waitcnt vmcnt(0)" ::: "memory");
        __hip_atomic_fetch_add(ctr, inc, __ATOMIC_RELAXED, __HIP_MEMORY_SCOPE_AGENT); }
}
__device__ __forceinline__ void wg_wait(unsigned* ctr, unsigned target) {
    if (threadIdx.x == 0) { unsigned sp = 0u;
        while (__hip_atomic_load(ctr, __ATOMIC_RELAXED, __HIP_MEMORY_SCOPE_AGENT) < target) { __builtin_amdgcn_s_sleep(2); if (++sp > (1u << 24)) break; }
        __builtin_amdgcn_fence(__ATOMIC_ACQUIRE, "agent"); asm volatile("s_waitcnt vmcnt(0)" ::: "memory"); }
    __syncthreads();
}
__device__ __forceinline__ int wg_ticket(unsigned* ctr, unsigned limit, volatile __attribute__((address_space(3))) unsigned* slot) {
    __syncthreads();
    if (threadIdx.x == 0) *slot = __hip_atomic_fetch_add(ctr, 1u, __ATOMIC_RELAXED, __HIP_MEMORY_SCOPE_AGENT);
    __syncthreads();
    const unsigned v = (unsigned)__builtin_amdgcn_readfirstlane((int)*slot);
    return v < limit ? (int)v : -1;
}
__device__ __forceinline__ int opaque_tid() { int t = threadIdx.x; asm volatile("" : "+v"(t)); return t; }
__device__ __forceinline__ float bf2f(bf16_t v) { return __uint_as_float(((u32)v) << 16); }
__device__ __forceinline__ bf16_t f2bf(float f) { u32 u = __float_as_uint(f); return (bf16_t)((u + 0x7fffu + ((u >> 16) & 1u)) >> 16); }
__device__ __forceinline__ float wave_sum(float v) {
#pragma unroll
    for (int o = 1; o < 64; o <<= 1) v += __shfl_xor(v, o);
    return v;
}
__device__ __forceinline__ float wave_max(float v) {
#pragma unroll
    for (int o = 1; o < 64; o <<= 1) v = fmaxf(v, __shfl_xor(v, o));
    return v;
}
__device__ __forceinline__ int oldcol(int n) {
    if (n < 416) return n;
    if (n < 448) return 2464 + (n - 416);
    if (n < 456) return 2496 + (n - 448);
    if (n < 512) return -1;
    if (n < 1024) return 416 + (n - 512);
    if (n < 1536) return 928 + (n - 1024);
    if (n < 1664) return 1440 + (n - 1536);
    if (n < 1792) return 1568 + (n - 1664);
    if (n < 2304) return 1696 + (n - 1792);
    if (n < 2560) return 2208 + (n - 2304);
    if (n < 3584) return 2504 + (n - 2560);
    return 3528 + (n - 3584);
}
__device__ __forceinline__ void sincos_d(double x, double& s, double& c) {
    const double two_over_pi = 0.63661977236758134308, pio2_hi = 1.57079632679489655800e+00, pio2_lo = 6.12323399573676603587e-17;
    const double q = rint(x * two_over_pi);
    double r = fma(-q, pio2_hi, x); r = fma(-q, pio2_lo, r);
    const double r2 = r * r;
    double sp = 1.0 / 1307674368000.0;
    sp = fma(sp, r2, -1.0 / 6227020800.0);
    sp = fma(sp, r2, 1.0 / 39916800.0);
    sp = fma(sp, r2, -1.0 / 362880.0);
    sp = fma(sp, r2, 1.0 / 5040.0);
    sp = fma(sp, r2, -1.0 / 120.0);
    sp = fma(sp, r2, 1.0 / 6.0);
    sp = fma(sp, -r2, 1.0);
    const double sr = sp * r;
    double cp = 1.0 / 20922789888000.0;
    cp = fma(cp, r2, -1.0 / 87178291200.0);
    cp = fma(cp, r2, 1.0 / 479001600.0);
    cp = fma(cp, r2, -1.0 / 3628800.0);
    cp = fma(cp, r2, 1.0 / 40320.0);
    cp = fma(cp, r2, -1.0 / 720.0);
    cp = fma(cp, r2, 1.0 / 24.0);
    cp = fma(cp, r2, -0.5);
    const double cr = fma(cp, r2, 1.0);
    const int n = ((int)q) & 3;
    s = (n == 0) ? sr : (n == 1) ? cr : (n == 2) ? -sr : -cr;
    c = (n == 0) ? cr : (n == 1) ? -sr : (n == 2) ? -cr : sr;
}

__device__ __forceinline__ void unpack8(const uint4 w, float (&f)[8]) {
    f[0] = __uint_as_float(w.x << 16); f[1] = __uint_as_float(w.x & 0xffff0000u);
    f[2] = __uint_as_float(w.y << 16); f[3] = __uint_as_float(w.y & 0xffff0000u);
    f[4] = __uint_as_float(w.z << 16); f[5] = __uint_as_float(w.z & 0xffff0000u);
    f[6] = __uint_as_float(w.w << 16); f[7] = __uint_as_float(w.w & 0xffff0000u);
}

namespace pg8 {
#define PG8_LAS __attribute__((address_space(3)))
typedef unsigned short bf16_t;
typedef short bf16x8 __attribute__((ext_vector_type(8)));
typedef float f32x4 __attribute__((ext_vector_type(4)));
typedef unsigned u32x4 __attribute__((ext_vector_type(4)));
constexpr int BM = 256, BK = 64, HALF = 128, HTB = HALF * BK * 2  , STAGE_BYTES = 8 * HTB, NXCD = 8, WGM = 8;

__host__ __device__ __forceinline__ int lds_byte(int r, int c) { const int st = (r >> 4) * 2 + (c >> 5), rr = r & 15, cc = c & 31, ob = rr * 64 + cc * 2; return st * 1024 + (ob ^ (((ob >> 9) & 1) << 5)); }
__host__ __device__ __forceinline__ void stage_rc(int b, int& R, int& C) { const int st = b / 1024, sb = b % 1024, swz = sb ^ (((sb >> 9) & 1) << 5); R = (st >> 1) * 16 + swz / 64; C = (st & 1) * 32 + (swz % 64) / 2; }
__host__ __device__ __forceinline__ int perm32(int rho) { const int n = rho >> 4, i = rho & 15; return 8 * (i >> 2) + 4 * n + (i & 3); }

struct Unit { int pm, pn; };
struct Gemm { const bf16_t* A; const bf16_t* Bt; int M, N, K, lda, ldb; };

struct StaticOrder {
    int nM, nN, nwg, G, c;
    __host__ __device__ void init(int M, int N, int G_, int c_) { nM = M / BM; nN = N / BM; nwg = nM * nN; G = G_; c = c_; }
    __host__ __device__ bool next(int i, Unit& u) const {
        const long L = (long)i * G + c; if (L >= nwg) return false;
        int wgid = (int)L; { const int q = nwg / NXCD, r = nwg % NXCD, xcd = wgid % NXCD, off = wgid / NXCD; wgid = (xcd < r ? xcd * (q + 1) : r * (q + 1) + (xcd - r) * q) + off; }
        const int nig = WGM * nN, gid = wgid / nig, fm = gid * WGM, gsz = (nM - fm) < WGM ? (nM - fm) : WGM;
        u.pm = fm + ((wgid % nig) % gsz); u.pn = (wgid % nig) / gsz; return true;
    }
    __device__ __forceinline__ void a_ready(const Unit&) const {}
    __device__ __forceinline__ void done(const Unit&) const {}
};
struct ProjOrder : StaticOrder {
    unsigned* ctr;
    __device__ __forceinline__ void done(const Unit& u) const { if (ctr && u.pn >= 8 && u.pn < 12) wg_signal(ctr, 1u); }
};
struct ListOrder {
    int nM, nN, G, c, id0, id1;
    __host__ __device__ bool next(int i, Unit& u) const {
        int L; if (G > 0) { L = i * G + c; if (L >= nM * nN) return false; } else { L = i == 0 ? id0 : (i == 1 ? id1 : -1); if (L < 0) return false; }
        u.pm = L / nN; u.pn = L % nN; return true;
    }
    __device__ __forceinline__ void a_ready(const Unit&) const {}
    __device__ __forceinline__ void done(const Unit&) const {}
};


__device__ __forceinline__ unsigned cvt_pk_bf16(float lo, float hi) { unsigned r; asm volatile("v_cvt_pk_bf16_f32 %0, %1, %2" : "=v"(r) : "v"(lo), "v"(hi)); return r; }
struct EpiBf16 {
    static constexpr bool PERM = true, AFTER_DRAIN = false, MID = false;
    bf16_t* O; int ldc;
    __device__ __forceinline__ void operator()(const f32x4 (&acc)[2][2][4][2], const Unit& u, int wr, int wc, int fr, int fq) const {
        const int row0 = u.pm * BM + wr * 64 + fr, col0 = u.pn * BM + wc * 32 + 8 * fq;
#pragma unroll
        for (int ai = 0; ai < 2; ++ai)
#pragma unroll
            for (int m = 0; m < 4; ++m) { bf16_t* rowp = O + (size_t)(row0 + ai * HALF + m * 16) * ldc + col0;
#pragma unroll
                for (int bj = 0; bj < 2; ++bj) { const f32x4 v0 = acc[ai][bj][m][0], v1 = acc[ai][bj][m][1];
                    u32x4 w; w.x = cvt_pk_bf16(v0[0], v0[1]); w.y = cvt_pk_bf16(v0[2], v0[3]); w.z = cvt_pk_bf16(v1[0], v1[1]); w.w = cvt_pk_bf16(v1[2], v1[3]);
                    *(u32x4*)(rowp + bj * HALF) = w; } }
    }
};
struct EpiProj {
    static constexpr bool PERM = true, AFTER_DRAIN = false, MID = false;
    bf16_t* proj; bf16_t* kic; float* wi; const float* rope; const float* gq; const float* gkv; const float* gkb; PG8_LAS float* xch;
    __device__ __forceinline__ static void st8v(bf16_t* p, const f32x4 a, const f32x4 b) {
        u32x4 w; w.x = cvt_pk_bf16(a[0], a[1]); w.y = cvt_pk_bf16(a[2], a[3]); w.z = cvt_pk_bf16(b[0], b[1]); w.w = cvt_pk_bf16(b[2], b[3]); *(u32x4*)p = w; }
    __device__ __forceinline__ void operator()(const f32x4 (&acc)[2][2][4][2], const Unit& u, int wr, int wc, int fr, int fq) const {
        const int pn = u.pn; const int rowb = u.pm * BM + wr * 64 + fr;
        const bool normt = (pn == 0) | (pn == 1) | (pn == 6);
        if (normt) {
#pragma unroll
            for (int ai = 0; ai < 2; ++ai)
#pragma unroll
                for (int m = 0; m < 4; ++m) {
                    float s = 0.f;
#pragma unroll
                    for (int n = 0; n < 2; ++n)
#pragma unroll
                        for (int j = 0; j < 4; ++j) { s = __builtin_fmaf(acc[ai][0][m][n][j], acc[ai][0][m][n][j], s); if (pn == 0) s = __builtin_fmaf(acc[ai][1][m][n][j], acc[ai][1][m][n][j], s); }
                    s += __shfl_xor(s, 16); s += __shfl_xor(s, 32);
                    if (fq == 0) xch[(ai * HALF + wr * 64 + m * 16 + fr) * 4 + wc] = s;
                }
            asm volatile("s_waitcnt lgkmcnt(0)" ::: "memory"); __builtin_amdgcn_s_barrier(); asm volatile("" ::: "memory");
        }
#pragma unroll
        for (int ai = 0; ai < 2; ++ai)
#pragma unroll
            for (int m = 0; m < 4; ++m) {
                const int rl = ai * HALF + wr * 64 + m * 16 + fr; const size_t row = (size_t)(rowb + ai * HALF + m * 16);
                bf16_t* prow = proj + row * NP; const float* cs = rope + row * 56;
                f32x4 a0 = acc[ai][0][m][0], a1 = acc[ai][0][m][1], b0 = acc[ai][1][m][0], b1 = acc[ai][1][m][1];
                const int c = wc * 32 + 8 * fq;
                if (pn == 0) {
                    const f32x4 pp = *(const PG8_LAS f32x4*)(xch + rl * 4); const float r = rsqrtf(((pp[0] + pp[1]) + (pp[2] + pp[3])) * (1.f / 256.f) + 1e-6f);
                    const f32x4 g0 = *(const f32x4*)(gq + c), g1 = *(const f32x4*)(gq + c + 4), g2 = *(const f32x4*)(gq + 128 + c), g3 = *(const f32x4*)(gq + 128 + c + 4);
                    st8v(prow + C_CQ + c, a0 * r * g0, a1 * r * g1); st8v(prow + C_CQ + 128 + c, b0 * r * g2, b1 * r * g3);
                } else if (pn == 1) {
                    const f32x4 pp = *(const PG8_LAS f32x4*)(xch + rl * 4); const float r = rsqrtf(((pp[0] + pp[1]) + (pp[2] + pp[3])) * (1.f / 128.f) + 1e-6f);
                    const f32x4 g0 = *(const f32x4*)(gkv + c), g1 = *(const f32x4*)(gkv + c + 4);
                    st8v(prow + C_CKV + c, a0 * r * g0, a1 * r * g1);
                    if (wc == 0) st8v(prow + C_KPE + 8 * fq, b0, b1);
                    else if (wc == 1) {
                        if (fq == 0) { const f32x4 c0 = *(const f32x4*)(cs + 48), c1 = *(const f32x4*)(cs + 52);
                            const f32x4 x1 = b0, x2 = b1;
                            b0[0] = x1[0] * c0[0] - x2[0] * c0[1]; b1[0] = x2[0] * c0[0] + x1[0] * c0[1]; b0[1] = x1[1] * c0[2] - x2[1] * c0[3]; b1[1] = x2[1] * c0[2] + x1[1] * c0[3];
                            b0[2] = x1[2] * c1[0] - x2[2] * c1[1]; b1[2] = x2[2] * c1[0] + x1[2] * c1[1]; b0[3] = x1[3] * c1[2] - x2[3] * c1[3]; b1[3] = x2[3] * c1[2] + x1[3] * c1[3]; }
                        st8v(kic + row * 32 + 8 * fq, b0, b1);
                    } else if (wc == 2 && fq == 0) { *(f32x4*)(wi + row * 8) = b0 * 0.0625f; *(f32x4*)(wi + row * 8 + 4) = b1 * 0.0625f; }
                } else if (pn == 6) {
                    const f32x4 pp = *(const PG8_LAS f32x4*)(xch + rl * 4); const float tot = (wc & 2) ? (pp[2] + pp[3]) : (pp[0] + pp[1]); const float r = rsqrtf(tot * (1.f / 64.f) + 1e-6f);
                    const int d = (wc & 1) * 32 + 8 * fq;
                    const f32x4 g0 = *(const f32x4*)(gkb + d), g1 = *(const f32x4*)(gkb + d + 4);
                    a0 = a0 * r * g0; a1 = a1 * r * g1;
                    {
                        f32x4 p0, p1;
#pragma unroll
                        for (int j = 0; j < 4; ++j) { p0[j] = __shfl_xor(a0[j], 16); p1[j] = __shfl_xor(a1[j], 16); }
                        if ((wc & 1) == 0 && fq < 2) {
                            const f32x4 c0 = *(const f32x4*)(cs + 32), c1 = *(const f32x4*)(cs + 36), c2 = *(const f32x4*)(cs + 40), c3 = *(const f32x4*)(cs + 44);
                            const float sg = fq == 0 ? -1.f : 1.f;
                            a0[0] = a0[0] * c0[0] + sg * p0[0] * c0[1]; a0[1] = a0[1] * c0[2] + sg * p0[1] * c0[3]; a0[2] = a0[2] * c1[0] + sg * p0[2] * c1[1]; a0[3] = a0[3] * c1[2] + sg * p0[3] * c1[3];
                            a1[0] = a1[0] * c2[0] + sg * p1[0] * c2[1]; a1[1] = a1[1] * c2[2] + sg * p1[1] * c2[3]; a1[2] = a1[2] * c3[0] + sg * p1[2] * c3[1]; a1[3] = a1[3] * c3[2] + sg * p1[3] * c3[3];
                        }
                    }
                    st8v(prow + C_KB + (wc >> 1) * 64 + d, a0, a1);
                    st8v(prow + C_VB + c, b0, b1);
                } else if (pn == 9) {
                    if (fq == 0) { const f32x4 c0 = *(const f32x4*)(cs + 48), c1 = *(const f32x4*)(cs + 52);
#pragma unroll
                        for (int hb = 0; hb < 2; ++hb) { f32x4& x1r = hb ? b0 : a0; f32x4& x2r = hb ? b1 : a1; const f32x4 x1 = x1r, x2 = x2r;
                            x1r[0] = x1[0] * c0[0] - x2[0] * c0[1]; x2r[0] = x2[0] * c0[0] + x1[0] * c0[1]; x1r[1] = x1[1] * c0[2] - x2[1] * c0[3]; x2r[1] = x2[1] * c0[2] + x1[1] * c0[3];
                            x1r[2] = x1[2] * c1[0] - x2[2] * c1[1]; x2r[2] = x2[2] * c1[0] + x1[2] * c1[1]; x1r[3] = x1[3] * c1[2] - x2[3] * c1[3]; x2r[3] = x2[3] * c1[2] + x1[3] * c1[3]; } }
                    st8v(prow + C_QI + c, a0, a1); st8v(prow + C_QI + 128 + c, b0, b1);
                } else {
                    st8v(prow + pn * 256 + c, a0, a1); st8v(prow + pn * 256 + 128 + c, b0, b1);
                }
            }
    }
};
struct EpiKV {
    static constexpr bool PERM = true, AFTER_DRAIN = false, MID = false;
    bf16_t* ka; bf16_t* kva; const bf16_t* proj; const float* rope; const float* gk; PG8_LAS float* xch;
    __device__ __forceinline__ void operator()(const f32x4 (&acc)[2][2][4][2], const Unit& u, int wr, int wc, int fr, int fq) const {
        const int pn = u.pn; const int rowb = u.pm * BM + wr * 64 + fr;
#pragma unroll
        for (int ai = 0; ai < 2; ++ai)
#pragma unroll
            for (int m = 0; m < 4; ++m) {
                const int rl = ai * HALF + wr * 64 + m * 16 + fr; const size_t row = (size_t)(rowb + ai * HALF + m * 16);
                if (wc < 2) {
#pragma unroll
                    for (int bj = 0; bj < 2; ++bj) { float s = 0.f;
#pragma unroll
                        for (int n = 0; n < 2; ++n)
#pragma unroll
                            for (int j = 0; j < 4; ++j) s = __builtin_fmaf(acc[ai][bj][m][n][j], acc[ai][bj][m][n][j], s);
                        s += __shfl_xor(s, 16); s += __shfl_xor(s, 32);
                        if (fq == 0) xch[(rl * 2 + bj) * 4 + wc] = s; }
                } else if (wc == 2) {
                    const u32x4 w = *(const u32x4*)(proj + row * NP + C_KPE + 8 * fq);
                    const f32x4 q0 = (f32x4){__uint_as_float(w.x << 16), __uint_as_float(w.x & 0xffff0000u), __uint_as_float(w.y << 16), __uint_as_float(w.y & 0xffff0000u)};
                    const f32x4 q1 = (f32x4){__uint_as_float(w.z << 16), __uint_as_float(w.z & 0xffff0000u), __uint_as_float(w.w << 16), __uint_as_float(w.w & 0xffff0000u)};
                    float s = 0.f;
#pragma unroll
                    for (int j = 0; j < 4; ++j) { s = __builtin_fmaf(q0[j], q0[j], s); s = __builtin_fmaf(q1[j], q1[j], s); }
                    s += __shfl_xor(s, 16); s += __shfl_xor(s, 32);
                    if (fq == 0) { xch[(rl * 2 + 0) * 4 + 2] = s; xch[(rl * 2 + 1) * 4 + 2] = s; }
                }
            }
        asm volatile("s_waitcnt lgkmcnt(0)" ::: "memory"); __builtin_amdgcn_s_barrier(); asm volatile("" ::: "memory");
#pragma unroll
        for (int ai = 0; ai < 2; ++ai)
#pragma unroll
            for (int m = 0; m < 4; ++m) {
                const int rl = ai * HALF + wr * 64 + m * 16 + fr; const size_t row = (size_t)(rowb + ai * HALF + m * 16);
                f32x4 pe0 = {0.f, 0.f, 0.f, 0.f}, pe1 = {0.f, 0.f, 0.f, 0.f};
                if (wc == 2) {
                    const u32x4 w = *(const u32x4*)(proj + row * NP + C_KPE + 8 * fq);
                    pe0 = (f32x4){__uint_as_float(w.x << 16), __uint_as_float(w.x & 0xffff0000u), __uint_as_float(w.y << 16), __uint_as_float(w.y & 0xffff0000u)};
                    pe1 = (f32x4){__uint_as_float(w.z << 16), __uint_as_float(w.z & 0xffff0000u), __uint_as_float(w.w << 16), __uint_as_float(w.w & 0xffff0000u)};
                }
#pragma unroll
                for (int bj = 0; bj < 2; ++bj) {
                    const int h = 2 * pn + bj;
                    const f32x4 a0 = acc[ai][bj][m][0], a1 = acc[ai][bj][m][1];
                    if (wc >= 2) EpiProj::st8v(kva + row * 1024 + h * 128 + 64 + (wc - 2) * 32 + 8 * fq, a0, a1);
                    if (wc <= 2) {
                        const f32x4 pp = *(const PG8_LAS f32x4*)(xch + (rl * 2 + bj) * 4); const float r = rsqrtf((pp[0] + pp[1] + pp[2]) * (1.f / 96.f) + 1e-6f);
                        if (wc < 2) { const int d = wc * 32 + 8 * fq; const f32x4 g0 = *(const f32x4*)(gk + d), g1 = *(const f32x4*)(gk + d + 4);
                            EpiProj::st8v(ka + row * 768 + h * 96 + d, a0 * r * g0, a1 * r * g1);
                        } else {
                            const int d = 64 + 8 * fq; const f32x4 g0 = *(const f32x4*)(gk + d), g1 = *(const f32x4*)(gk + d + 4);
                            f32x4 y0 = pe0 * r * g0, y1 = pe1 * r * g1, p0, p1;
#pragma unroll
                            for (int j = 0; j < 4; ++j) { p0[j] = __shfl_xor(y0[j], 32); p1[j] = __shfl_xor(y1[j], 32); }
                            const float* cs = rope + row * 56 + (fq & 1) * 16;
                            const f32x4 c0 = *(const f32x4*)(cs), c1 = *(const f32x4*)(cs + 4), c2 = *(const f32x4*)(cs + 8), c3 = *(const f32x4*)(cs + 12);
                            const float sg = fq < 2 ? -1.f : 1.f;
                            y0[0] = y0[0] * c0[0] + sg * p0[0] * c0[1]; y0[1] = y0[1] * c0[2] + sg * p0[1] * c0[3]; y0[2] = y0[2] * c1[0] + sg * p0[2] * c1[1]; y0[3] = y0[3] * c1[2] + sg * p0[3] * c1[3];
                            y1[0] = y1[0] * c2[0] + sg * p1[0] * c2[1]; y1[1] = y1[1] * c2[2] + sg * p1[1] * c2[3]; y1[2] = y1[2] * c3[0] + sg * p1[2] * c3[1]; y1[3] = y1[3] * c3[2] + sg * p1[3] * c3[3];
                            EpiProj::st8v(ka + row * 768 + h * 96 + d, y0, y1);
                        }
                    }
                }
            }
    }
};
__device__ __forceinline__ float expneg_c(float v) { return __expf(-__builtin_fminf(__builtin_fmaxf(v, -80.f), 80.f)); }
struct EpiGate2 {
    static constexpr bool PERM = true, AFTER_DRAIN = false, MID = true;
    bf16_t* O; const bf16_t* proj; const float* bias;
    __device__ __forceinline__ void mid(f32x4 (&acc)[2][2][4][2], const Unit& u, int wr, int wc, int fr, int fq) const {
        int row0 = u.pm * BM + wr * 64 + fr, col0 = u.pn * BM + wc * 32 + 8 * fq;
        asm volatile("" : "+v"(row0), "+v"(col0));
#pragma unroll
        for (int bj = 0; bj < 2; ++bj) { const int col = col0 + bj * HALF;
            f32x4 ba[2], bb[2];
#pragma unroll
            for (int n = 0; n < 2; ++n) { ba[n] = *(const f32x4*)(bias + col + 4 * n); bb[n] = *(const f32x4*)(bias + 1024 + col + 4 * n); }
#pragma unroll
            for (int ai = 0; ai < 2; ++ai) {
                u32x4 wa[4], wb[4];
#pragma unroll
                for (int m = 0; m < 4; ++m) { const size_t row = (size_t)(row0 + ai * HALF + m * 16); wa[m] = *(const u32x4*)(proj + row * NP + C_MA + col); wb[m] = *(const u32x4*)(proj + row * NP + C_MB + col); }
#pragma unroll
                for (int m = 0; m < 4; ++m) {
#pragma unroll
                    for (int e = 0; e < 4; ++e) {
                        const float ea0 = expneg_c(__uint_as_float(wa[m][e] << 16) + ba[e >> 1][(2 * e) & 3]), ea1 = expneg_c(__uint_as_float(wa[m][e] & 0xffff0000u) + ba[e >> 1][(2 * e + 1) & 3]);
                        const float eb0 = expneg_c(__uint_as_float(wb[m][e] << 16) + bb[e >> 1][(2 * e) & 3]), eb1 = expneg_c(__uint_as_float(wb[m][e] & 0xffff0000u) + bb[e >> 1][(2 * e + 1) & 3]);
                        acc[ai][bj][m][e >> 1][(2 * e) & 3] *= (1.f + eb0) * __builtin_amdgcn_rcpf(1.f + ea0);
                        acc[ai][bj][m][e >> 1][(2 * e + 1) & 3] *= (1.f + eb1) * __builtin_amdgcn_rcpf(1.f + ea1);
                    } }
                asm volatile("" ::: "memory"); }
        }
    }
    __device__ __forceinline__ void operator()(const f32x4 (&acc)[2][2][4][2], const Unit& u, int wr, int wc, int fr, int fq) const {
        const int row0 = u.pm * BM + wr * 64 + fr, col0 = u.pn * BM + wc * 32 + 8 * fq;
#pragma unroll
        for (int bj = 0; bj < 2; ++bj) { const int col = col0 + bj * HALF;
            f32x4 bb[2];
#pragma unroll
            for (int n = 0; n < 2; ++n) bb[n] = *(const f32x4*)(bias + 1024 + col + 4 * n);
            u32x4 wbq[8];
#pragma unroll
            for (int q = 0; q < 8; ++q) { const size_t row = (size_t)(row0 + (q >> 2) * HALF + (q & 3) * 16); wbq[q] = *(const u32x4*)(proj + row * NP + C_MB + col); }
#pragma unroll
            for (int q = 0; q < 8; ++q) { const size_t row = (size_t)(row0 + (q >> 2) * HALF + (q & 3) * 16); const u32x4 wb = wbq[q]; u32x4 w;
#pragma unroll
                    for (int e = 0; e < 4; ++e) {
                        const float g0 = __builtin_amdgcn_rcpf(1.f + expneg_c(__uint_as_float(wb[e] << 16) + bb[e >> 1][(2 * e) & 3])), g1 = __builtin_amdgcn_rcpf(1.f + expneg_c(__uint_as_float(wb[e] & 0xffff0000u) + bb[e >> 1][(2 * e + 1) & 3]));
                        w[e] = cvt_pk_bf16(acc[q >> 2][bj][q & 3][e >> 1][(2 * e) & 3] * g0, acc[q >> 2][bj][q & 3][e >> 1][(2 * e + 1) & 3] * g1);
                    }
                    *(u32x4*)(O + row * 1024 + col) = w; }
        }
    }
};
struct EpiResid {
    static constexpr bool PERM = true, AFTER_DRAIN = false, MID = false;
    float* out; const float* x;
    __device__ __forceinline__ void operator()(const f32x4 (&acc)[2][2][4][2], const Unit& u, int wr, int wc, int fr, int fq) const {
        const int row0 = u.pm * BM + wr * 64 + fr, col0 = u.pn * BM + wc * 32 + 8 * fq;
#pragma unroll
        for (int ai = 0; ai < 2; ++ai)
#pragma unroll
            for (int m = 0; m < 4; ++m) { const size_t row = (size_t)(row0 + ai * HALF + m * 16);
#pragma unroll
                for (int bj = 0; bj < 2; ++bj) { const size_t o = row * 1024 + col0 + bj * HALF;
                    *(f32x4*)(out + o) = *(const f32x4*)(x + o) + acc[ai][bj][m][0];
                    *(f32x4*)(out + o + 4) = *(const f32x4*)(x + o + 4) + acc[ai][bj][m][1]; } }
    }
};

template <class Epi, class Sched, bool ALIGN_EPI = false, bool SP2 = false>
__device__ __forceinline__ void gemm_phase(PG8_LAS unsigned char* lds, const Gemm g, const Sched& S, const Epi& E) {
    const int tid = opaque_tid(), wid = __builtin_amdgcn_readfirstlane(tid >> 6), lane = tid & 63, wr = wid >> 2, wc = wid & 3, fr = lane & 15, fq = lane >> 4;
    int K = g.K; asm volatile("" : "+s"(K));
    const int nt = K / BK;
    unsigned voffA[2], voffB[2];
#pragma unroll
    for (int i = 0; i < 2; ++i) { int R, C; stage_rc(tid * 16 + i * 8192, R, C); const int Rb = Epi::PERM ? ((R & ~31) + perm32(R & 31)) : R;
        voffA[i] = (unsigned)(R * g.lda + C) * 2u; voffB[i] = (unsigned)(Rb * g.ldb + C) * 2u; }
    const size_t kstep = (size_t)(BK * 2);
    const size_t hstepA = (size_t)HALF * g.lda * 2, hstepB = (size_t)HALF * g.ldb * 2;
    const size_t tstepA = 2 * hstepA, tstepB = 2 * hstepB;
    const unsigned ldsw = (unsigned)wid * 1024u;
    const int aoff = lds_byte(wr * 64 + fr, fq * 8), boff = lds_byte(wc * 32 + fr, fq * 8);
#define PG8_SA(b, h) (((b) * 2 + (h)) * HTB)
#define PG8_SB(b, h) ((4 + (b) * 2 + (h)) * HTB)
#define PG8_STAGE(bufoff, gbase, voff) do { _Pragma("unroll") for (int _i = 0; _i < 2; ++_i) \
        __builtin_amdgcn_global_load_lds((const unsigned*)((const char*)(gbase) + (voff)[_i]), (PG8_LAS unsigned*)(lds + (bufoff) + ldsw + _i * 8192), 16, 0, 0); } while (0)
#define PG8_LDA(dst, b, h) do { _Pragma("unroll") for (int m = 0; m < 4; ++m) _Pragma("unroll") for (int k = 0; k < 2; ++k) dst[m][k] = *(const PG8_LAS bf16x8*)(lds + PG8_SA(b, h) + aoff + m * 2048 + k * 1024); } while (0)
#define PG8_LDB(dst, b, h) do { _Pragma("unroll") for (int n = 0; n < 2; ++n) _Pragma("unroll") for (int k = 0; k < 2; ++k) dst[n][k] = *(const PG8_LAS bf16x8*)(lds + PG8_SB(b, h) + boff + n * 2048 + k * 1024); } while (0)
#define PG8_MMA(ai, bj, At, Bt) do { __builtin_amdgcn_s_setprio(1); _Pragma("unroll") for (int m = 0; m < 4; ++m) _Pragma("unroll") for (int n = 0; n < 2; ++n) _Pragma("unroll") for (int k = 0; k < 2; ++k) \
        acc[ai][bj][m][n] = __builtin_amdgcn_mfma_f32_16x16x32_bf16(Bt[n][k], At[m][k], acc[ai][bj][m][n], 0, 0, 0); __builtin_amdgcn_s_setprio(0); } while (0)
#define PG8_WAIT_V(n) asm volatile("s_waitcnt vmcnt(" #n ")" ::: "memory")
#define PG8_WAIT_L(n) asm volatile("s_waitcnt lgkmcnt(" #n ")" ::: "memory")
#define PG8_BAR __builtin_amdgcn_s_barrier()
#define PG8_SCHED __builtin_amdgcn_sched_barrier(0)
    Unit cur, nxt; int ui = 0;
    if (!S.next(0, cur)) return;
    f32x4 acc[2][2][4][2];
#pragma unroll
    for (int a = 0; a < 2; ++a)
#pragma unroll
        for (int b = 0; b < 2; ++b)
#pragma unroll
            for (int m = 0; m < 4; ++m)
#pragma unroll
                for (int n = 0; n < 2; ++n) acc[a][b][m][n] = (f32x4){0.f, 0.f, 0.f, 0.f};
    bf16x8 At[4][2], B0[2][2], B1[2][2];
    const char* cA = (const char*)g.A + (size_t)cur.pm * tstepA; const char* cB = (const char*)g.Bt + (size_t)cur.pn * tstepB;
    S.a_ready(cur);
    if constexpr (SP2) {
        PG8_STAGE(PG8_SB(0, 0), cB, voffB); PG8_STAGE(PG8_SB(0, 1), cB + hstepB, voffB); PG8_STAGE(PG8_SA(0, 0), cA, voffA); PG8_STAGE(PG8_SA(0, 1), cA + hstepA, voffA);
        if (wr == 1) PG8_BAR;
        PG8_WAIT_V(2); PG8_BAR;
        PG8_STAGE(PG8_SB(1, 0), cB + kstep, voffB); PG8_STAGE(PG8_SA(1, 0), cA + kstep, voffA); PG8_STAGE(PG8_SB(1, 1), cB + hstepB + kstep, voffB);
        PG8_WAIT_V(6); PG8_BAR;
    } else {
        PG8_STAGE(PG8_SB(0, 0), cB, voffB); PG8_STAGE(PG8_SA(0, 0), cA, voffA); PG8_STAGE(PG8_SB(0, 1), cB + hstepB, voffB); PG8_STAGE(PG8_SA(0, 1), cA + hstepA, voffA);
        if (wr == 1) PG8_BAR;
        PG8_WAIT_V(4); PG8_BAR;
        PG8_STAGE(PG8_SB(1, 0), cB + kstep, voffB); PG8_STAGE(PG8_SA(1, 0), cA + kstep, voffA); PG8_STAGE(PG8_SB(1, 1), cB + hstepB + kstep, voffB);
        PG8_WAIT_V(6); PG8_BAR;
    }
    for (;;) {
        const bool has_next = S.next(ui + 1, nxt);
        const char* nA = has_next ? (const char*)g.A + (size_t)nxt.pm * tstepA : cA; const char* nB = has_next ? (const char*)g.Bt + (size_t)nxt.pn * tstepB : cB;
        for (int t = 0; t < nt; t += 2) {
            if constexpr (Epi::MID) { if (t == (nt >> 1)) E.mid(acc, cur, wr, wc, fr, fq); }
            const bool last = (t == nt - 2);
            const char* a1 = cA + (size_t)(t + 1) * kstep;
            const char* a2 = last ? nA : cA + (size_t)(t + 2) * kstep; const char* b2 = last ? nB : cB + (size_t)(t + 2) * kstep;
            const char* a3 = a2 + kstep; const char* b3 = b2 + kstep;
            if (last && has_next) S.a_ready(nxt);
            if constexpr (SP2) {
            PG8_LDB(B0, 0, 0); PG8_LDB(B1, 0, 1); PG8_SCHED; PG8_LDA(At, 0, 0); PG8_STAGE(PG8_SA(1, 1), a1 + hstepA, voffA);
            PG8_WAIT_V(8); PG8_WAIT_L(0); PG8_BAR; PG8_MMA(0, 0, At, B0); PG8_MMA(0, 1, At, B1); PG8_BAR; PG8_SCHED;
            PG8_LDA(At, 0, 1); PG8_STAGE(PG8_SB(0, 0), b2, voffB); PG8_STAGE(PG8_SB(0, 1), b2 + hstepB, voffB); PG8_STAGE(PG8_SA(0, 0), a2, voffA);
            PG8_WAIT_V(8); PG8_WAIT_L(0); PG8_BAR; PG8_MMA(1, 0, At, B0); PG8_MMA(1, 1, At, B1); PG8_BAR; PG8_SCHED;
            PG8_LDB(B0, 1, 0); PG8_LDB(B1, 1, 1); PG8_SCHED; PG8_LDA(At, 1, 0); PG8_STAGE(PG8_SA(0, 1), a2 + hstepA, voffA);
            PG8_WAIT_V(8); PG8_WAIT_L(0); PG8_BAR; PG8_MMA(0, 0, At, B0); PG8_MMA(0, 1, At, B1); PG8_BAR; PG8_SCHED;
            PG8_LDA(At, 1, 1); PG8_STAGE(PG8_SB(1, 0), b3, voffB); PG8_STAGE(PG8_SB(1, 1), b3 + hstepB, voffB); PG8_STAGE(PG8_SA(1, 0), a3, voffA);
            PG8_WAIT_V(8); PG8_WAIT_L(0); PG8_BAR; PG8_MMA(1, 0, At, B0); PG8_MMA(1, 1, At, B1); PG8_BAR; PG8_SCHED;
            } else {
            PG8_LDB(B0, 0, 0); PG8_SCHED; PG8_LDA(At, 0, 0); PG8_STAGE(PG8_SA(1, 1), a1 + hstepA, voffA);
            PG8_WAIT_L(8); PG8_BAR; PG8_WAIT_L(0); PG8_MMA(0, 0, At, B0); PG8_BAR; PG8_SCHED;
            PG8_LDB(B1, 0, 1); PG8_STAGE(PG8_SB(0, 0), b2, voffB);
            PG8_BAR; PG8_WAIT_L(0); PG8_MMA(0, 1, At, B1); PG8_BAR;
            PG8_LDA(At, 0, 1); PG8_STAGE(PG8_SA(0, 0), a2, voffA);
            PG8_BAR; PG8_WAIT_L(0); PG8_MMA(1, 0, At, B0); PG8_BAR; PG8_SCHED;
            PG8_STAGE(PG8_SB(0, 1), b2 + hstepB, voffB);
            PG8_WAIT_V(6); PG8_BAR; PG8_MMA(1, 1, At, B1); PG8_BAR;
            PG8_LDB(B0, 1, 0); PG8_SCHED; PG8_LDA(At, 1, 0); PG8_STAGE(PG8_SA(0, 1), a2 + hstepA, voffA);
            PG8_WAIT_L(8); PG8_BAR; PG8_WAIT_L(0); PG8_MMA(0, 0, At, B0); PG8_BAR; PG8_SCHED;
            PG8_LDB(B1, 1, 1); PG8_STAGE(PG8_SB(1, 0), b3, voffB);
            PG8_BAR; PG8_WAIT_L(0); PG8_MMA(0, 1, At, B1); PG8_BAR;
            PG8_LDA(At, 1, 1); PG8_STAGE(PG8_SA(1, 0), a3, voffA);
            PG8_BAR; PG8_WAIT_L(0); PG8_MMA(1, 0, At, B0); PG8_BAR; PG8_SCHED;
            PG8_STAGE(PG8_SB(1, 1), b3 + hstepB, voffB);
            PG8_WAIT_V(6); PG8_BAR; PG8_MMA(1, 1, At, B1); PG8_BAR;
            }
        }
        if constexpr (ALIGN_EPI) { if (wr == 0) PG8_BAR; }
        if constexpr (!Epi::AFTER_DRAIN) { E(acc, cur, wr, wc, fr, fq); S.done(cur); }
        if (!has_next) break;
#pragma unroll
        for (int a = 0; a < 2; ++a)
#pragma unroll
            for (int b = 0; b < 2; ++b)
#pragma unroll
                for (int m = 0; m < 4; ++m)
#pragma unroll
                    for (int n = 0; n < 2; ++n) acc[a][b][m][n] = (f32x4){0.f, 0.f, 0.f, 0.f};
        cur = nxt; cA = nA; cB = nB; ++ui;
        if constexpr (ALIGN_EPI) { if (wr == 1) PG8_BAR; }
    }
    PG8_WAIT_V(0);
    if constexpr (!ALIGN_EPI) { if (wr == 0) PG8_BAR; }
    PG8_BAR;
    if constexpr (Epi::AFTER_DRAIN) { E.fused(acc, cur, wr, wc, fr, fq, lds, wid, lane); S.done(cur); }
#undef PG8_SA
#undef PG8_SB
#undef PG8_STAGE
#undef PG8_LDA
#undef PG8_LDB
#undef PG8_MMA
#undef PG8_WAIT_V
#undef PG8_WAIT_L
#undef PG8_BAR
#undef PG8_SCHED
}
}

namespace att {
typedef short bf16x8 __attribute__((ext_vector_type(8)));
typedef short s16x4 __attribute__((ext_vector_type(4)));
typedef float f32x16 __attribute__((ext_vector_type(16)));
typedef unsigned u32x4 __attribute__((ext_vector_type(4)));
typedef float f32x2_t __attribute__((ext_vector_type(2))); typedef __bf16 bf16x2_t __attribute__((ext_vector_type(2)));
typedef __attribute__((address_space(3))) const char* lds_cptr;
typedef short v4i16_t __attribute__((ext_vector_type(4)));
#define ASBAR() __builtin_amdgcn_sched_barrier(0)
#define APIN(x) asm volatile("" : "+v"(x))
#define AMFMA(a, b, c) __builtin_amdgcn_mfma_f32_32x32x16_bf16(a, b, c, 0, 0, 0)
#define AWAIT_BAR(N) asm volatile("s_waitcnt vmcnt(" #N ") lgkmcnt(0)\n\ts_barrier" ::: "memory")
#define AMX3(a, b, c) __builtin_fmaxf(__builtin_fmaxf((a), (b)), (c))
__device__ __forceinline__ int crow(int r, int hi) { return (r & 3) + 8 * (r >> 2) + 4 * hi; }
__device__ __forceinline__ void glds16(const void* gsrc, unsigned lds_dst) { unsigned keep;
    asm volatile("s_mov_b32 %0, m0\n\ts_mov_b32 m0, %2\n\ts_nop 0\n\tglobal_load_lds_dwordx4 %1, off\n\ts_mov_b32 m0, %0" : "=&s"(keep) : "v"(gsrc), "s"(lds_dst) : "memory"); }
__device__ __forceinline__ unsigned cvtpk_s(float lo, float hi) { f32x2_t v = {lo, hi}; bf16x2_t b = __builtin_convertvector(v, bf16x2_t); return __builtin_bit_cast(unsigned, b); }
__device__ __forceinline__ void kload2(bf16x8* kf, lds_cptr kp, int j) { kf[2 * j] = *(const __attribute__((address_space(3))) bf16x8*)(kp + j * 2048); kf[2 * j + 1] = *(const __attribute__((address_space(3))) bf16x8*)(kp + j * 2048 + 512); }
__device__ __forceinline__ bf16x8 kfrag(lds_cptr kp, int f) { return *(const __attribute__((address_space(3))) bf16x8*)(kp + (f >> 1) * 2048 + (f & 1) * 512); }
__device__ __forceinline__ s16x4 vtr(lds_cptr p) { return __builtin_bit_cast(s16x4, __builtin_amdgcn_ds_read_tr16_b64_v4i16((__attribute__((address_space(3))) v4i16_t*)p)); }
__device__ __forceinline__ void wait_bar_n(int n) {
    if (n <= 0) AWAIT_BAR(0); else if (n == 1) AWAIT_BAR(1); else if (n == 2) AWAIT_BAR(2); else if (n == 3) AWAIT_BAR(3); else if (n == 4) AWAIT_BAR(4); else AWAIT_BAR(5);
}
__device__ __forceinline__ void cmask(f32x16& p0, f32x16& p1, int jb, int qrel, int hi) {
    const int kb = 64 * jb + 4 * hi;
#pragma unroll
    for (int r = 0; r < 16; ++r) { const int kv = kb + (r & 3) + 8 * (r >> 2); if (kv > qrel) p0[r] = -INFINITY; if (kv + 32 > qrel) p1[r] = -INFINITY; } }
__device__ __forceinline__ float silu_f(float g) { return g / (1.f + __expf(-g)); }

template <int DQK> struct Geo {
    static constexpr int ND0 = DQK / 16, NKF = 2 * ND0, KSLOT = (DQK / 8) * 1024, VSLOT = 8192;
    static constexpr int LDS_K = 0, LDS_V = 4 * KSLOT, LDS_WS = LDS_V + 3 * VSLOT, LDS_OST = LDS_WS + 2048, LDS_BYTES = LDS_OST + 8 * 4096;
};
typedef const __attribute__((address_space(4))) u64* cu64p;
#define exp2_msel2(A, B, MA, MB) do { float a_ = (A), b_ = (B); \
    asm("v_exp_f32 %0, %0\n\tv_exp_f32 %1, %1\n\tv_cndmask_b32 %0, 0, %0, %2\n\tv_cndmask_b32 %1, 0, %1, %3" : "+v"(a_), "+v"(b_) : "s"(MA), "s"(MB)); (A) = a_; (B) = b_; } while (0)
template <int DQK, int PQ, int PK, int PV, int PO, int PG, int MODE, class NextQ>
__device__ __forceinline__ void attn_unit(const int qb, const bf16_t* Qb, const bf16_t* Kb, const bf16_t* Vb, bf16_t* Ob, const bf16_t* Gb, char* shm, const u64* Mb, const float* rope_b, const float* qgain,
                                          bf16x8 (&qpre)[6], const bool use_pre, NextQ& nq) {
    typedef Geo<DQK> G;
    constexpr int ND0 = G::ND0, KSLOT = G::KSLOT, VSLOT = G::VSLOT, LDS_K = G::LDS_K, LDS_V = G::LDS_V, LDS_WS = G::LDS_WS, LDS_OST = G::LDS_OST;
    constexpr float THRL = 8.f;
    int tid = threadIdx.x; asm volatile("" : "+v"(tid));
    const int lane = tid & 63, r32 = lane & 31, hi = lane >> 5; const int wid = __builtin_amdgcn_readfirstlane(tid >> 6);
    const int q0 = qb * 256, NT = (q0 + 256) / 64;
    const bf16_t* Qw = Qb + (long)(q0 + wid * 32) * PQ;
    const unsigned lds0 = (unsigned)(uintptr_t)shm;
    float* wsf = (float*)(shm + LDS_WS) + wid * 64;
    const int nkp = (DQK == 96 && wid < 4) ? 2 : 1;
    const bf16_t* ksrc = Kb + (long)lane * PK + wid * 8;
    const bf16_t* vsrc = Vb + (long)(16 * (wid & 3) + (lane >> 2)) * PV + (wid >> 2) * 32 + (lane & 3) * 8;
    const unsigned kdst = lds0 + LDS_K + wid * 1024, vdst = lds0 + LDS_V + wid * 1024;
#define DMA_K(t, sl) do { glds16(ksrc + (long)(t) * 64 * PK, (unsigned)__builtin_amdgcn_readfirstlane(kdst + (sl) * KSLOT)); \
        if (nkp == 2) glds16(ksrc + (long)(t) * 64 * PK + 64, (unsigned)__builtin_amdgcn_readfirstlane(kdst + (sl) * KSLOT + 8192)); } while (0)
#define DMA_V(t, sl) glds16(vsrc + (long)(t) * 64 * PV, (unsigned)__builtin_amdgcn_readfirstlane(vdst + (sl) * VSLOT))
    const lds_cptr shm3 = (lds_cptr)shm;
    const lds_cptr kp0 = shm3 + LDS_K + hi * 1024 + r32 * 16;
    const lds_cptr vp0 = shm3 + LDS_V + ((lane >> 4) & 1) * 32 + (lane & 3) * 8 + (4 * hi + ((lane & 15) >> 2)) * 64;
    DMA_K(0, 0); DMA_V(0, 0); DMA_K(1, 1);
    bf16x8 qr[ND0];
#pragma unroll
    for (int d0 = 0; d0 < ND0; ++d0) qr[d0] = use_pre ? qpre[d0] : *reinterpret_cast<const bf16x8*>(&Qw[(long)r32 * PQ + d0 * 16 + hi * 8]);
    {
        float v[ND0][8]; float ss = 0.f;
#pragma unroll
        for (int d0 = 0; d0 < ND0; ++d0)
#pragma unroll
            for (int e = 0; e < 8; ++e) { v[d0][e] = __uint_as_float(((unsigned)(unsigned short)qr[d0][e]) << 16); ss = __builtin_fmaf(v[d0][e], v[d0][e], ss); }
        ss += __shfl_xor(ss, 32);
        const float rn = rsqrtf(ss * (1.f / DQK) + 1e-6f);
        constexpr float QS = (DQK == 96) ? 0.14724445f : 0.18033688f;
#pragma unroll
        for (int d0 = 0; d0 < ND0; ++d0)
#pragma unroll
            for (int e = 0; e < 8; ++e) v[d0][e] = v[d0][e] * rn * qgain[16 * d0 + 8 * hi + e] * QS;
        const float* cs = rope_b + (size_t)(q0 + wid * 32 + r32) * 56;
        if (DQK == 96) {
            float4 c4[4];
#pragma unroll
            for (int i = 0; i < 4; ++i) c4[i] = *(const float4*)(cs + hi * 16 + 4 * i);
            const float cc[8] = {c4[0].x, c4[0].z, c4[1].x, c4[1].z, c4[2].x, c4[2].z, c4[3].x, c4[3].z}, sn[8] = {c4[0].y, c4[0].w, c4[1].y, c4[1].w, c4[2].y, c4[2].w, c4[3].y, c4[3].w};
#pragma unroll
            for (int e = 0; e < 8; ++e) { const float a = v[ND0 - 2][e], bb = v[ND0 - 1][e]; v[ND0 - 2][e] = a * cc[e] - bb * sn[e]; v[ND0 - 1][e] = bb * cc[e] + a * sn[e]; }
        } else {
            float4 c4[4];
#pragma unroll
            for (int i = 0; i < 4; ++i) c4[i] = *(const float4*)(cs + 32 + 4 * i);
            const float cc[8] = {c4[0].x, c4[0].z, c4[1].x, c4[1].z, c4[2].x, c4[2].z, c4[3].x, c4[3].z}, sn[8] = {c4[0].y, c4[0].w, c4[1].y, c4[1].w, c4[2].y, c4[2].w, c4[3].y, c4[3].w};
#pragma unroll
            for (int e = 0; e < 8; ++e) { const float pr = __shfl_xor(v[0][e], 32); v[0][e] = hi == 0 ? v[0][e] * cc[e] - pr * sn[e] : v[0][e] * cc[e] + pr * sn[e]; }
        }
#pragma unroll
        for (int d0 = 0; d0 < ND0; ++d0)
#pragma unroll
            for (int e = 0; e < 8; e += 2) { const unsigned pk = cvtpk_s(v[d0][e], v[d0][e + 1]); qr[d0][e] = (short)(pk & 0xffffu); qr[d0][e + 1] = (short)(pk >> 16); }
    }
    float mhat = 0.f, l_reg = 0.f; f32x16 o[2], negm;
    { float z = 0.f; asm volatile("" : "+v"(z));
#pragma unroll
      for (int r = 0; r < 16; ++r) { o[0][r] = z; o[1][r] = z; negm[r] = z; } asm volatile("" : "+v"(negm)); }
    const int qrel = wid * 32 + r32; bool resc = false;
    const cu64p mwave = (cu64p)(uintptr_t)(Mb + (size_t)(qb * 8 + wid) * 16);
#define MLOAD(m0, m1, t) do { if (MODE == 1) { const cu64p mp_ = mwave + (size_t)(2 * (t)) * 2048; \
        _Pragma("unroll") for (int r = 0; r < 16; ++r) { m0[r] = mp_[r]; m1[r] = mp_[2048 + r]; } } } while (0)
    f32x16 pA0, pA1, pB0, pB1; bf16x8 kf[2 * ND0]; s16x4 vlo[8], vhi[8]; u32x4 pw[4];
    int sl_prev = 0, sl_cur = 0, sl_next = 1;
#define ROT() do { sl_prev = sl_cur; sl_cur = sl_next; sl_next = (sl_next == 2) ? 0 : sl_next + 1; } while (0)
#define RESC() do { if (resc) { asm volatile("s_waitcnt lgkmcnt(0)" ::: "memory"); \
        _Pragma("unroll") for (int d_ = 0; d_ < 2; ++d_) _Pragma("unroll") for (int r = 0; r < 16; ++r) o[d_][r] *= wsf[crow(r, hi)]; } } while (0)
#define CMASKT(C0, C1, t) do { if (MODE == 0) { const int jb_ = (t) - (NT - 4); if (jb_ >= 0) cmask(C0, C1, jb_, qrel, hi); } } while (0)
#define DECIDE(C0, C1) do { float a_ = AMX3(C0[0], C0[1], C1[0]), b_ = AMX3(C0[2], C0[3], C1[1]); a_ = AMX3(a_, C1[2], C1[3]); \
        _Pragma("unroll") for (int r = 4; r < 16; r += 4) { a_ = AMX3(a_, C0[r], C0[r + 1]); b_ = AMX3(b_, C0[r + 2], C0[r + 3]); a_ = AMX3(a_, C1[r], C1[r + 1]); b_ = AMX3(b_, C1[r + 2], C1[r + 3]); } \
        float rm_ = __builtin_fmaxf(a_, b_); { auto rr_ = __builtin_amdgcn_permlane32_swap(__float_as_uint(rm_), __float_as_uint(rm_), false, false); rm_ = __builtin_fmaxf(__uint_as_float(rr_[0]), __uint_as_float(rr_[1])); } \
        resc = false; \
        if (__builtin_expect(__any(rm_ > THRL), 0)) { const float dl_ = __builtin_fmaxf(rm_, 0.f); mhat += dl_; \
            _Pragma("unroll") for (int r = 0; r < 16; ++r) { C0[r] -= dl_; C1[r] -= dl_; } \
            _Pragma("unroll") for (int r = 0; r < 16; ++r) negm[r] = -mhat; asm volatile("" : "+v"(negm)); \
            const float f_ = __builtin_amdgcn_exp2f(-dl_); l_reg *= f_; if (hi == 0) wsf[r32] = f_; resc = true; } } while (0)
    DMA_K(2, 2);
    wait_bar_n(1 + 2 * nkp);
    {
        const lds_cptr kb = kp0;
#pragma unroll
        for (int d0 = 0; d0 < ND0; ++d0) {
            const bf16x8 b0 = *(const __attribute__((address_space(3))) bf16x8*)(kb + d0 * 2048);
            const bf16x8 b1 = *(const __attribute__((address_space(3))) bf16x8*)(kb + d0 * 2048 + 512);
            if (d0 == 0) { pA0 = AMFMA(b0, qr[0], negm); pA1 = AMFMA(b1, qr[0], negm); }
            else { pA0 = AMFMA(b0, qr[d0], pA0); pA1 = AMFMA(b1, qr[d0], pA1); }
        }
    }
    CMASKT(pA0, pA1, 0);
    DECIDE(pA0, pA1);
    if (MODE == 1) { u64 m0[16], m1[16]; MLOAD(m0, m1, 0);
#pragma unroll
        for (int r = 0; r < 16; r += 2) { exp2_msel2(pA0[r], pA0[r + 1], m0[r], m0[r + 1]); exp2_msel2(pA1[r], pA1[r + 1], m1[r], m1[r + 1]); } }
    else {
#pragma unroll
        for (int r = 0; r < 16; ++r) { pA0[r] = __builtin_amdgcn_exp2f(pA0[r]); pA1[r] = __builtin_amdgcn_exp2f(pA1[r]); } }
    wait_bar_n(0);
    RESC();
    DMA_K(3, 3); DMA_V(1, 1);
    ROT();
#pragma unroll
    for (int f = 0; f < 4; ++f) kf[f] = kfrag(kp0 + 1 * KSLOT, f);
#define PELM(P0, P1, i) (((i) < 16) ? P0[(i) & 15] : P1[(i) & 15])
#define VFR(i) (bf16x8){vlo[i][0], vlo[i][1], vlo[i][2], vlo[i][3], vhi[i][0], vhi[i][1], vhi[i][2], vhi[i][3]}
#define VRD(i) do { vlo[i] = vtr(vp_ + (((i) >> 2) * 4096 + ((i) & 3) * 1024)); vhi[i] = vtr(vp_ + (((i) >> 2) * 4096 + ((i) & 3) * 1024 + 512)); } while (0)
#define STEP(C0, C1, P0, P1, t, GK, GV, GL) do { ASBAR(); \
        const lds_cptr vp_ = vp0 + sl_prev * VSLOT; const lds_cptr kpc_ = kp0 + ((t) & 3) * KSLOT; const lds_cptr kpn_ = kp0 + (((t) + 1) & 3) * KSLOT; \
        float sacc = P0[0] + P0[1]; u64 m0_[16], m1_[16]; MLOAD(m0_, m1_, t); \
        _Pragma("unroll") for (int g = 0; g < 2 * ND0; ++g) { \
            if (g < 8) { VRD(((g) >> 1) + 4 * ((g) & 1)); } \
            if (g + 4 < 2 * ND0) { kf[g + 4] = kfrag(kpc_, g + 4); } \
            ASBAR(); \
            if ((g & 1) == 0) { C0 = AMFMA(kf[g], qr[g >> 1], (g < 2) ? negm : C0); } else { C1 = AMFMA(kf[g], qr[g >> 1], (g < 2) ? negm : C1); } \
            if (g < 8) { sacc += PELM(P0, P1, 4 * g + 2); sacc += PELM(P0, P1, 4 * g + 3); if (g < 7) { sacc += PELM(P0, P1, 4 * g + 4); sacc += PELM(P0, P1, 4 * g + 5); } APIN(sacc); \
                pw[g >> 1][2 * (g & 1)] = cvtpk_s(PELM(P0, P1, 4 * g), PELM(P0, P1, 4 * g + 1)); pw[g >> 1][2 * (g & 1) + 1] = cvtpk_s(PELM(P0, P1, 4 * g + 2), PELM(P0, P1, 4 * g + 3)); APIN(pw[g >> 1]); } \
            ASBAR(); } \
        l_reg += sacc; \
        if (GK) { DMA_K((t) + 3, ((t) + 3) & 3); } if (GV) { DMA_V((t) + 1, sl_next); } \
        CMASKT(C0, C1, t); \
        DECIDE(C0, C1); \
        ASBAR(); \
        _Pragma("unroll") for (int i = 0; i < 8; ++i) { \
            if ((GL) && i >= 4) { kf[i - 4] = kfrag(kpn_, i - 4); ASBAR(); } \
            o[i & 1] = AMFMA(__builtin_bit_cast(bf16x8, pw[i >> 1]), VFR((i >> 1) + 4 * (i & 1)), o[i & 1]); \
            if (MODE == 1) { if (i < 4) { exp2_msel2(C0[4 * i], C0[4 * i + 1], m0_[4 * i], m0_[4 * i + 1]); exp2_msel2(C0[4 * i + 2], C0[4 * i + 3], m0_[4 * i + 2], m0_[4 * i + 3]); APIN(C0); } \
                             else { exp2_msel2(C1[4 * i - 16], C1[4 * i - 15], m1_[4 * i - 16], m1_[4 * i - 15]); exp2_msel2(C1[4 * i - 14], C1[4 * i - 13], m1_[4 * i - 14], m1_[4 * i - 13]); APIN(C1); } } \
            else if (i < 4) { _Pragma("unroll") for (int e = 0; e < 4; ++e) { C0[4 * i + e] = __builtin_amdgcn_exp2f(C0[4 * i + e]); } APIN(C0); } \
            else { _Pragma("unroll") for (int e = 0; e < 4; ++e) { C1[4 * i - 16 + e] = __builtin_amdgcn_exp2f(C1[4 * i - 16 + e]); } APIN(C1); } \
            ASBAR(); } \
    } while (0)
#define ENDW(tt) do { if ((tt) + 3 < NT) wait_bar_n(nkp + 1); else if ((tt) + 2 < NT) wait_bar_n(1); else wait_bar_n(0); } while (0)
    int t = 1;
    for (; t + 5 < NT; t += 2) {
        STEP(pB0, pB1, pA0, pA1, t, true, true, true);     wait_bar_n(nkp + 1); RESC(); ROT();
        STEP(pA0, pA1, pB0, pB1, t + 1, true, true, true); wait_bar_n(nkp + 1); RESC(); ROT();
    }
    for (; t + 1 < NT; t += 2) {
        STEP(pB0, pB1, pA0, pA1, t, (t + 3 < NT), (t + 1 < NT), (t + 1 < NT));       ENDW(t);     RESC(); ROT();
        STEP(pA0, pA1, pB0, pB1, t + 1, (t + 4 < NT), (t + 2 < NT), (t + 2 < NT));   ENDW(t + 1); RESC(); ROT();
    }
    STEP(pB0, pB1, pA0, pA1, NT - 1, false, false, false); RESC();
    const bf16_t* qnext; int pqn, nd0n; nq.draw(qnext, pqn, nd0n);
    if (qnext) { const bf16_t* qn_ = qnext + (long)(wid * 32 + r32) * pqn + hi * 8;
#pragma unroll
        for (int d0 = 0; d0 < 6; ++d0) if (d0 < nd0n) qpre[d0] = *reinterpret_cast<const bf16x8*>(qn_ + d0 * 16); }
    u32x4 gq[4];
    { const bf16_t* Gw_ = Gb + (long)(q0 + wid * 32) * PG;
#pragma unroll
      for (int i = 0; i < 4; ++i) gq[i] = *(const u32x4*)(Gw_ + (long)(i * 8 + (lane >> 3)) * PG + (lane & 7) * 8); }
    {
        float sacc = pB0[0] + pB0[1];
#pragma unroll
        for (int r = 2; r < 16; ++r) sacc += pB0[r];
#pragma unroll
        for (int r = 0; r < 16; ++r) sacc += pB1[r];
        l_reg += sacc;
#pragma unroll
        for (int g = 0; g < 8; ++g) { pw[g >> 1][2 * (g & 1)] = cvtpk_s(PELM(pB0, pB1, 4 * g), PELM(pB0, pB1, 4 * g + 1)); pw[g >> 1][2 * (g & 1) + 1] = cvtpk_s(PELM(pB0, pB1, 4 * g + 2), PELM(pB0, pB1, 4 * g + 3)); }
        const lds_cptr vp_ = vp0 + sl_cur * VSLOT;
#pragma unroll
        for (int i = 0; i < 8; ++i) VRD(i);
#pragma unroll
        for (int i = 0; i < 8; ++i) o[i & 1] = AMFMA(__builtin_bit_cast(bf16x8, pw[i >> 1]), VFR((i >> 1) + 4 * (i & 1)), o[i & 1]);
    }
    { auto rr = __builtin_amdgcn_permlane32_swap(__float_as_uint(l_reg), __float_as_uint(l_reg), false, false); l_reg = __uint_as_float(rr[0]) + __uint_as_float(rr[1]); }
    if (hi == 0) wsf[32 + r32] = l_reg; asm volatile("s_waitcnt lgkmcnt(0)" ::: "memory");
    float rli[16];
#pragma unroll
    for (int r = 0; r < 16; ++r) rli[r] = __builtin_amdgcn_rcpf(wsf[32 + crow(r, hi)]);
    {
        bf16_t* stg = (bf16_t*)(shm + LDS_OST) + wid * 2048;
#pragma unroll
        for (int r = 0; r < 16; ++r) { const int orow = crow(r, hi);
#pragma unroll
            for (int d0 = 0; d0 < 2; ++d0) stg[orow * 64 + d0 * 32 + r32] = f2bf(o[d0][r] * rli[r]); }
        asm volatile("s_waitcnt lgkmcnt(0)" ::: "memory");
        bf16_t* Ow = Ob + (long)(q0 + wid * 32) * PO;
#pragma unroll
        for (int i = 0; i < 4; ++i) { const int row = i * 8 + (lane >> 3), ch = lane & 7;
            const u32x4 v = *(const u32x4*)(stg + row * 64 + ch * 8); const u32x4 g = gq[i]; u32x4 w;
#pragma unroll
            for (int e = 0; e < 4; ++e) { const float lo = __uint_as_float(v[e] << 16) * silu_f(__uint_as_float(g[e] << 16)), hh = __uint_as_float(v[e] & 0xffff0000u) * silu_f(__uint_as_float(g[e] & 0xffff0000u)); w[e] = cvtpk_s(lo, hh); }
            *(u32x4*)(Ow + (long)row * PO + ch * 8) = w; }
    }
    asm volatile("s_waitcnt lgkmcnt(0)\n\ts_barrier" ::: "memory");
#undef MLOAD
#undef DMA_K
#undef DMA_V
#undef ROT
#undef RESC
#undef CMASKT
#undef DECIDE
#undef PELM
#undef VFR
#undef VRD
#undef STEP
#undef ENDW
}
}

namespace sel {
typedef short bf16x8 __attribute__((ext_vector_type(8)));
typedef float f32x16 __attribute__((ext_vector_type(16)));
constexpr int CAP = 64;
constexpr int L_HIST = 0, L_CS = 65536, L_CI = 73728, L_MASK = 81920, L_STAT = 98304, L_SEG = 100352, L_B = 102400, L_QUOTA = 102528, L_ABOVE = 102656, L_TLO = 102784, L_THI = 102912,
              L_CC = 103040, L_FAIL = 103168  , L_QI = 103424  , L_W = 104448  , L_BYTES = 104480;
__device__ __forceinline__ int crow(int r, int hi) { return (r & 3) + 8 * (r >> 2) + 4 * hi; }
__device__ __forceinline__ void score_tile_k(f32x16& sc, const bf16x8 (&qf)[8][2], const float (&w)[8], const bf16x8 k0, const bf16x8 k1) {
#pragma unroll
    for (int r = 0; r < 16; ++r) sc[r] = 0.f;
#pragma unroll
    for (int hh = 0; hh < 8; hh += 4) {
        f32x16 x[4];
#pragma unroll
        for (int h = 0; h < 4; ++h) { x[h] = __builtin_amdgcn_mfma_f32_32x32x16_bf16(k0, qf[hh + h][0], (f32x16){}, 0, 0, 0); x[h] = __builtin_amdgcn_mfma_f32_32x32x16_bf16(k1, qf[hh + h][1], x[h], 0, 0, 0); }
#pragma unroll
        for (int h = 0; h < 4; ++h)
#pragma unroll
            for (int r = 0; r < 16; ++r) { const float xv = x[h][r]; const int xi = __float_as_int(xv); sc[r] = __builtin_fmaf(w[hh + h], __int_as_float(xi > 0 ? xi : 0), sc[r]); }
        __builtin_amdgcn_sched_barrier(0);
    }
}
__device__ __forceinline__ void score_tile(f32x16& sc, const bf16x8 (&qf)[8][2], const float (&w)[8], const bf16_t* kig, int r32, int hi) {
    const bf16x8 k0 = *(const bf16x8*)(kig + r32 * 32 + hi * 8), k1 = *(const bf16x8*)(kig + r32 * 32 + 16 + hi * 8);
    score_tile_k(sc, qf, w, k0, k1);
}
#define SEL_GLOOP_BEGIN() { const bf16_t* kp_ = kib + (size_t)wid * 1024 + r32 * 32 + hi * 8; bf16x8 kn0_ = *(const bf16x8*)kp_, kn1_ = *(const bf16x8*)(kp_ + 16); \
    for (int g = wid; g <= qblk; g += 8) { const bf16x8 kc0_ = kn0_, kc1_ = kn1_; kp_ += 8 * 1024; if (g + 8 <= qblk) { kn0_ = *(const bf16x8*)kp_; kn1_ = *(const bf16x8*)(kp_ + 16); } \
        score_tile_k(sc, qf, w, kc0_, kc1_);
#define SEL_GLOOP_END() } }
__device__ __forceinline__ int key18_of(float s, float iw, float c0) { const float f = __builtin_amdgcn_fmed3f(__builtin_fmaf(s, iw, c0), 0.f, 262143.f); return (int)f; }
__device__ __forceinline__ int bin10_of(float s, float iw1, float c1) { const float f = __builtin_amdgcn_fmed3f(__builtin_fmaf(s, iw1, c1), 0.f, 1023.99609375f); return (int)f; }
__device__ __forceinline__ void scan_top(const unsigned short* h16, int nseg, int* seg_s, const int* cum0_s, int* B_out, int* above_out, int* cnt_out, int tid) {
    { const int q = tid & 31, seg = tid >> 5; if (seg < nseg) { int s = 0;
#pragma unroll 8
        for (int i = 0; i < 64; ++i) s += h16[((seg * 64 + i) * 32) + q];
        seg_s[q * 16 + seg] = s; } }
    __syncthreads();
    if (tid < 32) {
        int cum = cum0_s ? cum0_s[tid] : 0;
        int cseg[16];
#pragma unroll
        for (int i = 0; i < 16; ++i) cseg[i] = (i < nseg) ? seg_s[tid * 16 + i] : 0;
        int sg = 0; bool found = false;
#pragma unroll
        for (int i = 15; i >= 1; --i) { if (i < nseg) { const bool hit = !found && (cum + cseg[i] >= 256); if (hit) { sg = i; found = true; } if (!found) cum += cseg[i]; } }
        int bb = -1, cb = 0; bool fb = false;
#pragma unroll 1
        for (int ch = 3; ch >= 0; --ch) {
            int cv[16];
#pragma unroll
            for (int i = 0; i < 16; ++i) cv[i] = h16[(sg * 64 + ch * 16 + i) * 32 + tid];
#pragma unroll
            for (int i = 15; i >= 0; --i) { const bool hit = !fb && (cum + cv[i] >= 256); if (hit) { bb = sg * 64 + ch * 16 + i; cb = cv[i]; fb = true; } if (!fb) cum += cv[i]; }
        }
        B_out[tid] = bb; above_out[tid] = cum; cnt_out[tid] = cb;
    }
    __syncthreads();
}

__device__ __forceinline__ void sel_unit(const int b, const int qblk, const bf16_t* proj, const bf16_t* ki, const float* wi, u64* M64, unsigned char* smem) {
    unsigned* hist = (unsigned*)(smem + L_HIST); float* cs = (float*)(smem + L_CS); int* ci = (int*)(smem + L_CI); u64* mask = (u64*)(smem + L_MASK); unsigned* mask32 = (unsigned*)(smem + L_MASK);
    float* stat = (float*)(smem + L_STAT); int* seg_s = (int*)(smem + L_SEG); int* B_s = (int*)(smem + L_B); int* quota_s = (int*)(smem + L_QUOTA); int* above_s = (int*)(smem + L_ABOVE);
    int* tlo_s = (int*)(smem + L_TLO); int* thi_s = (int*)(smem + L_THI); unsigned* cc = (unsigned*)(smem + L_CC); int* flag_s = (int*)(smem + L_FAIL); int* failq = (int*)(smem + L_FAIL + 16);
    int* cnt_s = (int*)(smem + L_STAT);
    int tid = threadIdx.x; asm volatile("" : "+v"(tid));
    const int lane = tid & 63, r32 = lane & 31, hi = lane >> 5; const int wid = __builtin_amdgcn_readfirstlane(tid >> 6);
    const size_t trow = (size_t)b * SEQ + qblk * 32 + r32;
    const bf16_t* kib = ki + (size_t)b * SEQ * 32;
    const int gend = (qblk | 7) + 1;
    const bool topk = qblk >= 8;
    for (int i = tid; i < gend * 32; i += NTHREADS) mask32[i] = 0u;
    unsigned zz = 0u; asm volatile("" : "+v"(zz));
    if (topk) for (int i = tid; i < 4096; i += NTHREADS) ((uint4*)hist)[i] = make_uint4(zz, zz, zz, zz);
    if (tid < 32) { cc[tid] = 0u; failq[tid] = 0; }
    if (tid < 4) flag_s[tid] = 0;
    bf16x8 qf[8][2]; float w[8];
#pragma unroll
    for (int h = 0; h < 8; ++h) { qf[h][0] = *(const bf16x8*)(proj + trow * NP + C_QI + h * 32 + hi * 8); qf[h][1] = *(const bf16x8*)(proj + trow * NP + C_QI + h * 32 + 16 + hi * 8); w[h] = wi[trow * 8 + h]; }
    float iw = 0.f, c0 = 0.f; int Tlo = 0x7fffffff, Thi = -1;
    f32x16 sc;
    const unsigned hadd = (r32 & 1) ? 0x10000u : 1u; const unsigned hoff = (unsigned)(r32 >> 1) * 4u;
    if (topk) {
        score_tile(sc, qf, w, kib + (size_t)wid * 32 * 32, r32, hi);
        float s1 = 0.f, s2 = 0.f;
#pragma unroll
        for (int r = 0; r < 16; ++r) { s1 += sc[r]; s2 = __builtin_fmaf(sc[r], sc[r], s2); }
        s1 += __shfl_xor(s1, 32); s2 += __shfl_xor(s2, 32);
        if (hi == 0) { stat[(wid * 32 + r32) * 2] = s1; stat[(wid * 32 + r32) * 2 + 1] = s2; }
        __syncthreads();
        { float a1 = 0.f, a2 = 0.f;
#pragma unroll
          for (int ww = 0; ww < 8; ++ww) { a1 += stat[(ww * 32 + r32) * 2]; a2 += stat[(ww * 32 + r32) * 2 + 1]; }
          const float mu = a1 * (1.f / 256.f); float var = a2 * (1.f / 256.f) - mu * mu; var = __builtin_fmaxf(var, 0.f);
          const float sd = __builtin_sqrtf(var); const float lo = mu - 6.f * sd; iw = sd > 0.f ? 262144.f / (12.f * sd) : 0.f; c0 = -lo * iw; }
        const float iw1 = iw * (1.f / 256.f), c1 = c0 * (1.f / 256.f);
        SEL_GLOOP_BEGIN()
            if (g == qblk) {
#pragma unroll
                for (int r = 0; r < 16; ++r) { const int bin = bin10_of(sc[r], iw1, c1); if (crow(r, hi) <= r32) atomicAdd((unsigned*)((unsigned char*)hist + (bin << 6) + hoff), hadd); }
            } else {
#pragma unroll
                for (int r = 0; r < 16; ++r) { const int bin = bin10_of(sc[r], iw1, c1); atomicAdd((unsigned*)((unsigned char*)hist + (bin << 6) + hoff), hadd); }
            }
        SEL_GLOOP_END()
        __syncthreads();
        scan_top((const unsigned short*)hist, 16, seg_s, nullptr, B_s, above_s, cnt_s, tid);
        if (tid < 32) {
            const int Bf = B_s[tid];
            quota_s[tid] = 256 - above_s[tid]; tlo_s[tid] = Bf * 256; thi_s[tid] = Bf * 256 + 255;
            if (Bf <= 0 || Bf >= 1023) { failq[tid] = 1; flag_s[1] = 1; }
            else if (cnt_s[tid] > CAP) flag_s[0] = 1;
        }
        __syncthreads();
        if (flag_s[0] != 0) {
            const int Bq = B_s[r32];
            __syncthreads();
            for (int i = tid; i < 1024; i += NTHREADS) ((uint4*)hist)[i] = make_uint4(zz, zz, zz, zz);
            __syncthreads();
            SEL_GLOOP_BEGIN()
                const bool diag = (g == qblk);
#pragma unroll
                for (int r = 0; r < 16; ++r) {
                    const bool valid = !diag || (crow(r, hi) <= r32);
                    const int k18 = key18_of(sc[r], iw, c0); const int sub = k18 & 255;
                    if (valid && (k18 >> 8) == Bq) atomicAdd((unsigned*)((unsigned char*)hist + (sub << 6) + hoff), hadd);
                }
            SEL_GLOOP_END()
            __syncthreads();
            scan_top((const unsigned short*)hist, 4, seg_s, above_s, tlo_s  , quota_s  , cnt_s, tid);
            if (tid < 32 && failq[tid] == 0) {
                const int B2 = tlo_s[tid], ab = quota_s[tid];
                if (B2 < 0 || cnt_s[tid] > CAP) { failq[tid] = 1; flag_s[1] = 1; }
                quota_s[tid] = 256 - ab; tlo_s[tid] = B_s[tid] * 256 + B2; thi_s[tid] = B_s[tid] * 256 + B2;
            }
            __syncthreads();
        }
        Tlo = tlo_s[r32]; Thi = thi_s[r32];
        if (failq[r32] != 0) { Tlo = 0x7fffffff; Thi = 0x7fffffff; }
    } else { __syncthreads(); }
    const unsigned twid = (unsigned)(Thi - Tlo);
#define SEL_P2_BODY(VALID) do { \
        _Pragma("unroll") for (int r = 0; r < 16; ++r) { \
            const int k16 = topk ? key18_of(sc[r], iw, c0) : 0; \
            const u64 m = __ballot((VALID) && k16 > Thi); \
            if (lane == r) mine = m; \
            if ((VALID) && (unsigned)(k16 - Tlo) <= twid) { const unsigned slot = atomicAdd(&cc[r32], 1u); if (slot < (unsigned)CAP) { cs[r32 * CAP + slot] = sc[r]; ci[r32 * CAP + slot] = g * 32 + crow(r, hi); } } \
        } } while (0)
    SEL_GLOOP_BEGIN()
        u64 mine = 0ull;
        if (g == qblk) SEL_P2_BODY(crow(r, hi) <= r32); else SEL_P2_BODY(true);
        if (lane < 16) mask[g * 16 + lane] = mine;
    SEL_GLOOP_END()
#undef SEL_P2_BODY
    __syncthreads();
    if (topk) {
        for (int qq = 0; qq < 4; ++qq) {
            const int q = wid * 4 + qq; int c = (int)cc[q]; c = c < CAP ? c : CAP; const int quo = quota_s[q];
            const float si = lane < c ? cs[q * CAP + lane] : 0.f; const int ii = lane < c ? ci[q * CAP + lane] : 0; int rank = 0;
            for (int j = 0; j < c; ++j) { const float sj = cs[q * CAP + j]; const int ij = ci[q * CAP + j]; rank += (sj > si || (sj == si && ij < ii)) ? 1 : 0; }
            if (lane < c && rank < quo) { const int g = ii >> 5, ko = ii & 31, r = (ko & 3) + 4 * (ko >> 3), hh = (ko >> 2) & 1; atomicOr(&mask32[(g * 16 + r) * 2 + hh], 1u << q); }
        }
        if (flag_s[1] != 0) {
            u64* keys = (u64*)smem; float* qi_s = (float*)(smem + L_QI); float* w_s = (float*)(smem + L_W);
            for (int qq = 0; qq < 32; ++qq) {
                if (failq[qq] == 0) continue;
                const size_t t = (size_t)b * SEQ + qblk * 32 + qq; const int n = qblk * 32 + qq + 1;
                __syncthreads();
                if (tid < 256) qi_s[tid] = bf2f(proj[t * NP + C_QI + tid]);
                if (tid < 8) w_s[tid] = wi[t * 8 + tid];
                __syncthreads();
                int Npad = 512; while (Npad < n) Npad <<= 1;
                for (int s = tid; s < Npad; s += NTHREADS) {
                    u64 key = 0;
                    if (s < n) {
                        const bf16_t* kr = kib + (size_t)s * 32; float kv[32];
#pragma unroll
                        for (int d = 0; d < 32; d += 8) { float f[8]; unpack8(*(const uint4*)(kr + d), f);
#pragma unroll
                            for (int i = 0; i < 8; ++i) kv[d + i] = f[i]; }
                        float scv = 0.f;
#pragma unroll
                        for (int h = 0; h < 8; ++h) { float d = 0.f;
#pragma unroll
                            for (int i = 0; i < 32; ++i) d = fmaf(qi_s[h * 32 + i], kv[i], d);
                            scv = fmaf(w_s[h], fmaxf(d, 0.f), scv); }
                        u32 ub = __float_as_uint(scv); ub = (ub & 0x80000000u) ? ~ub : (ub | 0x80000000u);
                        key = ((u64)ub << 32) | (u64)(0xFFFFFFFFu - (u32)s);
                    }
                    keys[s] = key;
                }
                __syncthreads();
                for (int kk = 2; kk <= Npad; kk <<= 1)
                    for (int j = kk >> 1; j > 0; j >>= 1) {
                        for (int i = tid; i < Npad; i += NTHREADS) {
                            const int ixj = i ^ j;
                            if (ixj > i) { const u64 a = keys[i], c = keys[ixj]; const bool desc = (i & kk) == 0; if (desc ? (a < c) : (a > c)) { keys[i] = c; keys[ixj] = a; } }
                        }
                        __syncthreads();
                    }
                if (tid < 256) { const int ii = (int)(0xFFFFFFFFu - (u32)(keys[tid] & 0xFFFFFFFFull)); const int g = ii >> 5, ko = ii & 31, r = (ko & 3) + 4 * (ko >> 3), hh = (ko >> 2) & 1; atomicOr(&mask32[(g * 16 + r) * 2 + hh], 1u << qq); }
            }
        }
    }
    __syncthreads();
    u64* dst = M64 + (size_t)b * 128 * 128 * 16;
    for (int i = tid; i < gend * 16; i += NTHREADS) { const int g = i >> 4, r = i & 15; dst[((size_t)g * 128 + qblk) * 16 + r] = mask[i]; }
    __syncthreads();
}
}

#define GAS __attribute__((address_space(1)))
#define LAS __attribute__((address_space(3)))
typedef GAS unsigned gu32;
typedef GAS unsigned long long gu64;
#define RLX_AGENT __ATOMIC_RELAXED, __HIP_MEMORY_SCOPE_AGENT
#define XB_TMO      128
#define XB_XCNT(j)  (256  + 64 * (j))
#define XB_XSUB(j)  (1280 + 64 * (j))
#define XB_XGEN(j)  (2304 + 64 * (j))
#define XB_TOP      3328
#define XB_TOPGEN   3392
#define XCD_BAR_WORDS 3456
#define XB_SPIN_CAP (1u << 18)

__device__ __forceinline__ unsigned xb_ld(unsigned* p)              { return __hip_atomic_load(p, __ATOMIC_RELAXED, __HIP_MEMORY_SCOPE_AGENT); }
__device__ __forceinline__ unsigned xb_add(unsigned* p, unsigned v) { return __hip_atomic_fetch_add(p, v, __ATOMIC_RELAXED, __HIP_MEMORY_SCOPE_AGENT); }
__device__ __forceinline__ unsigned xb_xcc_id() { return (unsigned)__builtin_amdgcn_s_getreg((3 << 11) | 20) & 0xFu; }
#define XB_SPIN(cond, bar) do { unsigned _sp = 0; while (cond) { __builtin_amdgcn_s_sleep(1); \
    if ((++_sp & 255u) == 0u) { if (xb_ld(&(bar)[XB_TMO])) break; if (_sp > XB_SPIN_CAP) { atomicAdd(&(bar)[XB_TMO], 1u); break; } } } } while (0)

struct XcdBarrier {
    unsigned* bar; unsigned x;
    volatile LAS unsigned* st;
};

__device__ __forceinline__ XcdBarrier xcd_barrier_post(unsigned* bar, volatile LAS unsigned* st) {
    XcdBarrier b; b.bar = bar; b.x = xb_xcc_id(); b.st = st;
    if (threadIdx.x == 0) (void)xb_add(&bar[XB_XCNT(b.x)], 1u);
    return b;
}
__device__ __forceinline__ void xcd_barrier_complete(unsigned* bar, unsigned x, unsigned& nloc, unsigned& nx) {
    const unsigned G = gridDim.x * gridDim.y * gridDim.z;
    unsigned sum, cnt, mine, sp = 0u;
    for (;;) {
        sum = 0u; cnt = 0u; mine = 0u;
#pragma unroll
        for (unsigned j = 0; j < 16; ++j) { const unsigned c = xb_ld(&bar[XB_XCNT(j)]); sum += c; cnt += (c > 0u) ? 1u : 0u; mine = (j == x) ? c : mine; }
        if (sum == G) break;
        __builtin_amdgcn_s_sleep(1);
        if ((++sp & 255u) == 0u) { if (xb_ld(&bar[XB_TMO])) break; if (sp > XB_SPIN_CAP) { atomicAdd(&bar[XB_TMO], 1u); break; } }
    }
    nloc = mine > 0u ? mine : 1u; nx = cnt > 0u ? cnt : 1u;
}

__device__ __forceinline__ void xcd_barrier(const XcdBarrier& b) {
    asm volatile("s_waitcnt vmcnt(0)" ::: "memory");
    __syncthreads();
    if (threadIdx.x == 0) {
        unsigned* bar = b.bar;
        __builtin_amdgcn_s_waitcnt(0);
        unsigned nloc = b.st[0], nx = b.st[1];
        if (nloc == 0u) { xcd_barrier_complete(bar, b.x, nloc, nx); b.st[0] = nloc; b.st[1] = nx; }
        const unsigned old = xb_add(&bar[XB_XSUB(b.x)], 1u);
        const unsigned gen = old / nloc;
        if (old + 1u == (gen + 1u) * nloc) {
            __builtin_amdgcn_fence(__ATOMIC_RELEASE, "agent");
            asm volatile("s_waitcnt vmcnt(0)" ::: "memory");
            const unsigned og = xb_add(&bar[XB_TOP], 1u);
            const unsigned tg = og / nx;
            if (og + 1u == (tg + 1u) * nx) xb_add(&bar[XB_TOPGEN], 1u);
            else XB_SPIN(xb_ld(&bar[XB_TOPGEN]) == tg, bar);
            __builtin_amdgcn_fence(__ATOMIC_ACQUIRE, "agent");
            xb_add(&bar[XB_XGEN(b.x)], 1u);
            asm volatile("s_waitcnt vmcnt(0)" ::: "memory");
        } else {
            XB_SPIN(xb_ld(&bar[XB_XGEN(b.x)]) == gen, bar);
            __builtin_amdgcn_fence(__ATOMIC_ACQUIRE, "agent");
            asm volatile("s_waitcnt vmcnt(0)" ::: "memory");
        }
    }
    __syncthreads();
}


template <bool PERMUTE>
__device__ __forceinline__ void transpose_item(const float* W, int ldw, int N, bf16_t* WT, int ldt, int koff, float* scr, int item, int lane) {
    const int nblk = N / 32, kb = item / nblk, nb = item % nblk, k0 = 64 * kb, n0 = 32 * nb;
    const int nn = n0 + (lane & 31); const int sc = PERMUTE ? oldcol(nn) : nn;
    float wv_[32];
#pragma unroll
    for (int i = 0; i < 32; ++i) { const int kk = 2 * i + (lane >> 5); wv_[i] = sc >= 0 ? W[(size_t)(k0 + kk) * ldw + sc] : 0.f; }
#pragma unroll
    for (int i = 0; i < 32; ++i) { const int kk = 2 * i + (lane >> 5); scr[kk * 33 + (lane & 31)] = wv_[i]; }
    asm volatile("s_waitcnt lgkmcnt(0)" ::: "memory");
    const int c = lane & 7;
#pragma unroll
    for (int j = 0; j < 4; ++j) { const int n = (lane >> 3) + 8 * j; const float* s = scr + (8 * c) * 33 + n;
        uint4 o; o.x = (u32)f2bf(s[0 * 33]) | ((u32)f2bf(s[1 * 33]) << 16); o.y = (u32)f2bf(s[2 * 33]) | ((u32)f2bf(s[3 * 33]) << 16);
        o.z = (u32)f2bf(s[4 * 33]) | ((u32)f2bf(s[5 * 33]) << 16); o.w = (u32)f2bf(s[6 * 33]) | ((u32)f2bf(s[7 * 33]) << 16);
        *(uint4*)(WT + (size_t)(n0 + n) * ldt + koff + k0 + 8 * c) = o; }
    asm volatile("s_waitcnt lgkmcnt(0)" ::: "memory");
}
__device__ __forceinline__ void late_weights(const Params& p, unsigned char* smem, int wg, int nwg) {
    const int tidx = opaque_tid(); const int lane_ = tidx & 63, wv = tidx >> 6;
    float* scr = (float*)(smem + wv * 8704);
    constexpr int I_BR = 8 * 32, I_OUT = 16 * 32, I_ALL = 2 * I_BR + I_OUT;
    for (int it = wg * 8 + wv; it < I_ALL; it += nwg * 8) {
        int r = it;
        if (r < I_BR) { transpose_item<false>(p.w_br_mla, 1024, 1024, (bf16_t*)(p.ws + OFF_WBR), 1024, 0, scr, r, lane_); continue; } r -= I_BR;
        if (r < I_BR) { transpose_item<false>(p.w_br_dsa, 1024, 1024, (bf16_t*)(p.ws + OFF_WBR), 1024, 512, scr, r, lane_); continue; } r -= I_BR;
        transpose_item<false>(p.w_out, 1024, 1024, (bf16_t*)(p.ws + OFF_WOUT), 1024, 0, scr, r, lane_);
    }
}
__device__ __forceinline__ void ph0(const Params& p, unsigned char* smem) {
    const int tidx = opaque_tid(); const int gtid = blockIdx.x * blockDim.x + tidx, gsz = gridDim.x * blockDim.x;
    const int lane = tidx & 63, gw = gtid >> 6, nw = gsz >> 6;
    float4 va[4][4], vb[4][4];
#define PH0_LOAD(V, t_) do { _Pragma("unroll") for (int u = 0; u < 4; ++u) { const float4* xr = (const float4*)(p.x + (size_t)((t_) + u) * DM); \
        _Pragma("unroll") for (int j = 0; j < 4; ++j) V[u][j] = xr[j * 64 + lane]; } } while (0)
    const int st = nw * 4; int t = gw * 4;
    if (t < NT) PH0_LOAD(va, t);
    if (t + st < NT) PH0_LOAD(vb, t + st);
    {
        const int wv = tidx >> 6;
        float* scr = (float*)(smem + wv * 8704);
        constexpr int I_IN = 16 * 144, I_UQ = 4 * 24, I_UKV = 2 * 32;
        for (int it = gw; it < I_IN + I_UQ + I_UKV; it += nw) {
            if (it < I_IN) transpose_item<true>(p.w_in, DIN, NP, (bf16_t*)(p.ws + OFF_WIN), DM, 0, scr, it, lane);
            else if (it < I_IN + I_UQ) transpose_item<false>(p.w_uq, 768, 768, (bf16_t*)(p.ws + OFF_WUQ), 256, 0, scr, it - I_IN, lane);
            else transpose_item<false>(p.w_ukv, 1024, 1024, (bf16_t*)(p.ws + OFF_WUKV), 128, 0, scr, it - I_IN - I_UQ, lane);
        }
    }
    float* rope = (float*)(p.ws + OFF_ROPE);
    for (int i = gtid; i < NT * 28; i += gsz) {
        const int tt = i / 28, j = i % 28;
        const float ang = (float)p.pos[tt] * c_inv_freq[j];
        double s, c; sincos_d((double)ang, s, c);
        *(float2*)(rope + 2 * i) = make_float2((float)c, (float)s);
    }
    bf16_t* H = (bf16_t*)(p.ws + OFF_H);
    float4 g[4];
#pragma unroll
    for (int j = 0; j < 4; ++j) g[j] = *(const float4*)(p.norm_gain + (j * 64 + lane) * 4);
#define PH0_PROC(V, t_) do { _Pragma("unroll") for (int u = 0; u < 4; ++u) { float ss = 0.f; \
        _Pragma("unroll") for (int j = 0; j < 4; ++j) ss += V[u][j].x * V[u][j].x + V[u][j].y * V[u][j].y + V[u][j].z * V[u][j].z + V[u][j].w * V[u][j].w; \
        ss = wave_sum(ss); const float r = rsqrtf(ss * (1.f / DM) + 1e-6f); \
        _Pragma("unroll") for (int j = 0; j < 4; ++j) { \
            uint2 o; o.x = (u32)f2bf(V[u][j].x * r * g[j].x) | ((u32)f2bf(V[u][j].y * r * g[j].y) << 16); o.y = (u32)f2bf(V[u][j].z * r * g[j].z) | ((u32)f2bf(V[u][j].w * r * g[j].w) << 16); \
            *(uint2*)(H + (size_t)((t_) + u) * DM + (j * 64 + lane) * 4) = o; } } } while (0)
    for (;;) {
        if (t >= NT) break;
        PH0_PROC(va, t); if (t + 2 * st < NT) PH0_LOAD(va, t + 2 * st); t += st;
        if (t >= NT) break;
        PH0_PROC(vb, t); if (t + 2 * st < NT) PH0_LOAD(vb, t + 2 * st); t += st;
    }
#undef PH0_LOAD
#undef PH0_PROC
}
__device__ __forceinline__ void ph1(const Params& p, PG8_LAS unsigned char* lds, unsigned* ctr) {
    pg8::Gemm g{(const bf16_t*)(p.ws + OFF_H), (const bf16_t*)(p.ws + OFF_WIN), NT, NP, DM, DM, DM}; pg8::ProjOrder S; S.init(NT, NP, gridDim.x, blockIdx.x); S.ctr = ctr;
    pg8::EpiProj E{(bf16_t*)(p.ws + OFF_PROJ), (bf16_t*)(p.ws + OFF_KI), (float*)(p.ws + OFF_WI), (const float*)(p.ws + OFF_ROPE), p.mla_q_norm, p.mla_kv_norm, p.dsa_k_gain,
                   (PG8_LAS float*)(lds + LDS_XCH)};
    pg8::gemm_phase<pg8::EpiProj, pg8::ProjOrder, true, true>(lds, g, S, E);
}
__device__ __forceinline__ void ph2b(const Params& p, PG8_LAS unsigned char* lds, const bool df) {
    const int bx = blockIdx.x, a = bx - 128;
    { pg8::Gemm g{(const bf16_t*)(p.ws + OFF_PROJ) + C_CQ, (const bf16_t*)(p.ws + OFF_WUQ), NT, 768, 256, NP, 256};
      pg8::ListOrder S{NT / 256, 3, df ? 0 : (int)gridDim.x, bx, a >= 0 ? a : -1, (a >= 0 && a < 64) ? 128 + a : -1};
      pg8::EpiBf16 E{(bf16_t*)((unsigned char*)p.out + OUT_QA), 768};
      pg8::gemm_phase<pg8::EpiBf16, pg8::ListOrder, true, true>(lds, g, S, E); }
    { pg8::Gemm g{(const bf16_t*)(p.ws + OFF_PROJ) + C_CKV, (const bf16_t*)(p.ws + OFF_WUKV), NT, 1024, 128, NP, 128};
      pg8::ListOrder S{NT / 256, 4, df ? 0 : (int)gridDim.x, bx, a >= 0 ? a : (bx < 64 ? 192 + bx : -1), a >= 64 ? 64 + a : -1};
      pg8::EpiKV E{(bf16_t*)((unsigned char*)p.out + OUT_KA), (bf16_t*)(p.ws + OFF_KVA), (const bf16_t*)(p.ws + OFF_PROJ), (const float*)(p.ws + OFF_ROPE), p.mla_k_gain, (PG8_LAS float*)(lds + LDS_XCH)};
      pg8::gemm_phase<pg8::EpiKV, pg8::ListOrder, true, true>(lds, g, S, E); }
}
__device__ __forceinline__ void ph3_sel(const Params& p, unsigned char* smem, volatile __attribute__((address_space(3))) unsigned* slot) {
    const bf16_t* proj = (const bf16_t*)(p.ws + OFF_PROJ); const bf16_t* ki = (const bf16_t*)(p.ws + OFF_KI); const float* wi = (const float*)(p.ws + OFF_WI); u64* M64 = (u64*)(p.ws + OFF_MASK);
    unsigned cnt = 0u;
#pragma unroll 1
    for (;;) {
        const int t = wg_ticket(&g_bar[BAR_QSEL], 512u, slot); if (t < 0) break;
        const int b = t & 3, qblk = 127 - (t >> 2);
        sel::sel_unit(b, qblk, proj, ki, wi, M64, smem); cnt += 1u << (8 * b);
    }
    asm volatile("s_waitcnt vmcnt(0)" ::: "memory");
    __syncthreads();
    if (threadIdx.x == 0) { __builtin_amdgcn_fence(__ATOMIC_RELEASE, "agent"); asm volatile("s_waitcnt vmcnt(0)" ::: "memory");
#pragma unroll
        for (int b = 0; b < 4; ++b) { const unsigned c = (cnt >> (8 * b)) & 255u; if (c) __hip_atomic_fetch_add(&g_bar[BAR_SEL + 16 * b], c, __ATOMIC_RELAXED, __HIP_MEMORY_SCOPE_AGENT); } }
}
__device__ __forceinline__ int attn_next(int& k, const int kmax, volatile __attribute__((address_space(3))) unsigned* slot) {
    while (k < kmax) { const int q = ((int)blockIdx.x + k) & 7; const int t = wg_ticket(&g_bar[BAR_QATT + 16 * q], 128u, slot); if (t >= 0) return q * 128 + t; ++k; }
    return -1;
}
struct AttnNext {
    int k, kmax, nxt; volatile __attribute__((address_space(3))) unsigned* slot; const bf16_t* qa; const bf16_t* proj;
    __device__ __forceinline__ void draw(const bf16_t*& qn, int& pqn, int& nd0n) {
        nxt = attn_next(k, kmax, slot); qn = nullptr; pqn = 768; nd0n = 6;
        if (nxt >= 0) { const int qln = nxt >> 7, in_ = nxt & 127, qbn = 15 - ((in_ & 63) >> 2), bn = qln >> 1, hn = 4 * (qln & 1) + (in_ & 3); const size_t rn = (size_t)bn * SEQ + (size_t)qbn * 256;
            if ((in_ >> 6) == 0) { qn = qa + rn * 768 + hn * 96; pqn = 768; nd0n = 6; } else { qn = proj + rn * NP + C_QB + hn * 64; pqn = NP; nd0n = 4; } }
    }
};
__device__ __forceinline__ void ph_attn(const Params& p, char* shm, const bool df, volatile __attribute__((address_space(3))) unsigned* slot) {
    const bf16_t* qa = (const bf16_t*)((unsigned char*)p.out + OUT_QA); const bf16_t* ka = (const bf16_t*)((unsigned char*)p.out + OUT_KA);
    const bf16_t* kva = (const bf16_t*)(p.ws + OFF_KVA); const bf16_t* proj = (const bf16_t*)(p.ws + OFF_PROJ); bf16_t* ao = (bf16_t*)(p.ws + OFF_AO); const float* rope = (const float*)(p.ws + OFF_ROPE);
    const u64* M64 = (const u64*)(p.ws + OFF_MASK);
    AttnNext nq; nq.k = 0; nq.kmax = (gridDim.x % 8 == 0) ? 1 : 8; nq.slot = slot; nq.qa = qa; nq.proj = proj;
    att::bf16x8 qpre[6];
    bool pre = false, p2ok = !df; unsigned selok = df ? 0u : 15u;
    int cur = attn_next(nq.k, nq.kmax, slot);
#pragma unroll 1
    while (cur >= 0) {
        const int ql = cur >> 7, i_ = cur & 127, type = i_ >> 6, qb = 15 - ((i_ & 63) >> 2), b = ql >> 1, kvh = ql & 1, h = 4 * kvh + (i_ & 3); const size_t r0 = (size_t)b * SEQ;
        if (!p2ok) { wg_wait(&g_bar[BAR_P2B], gridDim.x); p2ok = true; }
        if (type == 0) {
            att::attn_unit<96, 768, 768, 1024, 1024, NP, 0>(qb, qa + r0 * 768 + h * 96, ka + r0 * 768 + h * 96, kva + r0 * 1024 + h * 128 + 64,
                                                            ao + r0 * 1024 + h * 64, proj + r0 * NP + C_GA + h * 64, shm, nullptr, rope + r0 * 56, p.mla_q_gain,
                                                            qpre, pre, nq);
        } else {
            if (!((selok >> b) & 1u)) { wg_wait(&g_bar[BAR_SEL + 16 * b], 128u); selok |= 1u << b; }
            att::attn_unit<64, NP, NP, NP, 1024, NP, 1>(qb, proj + r0 * NP + C_QB + h * 64, proj + r0 * NP + C_KB + kvh * 64, proj + r0 * NP + C_VB + kvh * 64,
                                                        ao + r0 * 1024 + 512 + h * 64, proj + r0 * NP + C_GB + h * 64, shm, M64 + (size_t)b * 128 * 128 * 16, rope + r0 * 56, p.dsa_q_gain,
                                                        qpre, pre, nq);
        }
        pre = nq.nxt >= 0; cur = nq.nxt;
    }
}
__device__ __forceinline__ void ph5(const Params& p, PG8_LAS unsigned char* lds) {
    const bf16_t* ao = (const bf16_t*)(p.ws + OFF_AO); const bf16_t* wbr = (const bf16_t*)(p.ws + OFF_WBR);
    pg8::Gemm g{ao, wbr, NT, DM, DM, 1024, 1024}; pg8::StaticOrder S; S.init(NT, DM, gridDim.x, blockIdx.x);
    pg8::EpiGate2 E{(bf16_t*)(p.ws + OFF_MERGED), (const bf16_t*)(p.ws + OFF_PROJ), p.b_merge};
    pg8::gemm_phase<pg8::EpiGate2, pg8::StaticOrder, true, true>(lds, g, S, E);
}
__device__ __forceinline__ void ph6(const Params& p, PG8_LAS unsigned char* lds) {
    pg8::Gemm g{(const bf16_t*)(p.ws + OFF_MERGED), (const bf16_t*)(p.ws + OFF_WOUT), NT, DM, DM, DM, DM}; pg8::StaticOrder S; S.init(NT, DM, gridDim.x, blockIdx.x);
    pg8::EpiResid E{p.out, p.x};
    pg8::gemm_phase<pg8::EpiResid, pg8::StaticOrder, true, true>(lds, g, S, E);
}

__global__ void __launch_bounds__(NTHREADS, 2) fwd_kernel(Params p) {
    extern __shared__ __attribute__((aligned(16))) unsigned char smem[];
    PG8_LAS unsigned char* lds = (PG8_LAS unsigned char*)smem;
    volatile LAS unsigned* misc = (volatile LAS unsigned*)(lds + LDS_MISC);
    if (threadIdx.x < 2) misc[threadIdx.x] = 0u;
    __syncthreads();
    const XcdBarrier bar = xcd_barrier_post(g_bar, misc);
    ph0(p, smem); xcd_barrier(bar);
    const bool df = gridDim.x == 256;
    ph1(p, lds, df ? &g_bar[BAR_P1] : nullptr);
    { const int lw = df ? (int)blockIdx.x - 128 : (int)blockIdx.x; if (lw >= 0) late_weights(p, smem, lw, df ? 128 : (int)gridDim.x); }
    if (df) wg_wait(&g_bar[BAR_P1], gridDim.x); else xcd_barrier(bar);
    ph2b(p, lds, df); if (df) wg_signal(&g_bar[BAR_P2B], 1u);
    ph3_sel(p, smem, misc + 4);
    if (!df) xcd_barrier(bar);
    ph_attn(p, (char*)smem, df, misc + 4); xcd_barrier(bar);
    ph5(p, lds); xcd_barrier(bar);
    ph6(p, lds);
    __syncthreads();
    if (threadIdx.x == 0) { const unsigned d = __hip_atomic_fetch_add(&g_bar[BAR_DONE], 1u, __ATOMIC_RELAXED, __HIP_MEMORY_SCOPE_AGENT); misc[2] = (d + 1u == gridDim.x) ? 1u : 0u; }
    __syncthreads();
    if (misc[2] != 0u) for (int i = threadIdx.x; i < BAR_WORDS; i += NTHREADS) __hip_atomic_store(&g_bar[i], 0u, __ATOMIC_RELAXED, __HIP_MEMORY_SCOPE_AGENT);
}

extern "C" void kernel_launch(void* const* d_in, const int* in_sizes, int n_in, void* d_out, int out_size, void* d_ws, size_t ws_size, hipStream_t stream) {
    static int grid_blocks = 0;
    if (!grid_blocks) {
        int dev = 0, cus = 0, per_cu = 0;
        hipGetDevice(&dev);
        hipDeviceGetAttribute(&cus, hipDeviceAttributeMultiprocessorCount, dev);
        hipFuncSetAttribute((const void*)fwd_kernel, hipFuncAttributeMaxDynamicSharedMemorySize, LDS_BYTES);
        hipOccupancyMaxActiveBlocksPerMultiprocessor(&per_cu, (const void*)fwd_kernel, NTHREADS, LDS_BYTES);
        if (per_cu < 1) per_cu = 1;
        grid_blocks = cus * per_cu;
    }
    Params p{};
    p.x = (const float*)d_in[0]; p.pos = (const int*)d_in[1]; p.norm_gain = (const float*)d_in[2]; p.w_in = (const float*)d_in[3]; p.b_merge = (const float*)d_in[4];
    p.mla_q_norm = (const float*)d_in[5]; p.w_uq = (const float*)d_in[6]; p.mla_kv_norm = (const float*)d_in[7]; p.w_ukv = (const float*)d_in[8];
    p.mla_q_gain = (const float*)d_in[9]; p.mla_k_gain = (const float*)d_in[10]; p.dsa_q_gain = (const float*)d_in[11]; p.dsa_k_gain = (const float*)d_in[12];
    p.w_br_mla = (const float*)d_in[13]; p.w_br_dsa = (const float*)d_in[14]; p.w_out = (const float*)d_in[15];
    p.out = (float*)d_out; p.ws = (unsigned char*)d_ws;
    void* args[] = {&p};
    hipError_t e = hipLaunchCooperativeKernel((const void*)fwd_kernel, dim3(grid_blocks), dim3(NTHREADS), args, LDS_BYTES, stream);
    if (e != hipSuccess) fprintf(stderr, "cooperative launch failed: %s (grid %d)\n", hipGetErrorString(e), grid_blocks);
}
```

```cpp
#include <hip/hip_runtime.h>
#include <cstdio>

typedef unsigned short bf16_t;
typedef unsigned int u32;
typedef unsigned long long u64;

constexpr int NB = 4, SEQ = 4096, NT = NB * SEQ, DM = 1024, DIN = 4552, NP = 4608;
constexpr int C_CQ = 0, C_CKV = 256, C_KPE = 384, C_KI = 416, C_WI = 448, C_GA = 512, C_QB = 1024, C_KB = 1536, C_VB = 1664,
              C_GB = 1792, C_QI = 2304, C_MA = 2560, C_MB = 3584;
constexpr size_t MiB = 1u << 20;
constexpr size_t OFF_WIN = 0, OFF_WUQ = 9 * MiB, OFF_WUKV = 9 * MiB + 512 * 1024, OFF_WBR = 10 * MiB, OFF_WOUT = 12 * MiB,
                 OFF_ROPE = 14 * MiB, OFF_WI = 17 * MiB + 512 * 1024, OFF_H = 18 * MiB, OFF_AO = 18 * MiB, OFF_PROJ = 50 * MiB,
                 OFF_KVA = 206 * MiB, OFF_MERGED = 206 * MiB, OFF_MASK = 238 * MiB, OFF_KI = 246 * MiB;
constexpr int BAR_WORDS = 3776, BAR_DONE = 3520;
constexpr int BAR_QSEL = 3632, BAR_QATT = 3648;
constexpr int BAR_P1 = 3536, BAR_P2B = 3552, BAR_SEL = 3568;
__device__ unsigned g_bar[BAR_WORDS];
constexpr int LDS_MISC = 131072 + 512;
constexpr int LDS_XCH = 131072 + 1024;
constexpr size_t OUT_QA = 0, OUT_KA = 24 * MiB;
constexpr int LDS_BYTES = 147456;
constexpr int NTHREADS = 512;

struct Params {
    const float* x; const int* pos; const float* norm_gain; const float* w_in; const float* b_merge;
    const float* mla_q_norm; const float* w_uq; const float* mla_kv_norm; const float* w_ukv;
    const float* mla_q_gain; const float* mla_k_gain; const float* dsa_q_gain; const float* dsa_k_gain;
    const float* w_br_mla; const float* w_br_dsa; const float* w_out;
    float* out; unsigned char* ws;
};

__device__ const float c_inv_freq[28] = {
    1.000000000e+00f, 4.403665960e-01f, 1.939227432e-01f, 8.539710194e-02f, 3.760603070e-02f, 1.656044088e-02f, 7.292664610e-03f, 3.211446106e-03f,
    1.414213562e-03f, 6.227724371e-04f, 2.742481884e-04f, 1.207697351e-04f, 5.318295734e-05f, 2.341999971e-05f, 1.031338525e-05f, 4.541670478e-06f,
    1.000000000e+00f, 1.939227432e-01f, 3.760603070e-02f, 7.292664610e-03f, 1.414213562e-03f, 2.742481884e-04f, 5.318295734e-05f, 1.031338525e-05f,
    1.000000000e+00f, 3.760603070e-02f, 1.414213562e-03f, 5.318295734e-05f};

__device__ __forceinline__ void wg_signal(unsigned* ctr, unsigned inc) {
    asm volatile("s_waitcnt vmcnt(0)" ::: "memory");
    __syncthreads();
    if (threadIdx.x == 0) { __builtin_amdgcn_fence(__ATOMIC_RELEASE, "agent"); asm volatile("s_waitcnt vmcnt(0)" ::: "memory");
        __hip_atomic_fetch_add(ctr, inc, __ATOMIC_RELAXED, __HIP_MEMORY_SCOPE_AGENT); }
}
__device__ __forceinline__ void wg_wait(unsigned* ctr, unsigned target) {
    if (threadIdx.x == 0) { unsigned sp = 0u;
        while (__hip_atomic_load(ctr, __ATOMIC_RELAXED, __HIP_MEMORY_SCOPE_AGENT) < target) { __builtin_amdgcn_s_sleep(2); if (++sp > (1u << 24)) break; }
        __builtin_amdgcn_fence(__ATOMIC_ACQUIRE, "agent"); asm volatile("s_waitcnt vmcnt(0)" ::: "memory"); }
    __syncthreads();
}
__device__ __forceinline__ int wg_ticket(unsigned* ctr, unsigned limit, volatile __attribute__((address_space(3))) unsigned* slot) {
    __syncthreads();
    if (threadIdx.x == 0) *slot = __hip_atomic_fetch_add(ctr, 1u, __ATOMIC_RELAXED, __HIP_MEMORY_SCOPE_AGENT);
    __syncthreads();
    const unsigned v = (unsigned)__builtin_amdgcn_readfirstlane((int)*slot);
    return v < limit ? (int)v : -1;
}
__device__ __forceinline__ unsigned ticket_issue(unsigned* ctr) {
    unsigned tv = 0u; if (threadIdx.x == 0) tv = __hip_atomic_fetch_add(ctr, 1u, __ATOMIC_RELAXED, __HIP_MEMORY_SCOPE_AGENT);
    return tv;
}
__device__ __forceinline__ unsigned ticket_collect(unsigned tv, volatile __attribute__((address_space(3))) unsigned* slot) {
    if (threadIdx.x == 0) *slot = tv;
    __syncthreads();
    return (unsigned)__builtin_amdgcn_readfirstlane((int)*slot);
}
__device__ __forceinline__ int opaque_tid() { int t = threadIdx.x; asm volatile("" : "+v"(t)); return t; }
__device__ __forceinline__ float bf2f(bf16_t v) { return __uint_as_float(((u32)v) << 16); }
__device__ __forceinline__ bf16_t f2bf(float f) { u32 u = __float_as_uint(f); return (bf16_t)((u + 0x7fffu + ((u >> 16) & 1u)) >> 16); }
__device__ __forceinline__ float wave_sum(float v) {
#pragma unroll
    for (int o = 1; o < 64; o <<= 1) v += __shfl_xor(v, o);
    return v;
}
__device__ __forceinline__ float wave_max(float v) {
#pragma unroll
    for (int o = 1; o < 64; o <<= 1) v = fmaxf(v, __shfl_xor(v, o));
    return v;
}
__device__ __forceinline__ int oldcol(int n) {
    if (n < 416) return n;
    if (n < 448) return 2464 + (n - 416);
    if (n < 456) return 2496 + (n - 448);
    if (n < 512) return -1;
    if (n < 1024) return 416 + (n - 512);
    if (n < 1536) return 928 + (n - 1024);
    if (n < 1664) return 1440 + (n - 1536);
    if (n < 1792) return 1568 + (n - 1664);
    if (n < 2304) return 1696 + (n - 1792);
    if (n < 2560) return 2208 + (n - 2304);
    if (n < 3584) return 2504 + (n - 2560);
    return 3528 + (n - 3584);
}
__device__ __forceinline__ void sincos_d(double x, double& s, double& c) {
    const double two_over_pi = 0.63661977236758134308, pio2_hi = 1.57079632679489655800e+00, pio2_lo = 6.12323399573676603587e-17;
    const double q = rint(x * two_over_pi);
    double r = fma(-q, pio2_hi, x); r = fma(-q, pio2_lo, r);
    const double r2 = r * r;
    double sp = 1.0 / 1307674368000.0;
    sp = fma(sp, r2, -1.0 / 6227020800.0);
    sp = fma(sp, r2, 1.0 / 39916800.0);
    sp = fma(sp, r2, -1.0 / 362880.0);
    sp = fma(sp, r2, 1.0 / 5040.0);
    sp = fma(sp, r2, -1.0 / 120.0);
    sp = fma(sp, r2, 1.0 / 6.0);
    sp = fma(sp, -r2, 1.0);
    const double sr = sp * r;
    double cp = 1.0 / 20922789888000.0;
    cp = fma(cp, r2, -1.0 / 87178291200.0);
    cp = fma(cp, r2, 1.0 / 479001600.0);
    cp = fma(cp, r2, -1.0 / 3628800.0);
    cp = fma(cp, r2, 1.0 / 40320.0);
    cp = fma(cp, r2, -1.0 / 720.0);
    cp = fma(cp, r2, 1.0 / 24.0);
    cp = fma(cp, r2, -0.5);
    const double cr = fma(cp, r2, 1.0);
    const int n = ((int)q) & 3;
    s = (n == 0) ? sr : (n == 1) ? cr : (n == 2) ? -sr : -cr;
    c = (n == 0) ? cr : (n == 1) ? -sr : (n == 2) ? -cr : sr;
}

__device__ __forceinline__ void unpack8(const uint4 w, float (&f)[8]) {
    f[0] = __uint_as_float(w.x << 16); f[1] = __uint_as_float(w.x & 0xffff0000u);
    f[2] = __uint_as_float(w.y << 16); f[3] = __uint_as_float(w.y & 0xffff0000u);
    f[4] = __uint_as_float(w.z << 16); f[5] = __uint_as_float(w.z & 0xffff0000u);
    f[6] = __uint_as_float(w.w << 16); f[7] = __uint_as_float(w.w & 0xffff0000u);
}

namespace pg8 {
#define PG8_LAS __attribute__((address_space(3)))
typedef unsigned short bf16_t;
typedef short bf16x8 __attribute__((ext_vector_type(8)));
typedef float f32x4 __attribute__((ext_vector_type(4)));
typedef unsigned u32x4 __attribute__((ext_vector_type(4)));
constexpr int BM = 256, BK = 64, HALF = 128, HTB = HALF * BK * 2  , STAGE_BYTES = 8 * HTB, NXCD = 8, WGM = 8;

__host__ __device__ __forceinline__ int lds_byte(int r, int c) { const int st = (r >> 4) * 2 + (c >> 5), rr = r & 15, cc = c & 31, ob = rr * 64 + cc * 2; return st * 1024 + (ob ^ (((ob >> 9) & 1) << 5)); }
__host__ __device__ __forceinline__ void stage_rc(int b, int& R, int& C) { const int st = b / 1024, sb = b % 1024, swz = sb ^ (((sb >> 9) & 1) << 5); R = (st >> 1) * 16 + swz / 64; C = (st & 1) * 32 + (swz % 64) / 2; }
__host__ __device__ __forceinline__ int perm32(int rho) { const int n = rho >> 4, i = rho & 15; return 8 * (i >> 2) + 4 * n + (i & 3); }

struct Unit { int pm, pn; };
struct Gemm { const bf16_t* A; const bf16_t* Bt; int M, N, K, lda, ldb; };

struct StaticOrder {
    int nM, nN, nwg, G, c;
    __host__ __device__ void init(int M, int N, int G_, int c_) { nM = M / BM; nN = N / BM; nwg = nM * nN; G = G_; c = c_; }
    __host__ __device__ bool next(int i, Unit& u) const {
        const long L = (long)i * G + c; if (L >= nwg) return false;
        int wgid = (int)L; { const int q = nwg / NXCD, r = nwg % NXCD, xcd = wgid % NXCD, off = wgid / NXCD; wgid = (xcd < r ? xcd * (q + 1) : r * (q + 1) + (xcd - r) * q) + off; }
        const int nig = WGM * nN, gid = wgid / nig, fm = gid * WGM, gsz = (nM - fm) < WGM ? (nM - fm) : WGM;
        u.pm = fm + ((wgid % nig) % gsz); u.pn = (wgid % nig) / gsz; return true;
    }
    __device__ __forceinline__ void a_ready(const Unit&) const {}
    __device__ __forceinline__ void done(const Unit&) const {}
};
struct ProjOrder : StaticOrder {
    unsigned* ctr;
    __device__ __forceinline__ void done(const Unit& u) const { if (ctr && u.pn >= 8 && u.pn < 12) wg_signal(ctr, 1u); }
};
struct ListOrder {
    int nM, nN, G, c, id0, id1;
    __host__ __device__ bool next(int i, Unit& u) const {
        int L; if (G > 0) { L = i * G + c; if (L >= nM * nN) return false; } else { L = i == 0 ? id0 : (i == 1 ? id1 : -1); if (L < 0) return false; }
        u.pm = L / nN; u.pn = L % nN; return true;
    }
    __device__ __forceinline__ void a_ready(const Unit&) const {}
    __device__ __forceinline__ void done(const Unit&) const {}
};


__device__ __forceinline__ unsigned cvt_pk_bf16(float lo, float hi) { unsigned r; asm volatile("v_cvt_pk_bf16_f32 %0, %1, %2" : "=v"(r) : "v"(lo), "v"(hi)); return r; }
struct EpiBf16 {
    static constexpr bool PERM = true, AFTER_DRAIN = false, MID = false;
    bf16_t* O; int ldc;
    __device__ __forceinline__ void operator()(const f32x4 (&acc)[2][2][4][2], const Unit& u, int wr, int wc, int fr, int fq) const {
        const int row0 = u.pm * BM + wr * 64 + fr, col0 = u.pn * BM + wc * 32 + 8 * fq;
#pragma unroll
        for (int ai = 0; ai < 2; ++ai)
#pragma unroll
            for (int m = 0; m < 4; ++m) { bf16_t* rowp = O + (size_t)(row0 + ai * HALF + m * 16) * ldc + col0;
#pragma unroll
                for (int bj = 0; bj < 2; ++bj) { const f32x4 v0 = acc[ai][bj][m][0], v1 = acc[ai][bj][m][1];
                    u32x4 w; w.x = cvt_pk_bf16(v0[0], v0[1]); w.y = cvt_pk_bf16(v0[2], v0[3]); w.z = cvt_pk_bf16(v1[0], v1[1]); w.w = cvt_pk_bf16(v1[2], v1[3]);
                    *(u32x4*)(rowp + bj * HALF) = w; } }
    }
};
struct EpiProj {
    static constexpr bool PERM = true, AFTER_DRAIN = false, MID = false;
    bf16_t* proj; bf16_t* kic; float* wi; const float* rope; const float* gq; const float* gkv; const float* gkb; PG8_LAS float* xch;
    __device__ __forceinline__ static void st8v(bf16_t* p, const f32x4 a, const f32x4 b) {
        u32x4 w; w.x = cvt_pk_bf16(a[0], a[1]); w.y = cvt_pk_bf16(a[2], a[3]); w.z = cvt_pk_bf16(b[0], b[1]); w.w = cvt_pk_bf16(b[2], b[3]); *(u32x4*)p = w; }
    __device__ __forceinline__ void operator()(const f32x4 (&acc)[2][2][4][2], const Unit& u, int wr, int wc, int fr, int fq) const {
        const int pn = u.pn; const int rowb = u.pm * BM + wr * 64 + fr;
        const bool normt = (pn == 0) | (pn == 1) | (pn == 6);
        if (normt) {
#pragma unroll
            for (int ai = 0; ai < 2; ++ai)
#pragma unroll
                for (int m = 0; m < 4; ++m) {
                    float s = 0.f;
#pragma unroll
                    for (int n = 0; n < 2; ++n)
#pragma unroll
                        for (int j = 0; j < 4; ++j) { s = __builtin_fmaf(acc[ai][0][m][n][j], acc[ai][0][m][n][j], s); if (pn == 0) s = __builtin_fmaf(acc[ai][1][m][n][j], acc[ai][1][m][n][j], s); }
                    s += __shfl_xor(s, 16); s += __shfl_xor(s, 32);
                    if (fq == 0) xch[(ai * HALF + wr * 64 + m * 16 + fr) * 4 + wc] = s;
                }
            asm volatile("s_waitcnt lgkmcnt(0)" ::: "memory"); __builtin_amdgcn_s_barrier(); asm volatile("" ::: "memory");
        }
#pragma unroll
        for (int ai = 0; ai < 2; ++ai)
#pragma unroll
            for (int m = 0; m < 4; ++m) {
                const int rl = ai * HALF + wr * 64 + m * 16 + fr; const size_t row = (size_t)(rowb + ai * HALF + m * 16);
                bf16_t* prow = proj + row * NP; const float* cs = rope + row * 56;
                f32x4 a0 = acc[ai][0][m][0], a1 = acc[ai][0][m][1], b0 = acc[ai][1][m][0], b1 = acc[ai][1][m][1];
                const int c = wc * 32 + 8 * fq;
                if (pn == 0) {
                    const f32x4 pp = *(const PG8_LAS f32x4*)(xch + rl * 4); const float r = rsqrtf(((pp[0] + pp[1]) + (pp[2] + pp[3])) * (1.f / 256.f) + 1e-6f);
                    const f32x4 g0 = *(const f32x4*)(gq + c), g1 = *(const f32x4*)(gq + c + 4), g2 = *(const f32x4*)(gq + 128 + c), g3 = *(const f32x4*)(gq + 128 + c + 4);
                    st8v(prow + C_CQ + c, a0 * r * g0, a1 * r * g1); st8v(prow + C_CQ + 128 + c, b0 * r * g2, b1 * r * g3);
                } else if (pn == 1) {
                    const f32x4 pp = *(const PG8_LAS f32x4*)(xch + rl * 4); const float r = rsqrtf(((pp[0] + pp[1]) + (pp[2] + pp[3])) * (1.f / 128.f) + 1e-6f);
                    const f32x4 g0 = *(const f32x4*)(gkv + c), g1 = *(const f32x4*)(gkv + c + 4);
                    st8v(prow + C_CKV + c, a0 * r * g0, a1 * r * g1);
                    if (wc == 0) st8v(prow + C_KPE + 8 * fq, b0, b1);
                    else if (wc == 1) {
                        if (fq == 0) { const f32x4 c0 = *(const f32x4*)(cs + 48), c1 = *(const f32x4*)(cs + 52);
                            const f32x4 x1 = b0, x2 = b1;
                            b0[0] = x1[0] * c0[0] - x2[0] * c0[1]; b1[0] = x2[0] * c0[0] + x1[0] * c0[1]; b0[1] = x1[1] * c0[2] - x2[1] * c0[3]; b1[1] = x2[1] * c0[2] + x1[1] * c0[3];
                            b0[2] = x1[2] * c1[0] - x2[2] * c1[1]; b1[2] = x2[2] * c1[0] + x1[2] * c1[1]; b0[3] = x1[3] * c1[2] - x2[3] * c1[3]; b1[3] = x2[3] * c1[2] + x1[3] * c1[3]; }
                        st8v(kic + row * 32 + 8 * fq, b0, b1);
                    } else if (wc == 2 && fq == 0) { *(f32x4*)(wi + row * 8) = b0 * 0.0625f; *(f32x4*)(wi + row * 8 + 4) = b1 * 0.0625f; }
                } else if (pn == 6) {
                    const f32x4 pp = *(const PG8_LAS f32x4*)(xch + rl * 4); const float tot = (wc & 2) ? (pp[2] + pp[3]) : (pp[0] + pp[1]); const float r = rsqrtf(tot * (1.f / 64.f) + 1e-6f);
                    const int d = (wc & 1) * 32 + 8 * fq;
                    const f32x4 g0 = *(const f32x4*)(gkb + d), g1 = *(const f32x4*)(gkb + d + 4);
                    a0 = a0 * r * g0; a1 = a1 * r * g1;
                    {
                        f32x4 p0, p1;
#pragma unroll
                        for (int j = 0; j < 4; ++j) { p0[j] = __shfl_xor(a0[j], 16); p1[j] = __shfl_xor(a1[j], 16); }
                        if ((wc & 1) == 0 && fq < 2) {
                            const f32x4 c0 = *(const f32x4*)(cs + 32), c1 = *(const f32x4*)(cs + 36), c2 = *(const f32x4*)(cs + 40), c3 = *(const f32x4*)(cs + 44);
                            const float sg = fq == 0 ? -1.f : 1.f;
                            a0[0] = a0[0] * c0[0] + sg * p0[0] * c0[1]; a0[1] = a0[1] * c0[2] + sg * p0[1] * c0[3]; a0[2] = a0[2] * c1[0] + sg * p0[2] * c1[1]; a0[3] = a0[3] * c1[2] + sg * p0[3] * c1[3];
                            a1[0] = a1[0] * c2[0] + sg * p1[0] * c2[1]; a1[1] = a1[1] * c2[2] + sg * p1[1] * c2[3]; a1[2] = a1[2] * c3[0] + sg * p1[2] * c3[1]; a1[3] = a1[3] * c3[2] + sg * p1[3] * c3[3];
                        }
                    }
                    st8v(prow + C_KB + (wc >> 1) * 64 + d, a0, a1);
                    st8v(prow + C_VB + c, b0, b1);
                } else if (pn == 9) {
                    if (fq == 0) { const f32x4 c0 = *(const f32x4*)(cs + 48), c1 = *(const f32x4*)(cs + 52);
#pragma unroll
                        for (int hb = 0; hb < 2; ++hb) { f32x4& x1r = hb ? b0 : a0; f32x4& x2r = hb ? b1 : a1; const f32x4 x1 = x1r, x2 = x2r;
                            x1r[0] = x1[0] * c0[0] - x2[0] * c0[1]; x2r[0] = x2[0] * c0[0] + x1[0] * c0[1]; x1r[1] = x1[1] * c0[2] - x2[1] * c0[3]; x2r[1] = x2[1] * c0[2] + x1[1] * c0[3];
                            x1r[2] = x1[2] * c1[0] - x2[2] * c1[1]; x2r[2] = x2[2] * c1[0] + x1[2] * c1[1]; x1r[3] = x1[3] * c1[2] - x2[3] * c1[3]; x2r[3] = x2[3] * c1[2] + x1[3] * c1[3]; } }
                    st8v(prow + C_QI + c, a0, a1); st8v(prow + C_QI + 128 + c, b0, b1);
                } else {
                    st8v(prow + pn * 256 + c, a0, a1); st8v(prow + pn * 256 + 128 + c, b0, b1);
                }
            }
    }
};
struct EpiKV {
    static constexpr bool PERM = true, AFTER_DRAIN = false, MID = false;
    bf16_t* ka; bf16_t* kva; const bf16_t* proj; const float* rope; const float* gk; PG8_LAS float* xch;
    __device__ __forceinline__ void operator()(const f32x4 (&acc)[2][2][4][2], const Unit& u, int wr, int wc, int fr, int fq) const {
        const int pn = u.pn; const int rowb = u.pm * BM + wr * 64 + fr;
#pragma unroll
        for (int ai = 0; ai < 2; ++ai)
#pragma unroll
            for (int m = 0; m < 4; ++m) {
                const int rl = ai * HALF + wr * 64 + m * 16 + fr; const size_t row = (size_t)(rowb + ai * HALF + m * 16);
                if (wc < 2) {
#pragma unroll
                    for (int bj = 0; bj < 2; ++bj) { float s = 0.f;
#pragma unroll
                        for (int n = 0; n < 2; ++n)
#pragma unroll
                            for (int j = 0; j < 4; ++j) s = __builtin_fmaf(acc[ai][bj][m][n][j], acc[ai][bj][m][n][j], s);
                        s += __shfl_xor(s, 16); s += __shfl_xor(s, 32);
                        if (fq == 0) xch[(rl * 2 + bj) * 4 + wc] = s; }
                } else if (wc == 2) {
                    const u32x4 w = *(const u32x4*)(proj + row * NP + C_KPE + 8 * fq);
                    const f32x4 q0 = (f32x4){__uint_as_float(w.x << 16), __uint_as_float(w.x & 0xffff0000u), __uint_as_float(w.y << 16), __uint_as_float(w.y & 0xffff0000u)};
                    const f32x4 q1 = (f32x4){__uint_as_float(w.z << 16), __uint_as_float(w.z & 0xffff0000u), __uint_as_float(w.w << 16), __uint_as_float(w.w & 0xffff0000u)};
                    float s = 0.f;
#pragma unroll
                    for (int j = 0; j < 4; ++j) { s = __builtin_fmaf(q0[j], q0[j], s); s = __builtin_fmaf(q1[j], q1[j], s); }
                    s += __shfl_xor(s, 16); s += __shfl_xor(s, 32);
                    if (fq == 0) { xch[(rl * 2 + 0) * 4 + 2] = s; xch[(rl * 2 + 1) * 4 + 2] = s; }
                }
            }
        asm volatile("s_waitcnt lgkmcnt(0)" ::: "memory"); __builtin_amdgcn_s_barrier(); asm volatile("" ::: "memory");
#pragma unroll
        for (int ai = 0; ai < 2; ++ai)
#pragma unroll
            for (int m = 0; m < 4; ++m) {
                const int rl = ai * HALF + wr * 64 + m * 16 + fr; const size_t row = (size_t)(rowb + ai * HALF + m * 16);
                f32x4 pe0 = {0.f, 0.f, 0.f, 0.f}, pe1 = {0.f, 0.f, 0.f, 0.f};
                if (wc == 2) {
                    const u32x4 w = *(const u32x4*)(proj + row * NP + C_KPE + 8 * fq);
                    pe0 = (f32x4){__uint_as_float(w.x << 16), __uint_as_float(w.x & 0xffff0000u), __uint_as_float(w.y << 16), __uint_as_float(w.y & 0xffff0000u)};
                    pe1 = (f32x4){__uint_as_float(w.z << 16), __uint_as_float(w.z & 0xffff0000u), __uint_as_float(w.w << 16), __uint_as_float(w.w & 0xffff0000u)};
                }
#pragma unroll
                for (int bj = 0; bj < 2; ++bj) {
                    const int h = 2 * pn + bj;
                    const f32x4 a0 = acc[ai][bj][m][0], a1 = acc[ai][bj][m][1];
                    if (wc >= 2) EpiProj::st8v(kva + row * 1024 + h * 128 + 64 + (wc - 2) * 32 + 8 * fq, a0, a1);
                    if (wc <= 2) {
                        const f32x4 pp = *(const PG8_LAS f32x4*)(xch + (rl * 2 + bj) * 4); const float r = rsqrtf((pp[0] + pp[1] + pp[2]) * (1.f / 96.f) + 1e-6f);
                        if (wc < 2) { const int d = wc * 32 + 8 * fq; const f32x4 g0 = *(const f32x4*)(gk + d), g1 = *(const f32x4*)(gk + d + 4);
                            EpiProj::st8v(ka + row * 768 + h * 96 + d, a0 * r * g0, a1 * r * g1);
                        } else {
                            const int d = 64 + 8 * fq; const f32x4 g0 = *(const f32x4*)(gk + d), g1 = *(const f32x4*)(gk + d + 4);
                            f32x4 y0 = pe0 * r * g0, y1 = pe1 * r * g1, p0, p1;
#pragma unroll
                            for (int j = 0; j < 4; ++j) { p0[j] = __shfl_xor(y0[j], 32); p1[j] = __shfl_xor(y1[j], 32); }
                            const float* cs = rope + row * 56 + (fq & 1) * 16;
                            const f32x4 c0 = *(const f32x4*)(cs), c1 = *(const f32x4*)(cs + 4), c2 = *(const f32x4*)(cs + 8), c3 = *(const f32x4*)(cs + 12);
                            const float sg = fq < 2 ? -1.f : 1.f;
                            y0[0] = y0[0] * c0[0] + sg * p0[0] * c0[1]; y0[1] = y0[1] * c0[2] + sg * p0[1] * c0[3]; y0[2] = y0[2] * c1[0] + sg * p0[2] * c1[1]; y0[3] = y0[3] * c1[2] + sg * p0[3] * c1[3];
                            y1[0] = y1[0] * c2[0] + sg * p1[0] * c2[1]; y1[1] = y1[1] * c2[2] + sg * p1[1] * c2[3]; y1[2] = y1[2] * c3[0] + sg * p1[2] * c3[1]; y1[3] = y1[3] * c3[2] + sg * p1[3] * c3[3];
                            EpiProj::st8v(ka + row * 768 + h * 96 + d, y0, y1);
                        }
                    }
                }
            }
    }
};
__device__ __forceinline__ float expneg_c(float v) { return __expf(-__builtin_fminf(__builtin_fmaxf(v, -80.f), 80.f)); }
struct EpiGate2 {
    static constexpr bool PERM = true, AFTER_DRAIN = false, MID = true;
    bf16_t* O; const bf16_t* proj; const float* bias;
    __device__ __forceinline__ void mid(f32x4 (&acc)[2][2][4][2], const Unit& u, int wr, int wc, int fr, int fq) const {
        int row0 = u.pm * BM + wr * 64 + fr, col0 = u.pn * BM + wc * 32 + 8 * fq;
        asm volatile("" : "+v"(row0), "+v"(col0));
#pragma unroll
        for (int bj = 0; bj < 2; ++bj) { const int col = col0 + bj * HALF;
            f32x4 ba[2], bb[2];
#pragma unroll
            for (int n = 0; n < 2; ++n) { ba[n] = *(const f32x4*)(bias + col + 4 * n); bb[n] = *(const f32x4*)(bias + 1024 + col + 4 * n); }
#pragma unroll
            for (int ai = 0; ai < 2; ++ai) {
                u32x4 wa[4], wb[4];
#pragma unroll
                for (int m = 0; m < 4; ++m) { const size_t row = (size_t)(row0 + ai * HALF + m * 16); wa[m] = *(const u32x4*)(proj + row * NP + C_MA + col); wb[m] = *(const u32x4*)(proj + row * NP + C_MB + col); }
#pragma unroll
                for (int m = 0; m < 4; ++m) {
#pragma unroll
                    for (int e = 0; e < 4; ++e) {
                        const float ea0 = expneg_c(__uint_as_float(wa[m][e] << 16) + ba[e >> 1][(2 * e) & 3]), ea1 = expneg_c(__uint_as_float(wa[m][e] & 0xffff0000u) + ba[e >> 1][(2 * e + 1) & 3]);
                        const float eb0 = expneg_c(__uint_as_float(wb[m][e] << 16) + bb[e >> 1][(2 * e) & 3]), eb1 = expneg_c(__uint_as_float(wb[m][e] & 0xffff0000u) + bb[e >> 1][(2 * e + 1) & 3]);
                        acc[ai][bj][m][e >> 1][(2 * e) & 3] *= (1.f + eb0) * __builtin_amdgcn_rcpf(1.f + ea0);
                        acc[ai][bj][m][e >> 1][(2 * e + 1) & 3] *= (1.f + eb1) * __builtin_amdgcn_rcpf(1.f + ea1);
                    } }
                asm volatile("" ::: "memory"); }
        }
    }
    __device__ __forceinline__ void operator()(const f32x4 (&acc)[2][2][4][2], const Unit& u, int wr, int wc, int fr, int fq) const {
        const int row0 = u.pm * BM + wr * 64 + fr, col0 = u.pn * BM + wc * 32 + 8 * fq;
#pragma unroll
        for (int bj = 0; bj < 2; ++bj) { const int col = col0 + bj * HALF;
            f32x4 bb[2];
#pragma unroll
            for (int n = 0; n < 2; ++n) bb[n] = *(const f32x4*)(bias + 1024 + col + 4 * n);
            u32x4 wbq[8];
#pragma unroll
            for (int q = 0; q < 8; ++q) { const size_t row = (size_t)(row0 + (q >> 2) * HALF + (q & 3) * 16); wbq[q] = *(const u32x4*)(proj + row * NP + C_MB + col); }
#pragma unroll
            for (int q = 0; q < 8; ++q) { const size_t row = (size_t)(row0 + (q >> 2) * HALF + (q & 3) * 16); const u32x4 wb = wbq[q]; u32x4 w;
#pragma unroll
                    for (int e = 0; e < 4; ++e) {
                        const float g0 = __builtin_amdgcn_rcpf(1.f + expneg_c(__uint_as_float(wb[e] << 16) + bb[e >> 1][(2 * e) & 3])), g1 = __builtin_amdgcn_rcpf(1.f + expneg_c(__uint_as_float(wb[e] & 0xffff0000u) + bb[e >> 1][(2 * e + 1) & 3]));
                        w[e] = cvt_pk_bf16(acc[q >> 2][bj][q & 3][e >> 1][(2 * e) & 3] * g0, acc[q >> 2][bj][q & 3][e >> 1][(2 * e + 1) & 3] * g1);
                    }
                    *(u32x4*)(O + row * 1024 + col) = w; }
        }
    }
};
struct EpiResid {
    static constexpr bool PERM = true, AFTER_DRAIN = false, MID = false;
    float* out; const float* x;
    __device__ __forceinline__ void operator()(const f32x4 (&acc)[2][2][4][2], const Unit& u, int wr, int wc, int fr, int fq) const {
        const int row0 = u.pm * BM + wr * 64 + fr, col0 = u.pn * BM + wc * 32 + 8 * fq;
#pragma unroll
        for (int ai = 0; ai < 2; ++ai)
#pragma unroll
            for (int m = 0; m < 4; ++m) { const size_t row = (size_t)(row0 + ai * HALF + m * 16);
#pragma unroll
                for (int bj = 0; bj < 2; ++bj) { const size_t o = row * 1024 + col0 + bj * HALF;
                    *(f32x4*)(out + o) = *(const f32x4*)(x + o) + acc[ai][bj][m][0];
                    *(f32x4*)(out + o + 4) = *(const f32x4*)(x + o + 4) + acc[ai][bj][m][1]; } }
    }
};

template <class Epi, class Sched, bool ALIGN_EPI = false, bool SP2 = false>
__device__ __forceinline__ void gemm_phase(PG8_LAS unsigned char* lds, const Gemm g, const Sched& S, const Epi& E) {
    const int tid = opaque_tid(), wid = __builtin_amdgcn_readfirstlane(tid >> 6), lane = tid & 63, wr = wid >> 2, wc = wid & 3, fr = lane & 15, fq = lane >> 4;
    int K = g.K; asm volatile("" : "+s"(K));
    const int nt = K / BK;
    unsigned voffA[2], voffB[2];
#pragma unroll
    for (int i = 0; i < 2; ++i) { int R, C; stage_rc(tid * 16 + i * 8192, R, C); const int Rb = Epi::PERM ? ((R & ~31) + perm32(R & 31)) : R;
        voffA[i] = (unsigned)(R * g.lda + C) * 2u; voffB[i] = (unsigned)(Rb * g.ldb + C) * 2u; }
    const size_t kstep = (size_t)(BK * 2);
    const size_t hstepA = (size_t)HALF * g.lda * 2, hstepB = (size_t)HALF * g.ldb * 2;
    const size_t tstepA = 2 * hstepA, tstepB = 2 * hstepB;
    const unsigned ldsw = (unsigned)wid * 1024u;
    const int aoff = lds_byte(wr * 64 + fr, fq * 8), boff = lds_byte(wc * 32 + fr, fq * 8);
#define PG8_SA(b, h) (((b) * 2 + (h)) * HTB)
#define PG8_SB(b, h) ((4 + (b) * 2 + (h)) * HTB)
#define PG8_STAGE(bufoff, gbase, voff) do { _Pragma("unroll") for (int _i = 0; _i < 2; ++_i) \
        __builtin_amdgcn_global_load_lds((const unsigned*)((const char*)(gbase) + (voff)[_i]), (PG8_LAS unsigned*)(lds + (bufoff) + ldsw + _i * 8192), 16, 0, 0); } while (0)
#define PG8_LDA(dst, b, h) do { _Pragma("unroll") for (int m = 0; m < 4; ++m) _Pragma("unroll") for (int k = 0; k < 2; ++k) dst[m][k] = *(const PG8_LAS bf16x8*)(lds + PG8_SA(b, h) + aoff + m * 2048 + k * 1024); } while (0)
#define PG8_LDB(dst, b, h) do { _Pragma("unroll") for (int n = 0; n < 2; ++n) _Pragma("unroll") for (int k = 0; k < 2; ++k) dst[n][k] = *(const PG8_LAS bf16x8*)(lds + PG8_SB(b, h) + boff + n * 2048 + k * 1024); } while (0)
#define PG8_MMA(ai, bj, At, Bt) do { __builtin_amdgcn_s_setprio(1); _Pragma("unroll") for (int m = 0; m < 4; ++m) _Pragma("unroll") for (int n = 0; n < 2; ++n) _Pragma("unroll") for (int k = 0; k < 2; ++k) \
        acc[ai][bj][m][n] = __builtin_amdgcn_mfma_f32_16x16x32_bf16(Bt[n][k], At[m][k], acc[ai][bj][m][n], 0, 0, 0); __builtin_amdgcn_s_setprio(0); } while (0)
#define PG8_WAIT_V(n) asm volatile("s_waitcnt vmcnt(" #n ")" ::: "memory")
#define PG8_WAIT_L(n) asm volatile("s_waitcnt lgkmcnt(" #n ")" ::: "memory")
#define PG8_BAR __builtin_amdgcn_s_barrier()
#define PG8_SCHED __builtin_amdgcn_sched_barrier(0)
    Unit cur, nxt; int ui = 0;
    if (!S.next(0, cur)) return;
    f32x4 acc[2][2][4][2];
#pragma unroll
    for (int a = 0; a < 2; ++a)
#pragma unroll
        for (int b = 0; b < 2; ++b)
#pragma unroll
            for (int m = 0; m < 4; ++m)
#pragma unroll
                for (int n = 0; n < 2; ++n) acc[a][b][m][n] = (f32x4){0.f, 0.f, 0.f, 0.f};
    bf16x8 At[4][2], B0[2][2], B1[2][2];
    const char* cA = (const char*)g.A + (size_t)cur.pm * tstepA; const char* cB = (const char*)g.Bt + (size_t)cur.pn * tstepB;
    S.a_ready(cur);
    if constexpr (SP2) {
        PG8_STAGE(PG8_SB(0, 0), cB, voffB); PG8_STAGE(PG8_SB(0, 1), cB + hstepB, voffB); PG8_STAGE(PG8_SA(0, 0), cA, voffA); PG8_STAGE(PG8_SA(0, 1), cA + hstepA, voffA);
        if (wr == 1) PG8_BAR;
        PG8_WAIT_V(2); PG8_BAR;
        PG8_STAGE(PG8_SB(1, 0), cB + kstep, voffB); PG8_STAGE(PG8_SA(1, 0), cA + kstep, voffA); PG8_STAGE(PG8_SB(1, 1), cB + hstepB + kstep, voffB);
        PG8_WAIT_V(6); PG8_BAR;
    } else {
        PG8_STAGE(PG8_SB(0, 0), cB, voffB); PG8_STAGE(PG8_SA(0, 0), cA, voffA); PG8_STAGE(PG8_SB(0, 1), cB + hstepB, voffB); PG8_STAGE(PG8_SA(0, 1), cA + hstepA, voffA);
        if (wr == 1) PG8_BAR;
        PG8_WAIT_V(4); PG8_BAR;
        PG8_STAGE(PG8_SB(1, 0), cB + kstep, voffB); PG8_STAGE(PG8_SA(1, 0), cA + kstep, voffA); PG8_STAGE(PG8_SB(1, 1), cB + hstepB + kstep, voffB);
        PG8_WAIT_V(6); PG8_BAR;
    }
    for (;;) {
        const bool has_next = S.next(ui + 1, nxt);
        const char* nA = has_next ? (const char*)g.A + (size_t)nxt.pm * tstepA : cA; const char* nB = has_next ? (const char*)g.Bt + (size_t)nxt.pn * tstepB : cB;
        for (int t = 0; t < nt; t += 2) {
            if constexpr (Epi::MID) { if (t == (nt >> 1)) E.mid(acc, cur, wr, wc, fr, fq); }
            const bool last = (t == nt - 2);
            const char* a1 = cA + (size_t)(t + 1) * kstep;
            const char* a2 = last ? nA : cA + (size_t)(t + 2) * kstep; const char* b2 = last ? nB : cB + (size_t)(t + 2) * kstep;
            const char* a3 = a2 + kstep; const char* b3 = b2 + kstep;
            if (last && has_next) S.a_ready(nxt);
            if constexpr (SP2) {
            PG8_LDB(B0, 0, 0); PG8_LDB(B1, 0, 1); PG8_SCHED; PG8_LDA(At, 0, 0); PG8_STAGE(PG8_SA(1, 1), a1 + hstepA, voffA);
            PG8_WAIT_V(8); PG8_WAIT_L(0); PG8_BAR; PG8_MMA(0, 0, At, B0); PG8_MMA(0, 1, At, B1); PG8_BAR; PG8_SCHED;
            PG8_LDA(At, 0, 1); PG8_STAGE(PG8_SB(0, 0), b2, voffB); PG8_STAGE(PG8_SB(0, 1), b2 + hstepB, voffB); PG8_STAGE(PG8_SA(0, 0), a2, voffA);
            PG8_WAIT_V(8); PG8_WAIT_L(0); PG8_BAR; PG8_MMA(1, 0, At, B0); PG8_MMA(1, 1, At, B1); PG8_BAR; PG8_SCHED;
            PG8_LDB(B0, 1, 0); PG8_LDB(B1, 1, 1); PG8_SCHED; PG8_LDA(At, 1, 0); PG8_STAGE(PG8_SA(0, 1), a2 + hstepA, voffA);
            PG8_WAIT_V(8); PG8_WAIT_L(0); PG8_BAR; PG8_MMA(0, 0, At, B0); PG8_MMA(0, 1, At, B1); PG8_BAR; PG8_SCHED;
            PG8_LDA(At, 1, 1); PG8_STAGE(PG8_SB(1, 0), b3, voffB); PG8_STAGE(PG8_SB(1, 1), b3 + hstepB, voffB); PG8_STAGE(PG8_SA(1, 0), a3, voffA);
            PG8_WAIT_V(8); PG8_WAIT_L(0); PG8_BAR; PG8_MMA(1, 0, At, B0); PG8_MMA(1, 1, At, B1); PG8_BAR; PG8_SCHED;
            } else {
            PG8_LDB(B0, 0, 0); PG8_SCHED; PG8_LDA(At, 0, 0); PG8_STAGE(PG8_SA(1, 1), a1 + hstepA, voffA);
            PG8_WAIT_L(8); PG8_BAR; PG8_WAIT_L(0); PG8_MMA(0, 0, At, B0); PG8_BAR; PG8_SCHED;
            PG8_LDB(B1, 0, 1); PG8_STAGE(PG8_SB(0, 0), b2, voffB);
            PG8_BAR; PG8_WAIT_L(0); PG8_MMA(0, 1, At, B1); PG8_BAR;
            PG8_LDA(At, 0, 1); PG8_STAGE(PG8_SA(0, 0), a2, voffA);
            PG8_BAR; PG8_WAIT_L(0); PG8_MMA(1, 0, At, B0); PG8_BAR; PG8_SCHED;
            PG8_STAGE(PG8_SB(0, 1), b2 + hstepB, voffB);
            PG8_WAIT_V(6); PG8_BAR; PG8_MMA(1, 1, At, B1); PG8_BAR;
            PG8_LDB(B0, 1, 0); PG8_SCHED; PG8_LDA(At, 1, 0); PG8_STAGE(PG8_SA(0, 1), a2 + hstepA, voffA);
            PG8_WAIT_L(8); PG8_BAR; PG8_WAIT_L(0); PG8_MMA(0, 0, At, B0); PG8_BAR; PG8_SCHED;
            PG8_LDB(B1, 1, 1); PG8_STAGE(PG8_SB(1, 0), b3, voffB);
            PG8_BAR; PG8_WAIT_L(0); PG8_MMA(0, 1, At, B1); PG8_BAR;
            PG8_LDA(At, 1, 1); PG8_STAGE(PG8_SA(1, 0), a3, voffA);
            PG8_BAR; PG8_WAIT_L(0); PG8_MMA(1, 0, At, B0); PG8_BAR; PG8_SCHED;
            PG8_STAGE(PG8_SB(1, 1), b3 + hstepB, voffB);
            PG8_WAIT_V(6); PG8_BAR; PG8_MMA(1, 1, At, B1); PG8_BAR;
            }
        }
        if constexpr (ALIGN_EPI) { if (wr == 0) PG8_BAR; }
        if constexpr (!Epi::AFTER_DRAIN) { E(acc, cur, wr, wc, fr, fq); S.done(cur); }
        if (!has_next) break;
#pragma unroll
        for (int a = 0; a < 2; ++a)
#pragma unroll
            for (int b = 0; b < 2; ++b)
#pragma unroll
                for (int m = 0; m < 4; ++m)
#pragma unroll
                    for (int n = 0; n < 2; ++n) acc[a][b][m][n] = (f32x4){0.f, 0.f, 0.f, 0.f};
        cur = nxt; cA = nA; cB = nB; ++ui;
        if constexpr (ALIGN_EPI) { if (wr == 1) PG8_BAR; }
    }
    PG8_WAIT_V(0);
    if constexpr (!ALIGN_EPI) { if (wr == 0) PG8_BAR; }
    PG8_BAR;
    if constexpr (Epi::AFTER_DRAIN) { E.fused(acc, cur, wr, wc, fr, fq, lds, wid, lane); S.done(cur); }
#undef PG8_SA
#undef PG8_SB
#undef PG8_STAGE
#undef PG8_LDA
#undef PG8_LDB
#undef PG8_MMA
#undef PG8_WAIT_V
#undef PG8_WAIT_L
#undef PG8_BAR
#undef PG8_SCHED
}
}

namespace att {
typedef short bf16x8 __attribute__((ext_vector_type(8)));
typedef short s16x4 __attribute__((ext_vector_type(4)));
typedef float f32x16 __attribute__((ext_vector_type(16)));
typedef unsigned u32x4 __attribute__((ext_vector_type(4)));
typedef float f32x2_t __attribute__((ext_vector_type(2))); typedef __bf16 bf16x2_t __attribute__((ext_vector_type(2)));
typedef __attribute__((address_space(3))) const char* lds_cptr;
typedef short v4i16_t __attribute__((ext_vector_type(4)));
#define ASBAR() __builtin_amdgcn_sched_barrier(0)
#define APIN(x) asm volatile("" : "+v"(x))
#define AMFMA(a, b, c) __builtin_amdgcn_mfma_f32_32x32x16_bf16(a, b, c, 0, 0, 0)
#define AWAIT_BAR(N) asm volatile("s_waitcnt vmcnt(" #N ") lgkmcnt(0)\n\ts_barrier" ::: "memory")
#define AMX3(a, b, c) __builtin_fmaxf(__builtin_fmaxf((a), (b)), (c))
__device__ __forceinline__ int crow(int r, int hi) { return (r & 3) + 8 * (r >> 2) + 4 * hi; }
__device__ __forceinline__ void glds16(const void* gsrc, unsigned lds_dst) { unsigned keep;
    asm volatile("s_mov_b32 %0, m0\n\ts_mov_b32 m0, %2\n\ts_nop 0\n\tglobal_load_lds_dwordx4 %1, off\n\ts_mov_b32 m0, %0" : "=&s"(keep) : "v"(gsrc), "s"(lds_dst) : "memory"); }
__device__ __forceinline__ unsigned cvtpk_s(float lo, float hi) { f32x2_t v = {lo, hi}; bf16x2_t b = __builtin_convertvector(v, bf16x2_t); return __builtin_bit_cast(unsigned, b); }
__device__ __forceinline__ void kload2(bf16x8* kf, lds_cptr kp, int j) { kf[2 * j] = *(const __attribute__((address_space(3))) bf16x8*)(kp + j * 2048); kf[2 * j + 1] = *(const __attribute__((address_space(3))) bf16x8*)(kp + j * 2048 + 512); }
__device__ __forceinline__ bf16x8 kfrag(lds_cptr kp, int f) { return *(const __attribute__((address_space(3))) bf16x8*)(kp + (f >> 1) * 2048 + (f & 1) * 512); }
__device__ __forceinline__ s16x4 vtr(lds_cptr p) { return __builtin_bit_cast(s16x4, __builtin_amdgcn_ds_read_tr16_b64_v4i16((__attribute__((address_space(3))) v4i16_t*)p)); }
__device__ __forceinline__ void wait_bar_n(int n) {
    if (n <= 0) AWAIT_BAR(0); else if (n == 1) AWAIT_BAR(1); else if (n == 2) AWAIT_BAR(2); else if (n == 3) AWAIT_BAR(3); else if (n == 4) AWAIT_BAR(4); else AWAIT_BAR(5);
}
__device__ __forceinline__ void cmask(f32x16& p0, f32x16& p1, int jb, int qrel, int hi) {
    const int kb = 64 * jb + 4 * hi;
#pragma unroll
    for (int r = 0; r < 16; ++r) { const int kv = kb + (r & 3) + 8 * (r >> 2); if (kv > qrel) p0[r] = -INFINITY; if (kv + 32 > qrel) p1[r] = -INFINITY; } }
__device__ __forceinline__ float silu_f(float g) { return g / (1.f + __expf(-g)); }

template <int DQK> struct Geo {
    static constexpr int ND0 = DQK / 16, NKF = 2 * ND0, KSLOT = (DQK / 8) * 1024, VSLOT = 8192;
    static constexpr int LDS_K = 0, LDS_V = 4 * KSLOT, LDS_WS = LDS_V + 3 * VSLOT, LDS_OST = LDS_WS + 2048, LDS_BYTES = LDS_OST + 8 * 4096;
};
typedef const __attribute__((address_space(4))) u64* cu64p;
#define exp2_msel2(A, B, MA, MB) do { float a_ = (A), b_ = (B); \
    asm("v_exp_f32 %0, %0\n\tv_exp_f32 %1, %1\n\tv_cndmask_b32 %0, 0, %0, %2\n\tv_cndmask_b32 %1, 0, %1, %3" : "+v"(a_), "+v"(b_) : "s"(MA), "s"(MB)); (A) = a_; (B) = b_; } while (0)
template <int DQK, int PQ, int PK, int PV, int PO, int PG, int MODE, class NextQ>
__device__ __forceinline__ void attn_unit(const int qb, const bf16_t* Qb, const bf16_t* Kb, const bf16_t* Vb, bf16_t* Ob, const bf16_t* Gb, char* shm, const u64* Mb, const float* rope_b, const float* qgain,
                                          bf16x8 (&qpre)[6], const bool use_pre, NextQ& nq) {
    typedef Geo<DQK> G;
    constexpr int ND0 = G::ND0, KSLOT = G::KSLOT, VSLOT = G::VSLOT, LDS_K = G::LDS_K, LDS_V = G::LDS_V, LDS_WS = G::LDS_WS, LDS_OST = G::LDS_OST;
    constexpr float THRL = 8.f;
    int tid = threadIdx.x; asm volatile("" : "+v"(tid));
    const int lane = tid & 63, r32 = lane & 31, hi = lane >> 5; const int wid = __builtin_amdgcn_readfirstlane(tid >> 6);
    const int q0 = qb * 256, NT = (q0 + 256) / 64;
    const bf16_t* Qw = Qb + (long)(q0 + wid * 32) * PQ;
    const unsigned lds0 = (unsigned)(uintptr_t)shm;
    float* wsf = (float*)(shm + LDS_WS) + wid * 64;
    const int nkp = (DQK == 96 && wid < 4) ? 2 : 1;
    const bf16_t* ksrc = Kb + (long)lane * PK + wid * 8;
    const bf16_t* vsrc = Vb + (long)(16 * (wid & 3) + (lane >> 2)) * PV + (wid >> 2) * 32 + (lane & 3) * 8;
    const unsigned kdst = lds0 + LDS_K + wid * 1024, vdst = lds0 + LDS_V + wid * 1024;
#define DMA_K(t, sl) do { glds16(ksrc + (long)(t) * 64 * PK, (unsigned)__builtin_amdgcn_readfirstlane(kdst + (sl) * KSLOT)); \
        if (nkp == 2) glds16(ksrc + (long)(t) * 64 * PK + 64, (unsigned)__builtin_amdgcn_readfirstlane(kdst + (sl) * KSLOT + 8192)); } while (0)
#define DMA_V(t, sl) glds16(vsrc + (long)(t) * 64 * PV, (unsigned)__builtin_amdgcn_readfirstlane(vdst + (sl) * VSLOT))
    const lds_cptr shm3 = (lds_cptr)shm;
    const lds_cptr kp0 = shm3 + LDS_K + hi * 1024 + r32 * 16;
    const lds_cptr vp0 = shm3 + LDS_V + ((lane >> 4) & 1) * 32 + (lane & 3) * 8 + (4 * hi + ((lane & 15) >> 2)) * 64;
    DMA_K(0, 0); DMA_V(0, 0); DMA_K(1, 1);
    bf16x8 qr[ND0];
#pragma unroll
    for (int d0 = 0; d0 < ND0; ++d0) qr[d0] = use_pre ? qpre[d0] : *reinterpret_cast<const bf16x8*>(&Qw[(long)r32 * PQ + d0 * 16 + hi * 8]);
    {
        float v[ND0][8]; float ss = 0.f;
#pragma unroll
        for (int d0 = 0; d0 < ND0; ++d0)
#pragma unroll
            for (int e = 0; e < 8; ++e) { v[d0][e] = __uint_as_float(((unsigned)(unsigned short)qr[d0][e]) << 16); ss = __builtin_fmaf(v[d0][e], v[d0][e], ss); }
        ss += __shfl_xor(ss, 32);
        const float rn = rsqrtf(ss * (1.f / DQK) + 1e-6f);
        constexpr float QS = (DQK == 96) ? 0.14724445f : 0.18033688f;
#pragma unroll
        for (int d0 = 0; d0 < ND0; ++d0)
#pragma unroll
            for (int e = 0; e < 8; ++e) v[d0][e] = v[d0][e] * rn * qgain[16 * d0 + 8 * hi + e] * QS;
        const float* cs = rope_b + (size_t)(q0 + wid * 32 + r32) * 56;
        if (DQK == 96) {
            float4 c4[4];
#pragma unroll
            for (int i = 0; i < 4; ++i) c4[i] = *(const float4*)(cs + hi * 16 + 4 * i);
            const float cc[8] = {c4[0].x, c4[0].z, c4[1].x, c4[1].z, c4[2].x, c4[2].z, c4[3].x, c4[3].z}, sn[8] = {c4[0].y, c4[0].w, c4[1].y, c4[1].w, c4[2].y, c4[2].w, c4[3].y, c4[3].w};
#pragma unroll
            for (int e = 0; e < 8; ++e) { const float a = v[ND0 - 2][e], bb = v[ND0 - 1][e]; v[ND0 - 2][e] = a * cc[e] - bb * sn[e]; v[ND0 - 1][e] = bb * cc[e] + a * sn[e]; }
        } else {
            float4 c4[4];
#pragma unroll
            for (int i = 0; i < 4; ++i) c4[i] = *(const float4*)(cs + 32 + 4 * i);
            const float cc[8] = {c4[0].x, c4[0].z, c4[1].x, c4[1].z, c4[2].x, c4[2].z, c4[3].x, c4[3].z}, sn[8] = {c4[0].y, c4[0].w, c4[1].y, c4[1].w, c4[2].y, c4[2].w, c4[3].y, c4[3].w};
#pragma unroll
            for (int e = 0; e < 8; ++e) { const float pr = __shfl_xor(v[0][e], 32); v[0][e] = hi == 0 ? v[0][e] * cc[e] - pr * sn[e] : v[0][e] * cc[e] + pr * sn[e]; }
        }
#pragma unroll
        for (int d0 = 0; d0 < ND0; ++d0)
#pragma unroll
            for (int e = 0; e < 8; e += 2) { const unsigned pk = cvtpk_s(v[d0][e], v[d0][e + 1]); qr[d0][e] = (short)(pk & 0xffffu); qr[d0][e + 1] = (short)(pk >> 16); }
    }
    float mhat = 0.f, l_reg = 0.f; f32x16 o[2], negm;
    { float z = 0.f; asm volatile("" : "+v"(z));
#pragma unroll
      for (int r = 0; r < 16; ++r) { o[0][r] = z; o[1][r] = z; negm[r] = z; } asm volatile("" : "+v"(negm)); }
    const int qrel = wid * 32 + r32; bool resc = false;
    const cu64p mwave = (cu64p)(uintptr_t)(Mb + (size_t)(qb * 8 + wid) * 16);
#define MLOAD(m0, m1, t) do { if (MODE == 1) { const cu64p mp_ = mwave + (size_t)(2 * (t)) * 2048; \
        _Pragma("unroll") for (int r = 0; r < 16; ++r) { m0[r] = mp_[r]; m1[r] = mp_[2048 + r]; } } } while (0)
    f32x16 pA0, pA1, pB0, pB1; bf16x8 kf[2 * ND0]; s16x4 vlo[8], vhi[8]; u32x4 pw[4];
    int sl_prev = 0, sl_cur = 0, sl_next = 1;
#define ROT() do { sl_prev = sl_cur; sl_cur = sl_next; sl_next = (sl_next == 2) ? 0 : sl_next + 1; } while (0)
#define RESC() do { if (resc) { asm volatile("s_waitcnt lgkmcnt(0)" ::: "memory"); \
        _Pragma("unroll") for (int d_ = 0; d_ < 2; ++d_) _Pragma("unroll") for (int r = 0; r < 16; ++r) o[d_][r] *= wsf[crow(r, hi)]; } } while (0)
#define CMASKT(C0, C1, t) do { if (MODE == 0) { const int jb_ = (t) - (NT - 4); if (jb_ >= 0) cmask(C0, C1, jb_, qrel, hi); } } while (0)
#define DECIDE(C0, C1) do { float a_ = AMX3(C0[0], C0[1], C1[0]), b_ = AMX3(C0[2], C0[3], C1[1]); a_ = AMX3(a_, C1[2], C1[3]); \
        _Pragma("unroll") for (int r = 4; r < 16; r += 4) { a_ = AMX3(a_, C0[r], C0[r + 1]); b_ = AMX3(b_, C0[r + 2], C0[r + 3]); a_ = AMX3(a_, C1[r], C1[r + 1]); b_ = AMX3(b_, C1[r + 2], C1[r + 3]); } \
        float rm_ = __builtin_fmaxf(a_, b_); { auto rr_ = __builtin_amdgcn_permlane32_swap(__float_as_uint(rm_), __float_as_uint(rm_), false, false); rm_ = __builtin_fmaxf(__uint_as_float(rr_[0]), __uint_as_float(rr_[1])); } \
        resc = false; \
        if (__builtin_expect(__any(rm_ > THRL), 0)) { const float dl_ = __builtin_fmaxf(rm_, 0.f); mhat += dl_; \
            _Pragma("unroll") for (int r = 0; r < 16; ++r) { C0[r] -= dl_; C1[r] -= dl_; } \
            _Pragma("unroll") for (int r = 0; r < 16; ++r) negm[r] = -mhat; asm volatile("" : "+v"(negm)); \
            const float f_ = __builtin_amdgcn_exp2f(-dl_); l_reg *= f_; if (hi == 0) wsf[r32] = f_; resc = true; } } while (0)
    DMA_K(2, 2);
    wait_bar_n(1 + 2 * nkp);
    {
        const lds_cptr kb = kp0;
#pragma unroll
        for (int d0 = 0; d0 < ND0; ++d0) {
            const bf16x8 b0 = *(const __attribute__((address_space(3))) bf16x8*)(kb + d0 * 2048);
            const bf16x8 b1 = *(const __attribute__((address_space(3))) bf16x8*)(kb + d0 * 2048 + 512);
            if (d0 == 0) { pA0 = AMFMA(b0, qr[0], negm); pA1 = AMFMA(b1, qr[0], negm); }
            else { pA0 = AMFMA(b0, qr[d0], pA0); pA1 = AMFMA(b1, qr[d0], pA1); }
        }
    }
    CMASKT(pA0, pA1, 0);
    DECIDE(pA0, pA1);
    if (MODE == 1) { u64 m0[16], m1[16]; MLOAD(m0, m1, 0);
#pragma unroll
        for (int r = 0; r < 16; r += 2) { exp2_msel2(pA0[r], pA0[r + 1], m0[r], m0[r + 1]); exp2_msel2(pA1[r], pA1[r + 1], m1[r], m1[r + 1]); } }
    else {
#pragma unroll
        for (int r = 0; r < 16; ++r) { pA0[r] = __builtin_amdgcn_exp2f(pA0[r]); pA1[r] = __builtin_amdgcn_exp2f(pA1[r]); } }
    wait_bar_n(0);
    RESC();
    DMA_K(3, 3); DMA_V(1, 1);
    ROT();
#pragma unroll
    for (int f = 0; f < 4; ++f) kf[f] = kfrag(kp0 + 1 * KSLOT, f);
#define PELM(P0, P1, i) (((i) < 16) ? P0[(i) & 15] : P1[(i) & 15])
#define VFR(i) (bf16x8){vlo[i][0], vlo[i][1], vlo[i][2], vlo[i][3], vhi[i][0], vhi[i][1], vhi[i][2], vhi[i][3]}
#define VRD(i) do { vlo[i] = vtr(vp_ + (((i) >> 2) * 4096 + ((i) & 3) * 1024)); vhi[i] = vtr(vp_ + (((i) >> 2) * 4096 + ((i) & 3) * 1024 + 512)); } while (0)
#define STEP(C0, C1, P0, P1, t, GK, GV, GL) do { ASBAR(); \
        const lds_cptr vp_ = vp0 + sl_prev * VSLOT; const lds_cptr kpc_ = kp0 + ((t) & 3) * KSLOT; const lds_cptr kpn_ = kp0 + (((t) + 1) & 3) * KSLOT; \
        float sacc = P0[0] + P0[1]; u64 m0_[16], m1_[16]; MLOAD(m0_, m1_, t); \
        _Pragma("unroll") for (int g = 0; g < 2 * ND0; ++g) { \
            if (g < 8) { VRD(((g) >> 1) + 4 * ((g) & 1)); } \
            if (g + 4 < 2 * ND0) { kf[g + 4] = kfrag(kpc_, g + 4); } \
            ASBAR(); \
            if ((g & 1) == 0) { C0 = AMFMA(kf[g], qr[g >> 1], (g < 2) ? negm : C0); } else { C1 = AMFMA(kf[g], qr[g >> 1], (g < 2) ? negm : C1); } \
            if (g < 8) { sacc += PELM(P0, P1, 4 * g + 2); sacc += PELM(P0, P1, 4 * g + 3); if (g < 7) { sacc += PELM(P0, P1, 4 * g + 4); sacc += PELM(P0, P1, 4 * g + 5); } APIN(sacc); \
                pw[g >> 1][2 * (g & 1)] = cvtpk_s(PELM(P0, P1, 4 * g), PELM(P0, P1, 4 * g + 1)); pw[g >> 1][2 * (g & 1) + 1] = cvtpk_s(PELM(P0, P1, 4 * g + 2), PELM(P0, P1, 4 * g + 3)); APIN(pw[g >> 1]); } \
            ASBAR(); } \
        l_reg += sacc; \
        if (GK) { DMA_K((t) + 3, ((t) + 3) & 3); } if (GV) { DMA_V((t) + 1, sl_next); } \
        CMASKT(C0, C1, t); \
        DECIDE(C0, C1); \
        ASBAR(); \
        _Pragma("unroll") for (int i = 0; i < 8; ++i) { \
            if ((GL) && i >= 4) { kf[i - 4] = kfrag(kpn_, i - 4); ASBAR(); } \
            o[i & 1] = AMFMA(__builtin_bit_cast(bf16x8, pw[i >> 1]), VFR((i >> 1) + 4 * (i & 1)), o[i & 1]); \
            if (MODE == 1) { if (i < 4) { exp2_msel2(C0[4 * i], C0[4 * i + 1], m0_[4 * i], m0_[4 * i + 1]); exp2_msel2(C0[4 * i + 2], C0[4 * i + 3], m0_[4 * i + 2], m0_[4 * i + 3]); APIN(C0); } \
                             else { exp2_msel2(C1[4 * i - 16], C1[4 * i - 15], m1_[4 * i - 16], m1_[4 * i - 15]); exp2_msel2(C1[4 * i - 14], C1[4 * i - 13], m1_[4 * i - 14], m1_[4 * i - 13]); APIN(C1); } } \
            else if (i < 4) { _Pragma("unroll") for (int e = 0; e < 4; ++e) { C0[4 * i + e] = __builtin_amdgcn_exp2f(C0[4 * i + e]); } APIN(C0); } \
            else { _Pragma("unroll") for (int e = 0; e < 4; ++e) { C1[4 * i - 16 + e] = __builtin_amdgcn_exp2f(C1[4 * i - 16 + e]); } APIN(C1); } \
            ASBAR(); } \
    } while (0)
#define ENDW(tt) do { if ((tt) + 3 < NT) wait_bar_n(nkp + 1); else if ((tt) + 2 < NT) wait_bar_n(1); else wait_bar_n(0); } while (0)
    int t = 1;
    for (; t + 5 < NT; t += 2) {
        STEP(pB0, pB1, pA0, pA1, t, true, true, true);     wait_bar_n(nkp + 1); RESC(); ROT();
        STEP(pA0, pA1, pB0, pB1, t + 1, true, true, true); wait_bar_n(nkp + 1); RESC(); ROT();
    }
    for (; t + 1 < NT; t += 2) {
        STEP(pB0, pB1, pA0, pA1, t, (t + 3 < NT), (t + 1 < NT), (t + 1 < NT));       ENDW(t);     RESC(); ROT();
        STEP(pA0, pA1, pB0, pB1, t + 1, (t + 4 < NT), (t + 2 < NT), (t + 2 < NT));   ENDW(t + 1); RESC(); ROT();
    }
    nq.issue();
    STEP(pB0, pB1, pA0, pA1, NT - 1, false, false, false); RESC();
    const bf16_t* qnext; int pqn, nd0n; nq.draw(qnext, pqn, nd0n);
    if (qnext) { const bf16_t* qn_ = qnext + (long)(wid * 32 + r32) * pqn + hi * 8;
#pragma unroll
        for (int d0 = 0; d0 < 6; ++d0) if (d0 < nd0n) qpre[d0] = *reinterpret_cast<const bf16x8*>(qn_ + d0 * 16); }
    u32x4 gq[4];
    { const bf16_t* Gw_ = Gb + (long)(q0 + wid * 32) * PG;
#pragma unroll
      for (int i = 0; i < 4; ++i) gq[i] = *(const u32x4*)(Gw_ + (long)(i * 8 + (lane >> 3)) * PG + (lane & 7) * 8); }
    {
        float sacc = pB0[0] + pB0[1];
#pragma unroll
        for (int r = 2; r < 16; ++r) sacc += pB0[r];
#pragma unroll
        for (int r = 0; r < 16; ++r) sacc += pB1[r];
        l_reg += sacc;
#pragma unroll
        for (int g = 0; g < 8; ++g) { pw[g >> 1][2 * (g & 1)] = cvtpk_s(PELM(pB0, pB1, 4 * g), PELM(pB0, pB1, 4 * g + 1)); pw[g >> 1][2 * (g & 1) + 1] = cvtpk_s(PELM(pB0, pB1, 4 * g + 2), PELM(pB0, pB1, 4 * g + 3)); }
        const lds_cptr vp_ = vp0 + sl_cur * VSLOT;
#pragma unroll
        for (int i = 0; i < 8; ++i) VRD(i);
#pragma unroll
        for (int i = 0; i < 8; ++i) o[i & 1] = AMFMA(__builtin_bit_cast(bf16x8, pw[i >> 1]), VFR((i >> 1) + 4 * (i & 1)), o[i & 1]);
    }
    { auto rr = __builtin_amdgcn_permlane32_swap(__float_as_uint(l_reg), __float_as_uint(l_reg), false, false); l_reg = __uint_as_float(rr[0]) + __uint_as_float(rr[1]); }
    if (hi == 0) wsf[32 + r32] = l_reg; asm volatile("s_waitcnt lgkmcnt(0)" ::: "memory");
    float rli[16];
#pragma unroll
    for (int r = 0; r < 16; ++r) rli[r] = __builtin_amdgcn_rcpf(wsf[32 + crow(r, hi)]);
    {
        bf16_t* stg = (bf16_t*)(shm + LDS_OST) + wid * 2048;
#pragma unroll
        for (int r = 0; r < 16; ++r) { const int orow = crow(r, hi);
#pragma unroll
            for (int d0 = 0; d0 < 2; ++d0) stg[orow * 64 + d0 * 32 + r32] = f2bf(o[d0][r] * rli[r]); }
        asm volatile("s_waitcnt lgkmcnt(0)" ::: "memory");
        bf16_t* Ow = Ob + (long)(q0 + wid * 32) * PO;
#pragma unroll
        for (int i = 0; i < 4; ++i) { const int row = i * 8 + (lane >> 3), ch = lane & 7;
            const u32x4 v = *(const u32x4*)(stg + row * 64 + ch * 8); const u32x4 g = gq[i]; u32x4 w;
#pragma unroll
            for (int e = 0; e < 4; ++e) { const float lo = __uint_as_float(v[e] << 16) * silu_f(__uint_as_float(g[e] << 16)), hh = __uint_as_float(v[e] & 0xffff0000u) * silu_f(__uint_as_float(g[e] & 0xffff0000u)); w[e] = cvtpk_s(lo, hh); }
            *(u32x4*)(Ow + (long)row * PO + ch * 8) = w; }
    }
    asm volatile("s_waitcnt lgkmcnt(0)\n\ts_barrier" ::: "memory");
#undef MLOAD
#undef DMA_K
#undef DMA_V
#undef ROT
#undef RESC
#undef CMASKT
#undef DECIDE
#undef PELM
#undef VFR
#undef VRD
#undef STEP
#undef ENDW
}
}

namespace sel {
typedef short bf16x8 __attribute__((ext_vector_type(8)));
typedef float f32x16 __attribute__((ext_vector_type(16)));
constexpr int CAP = 64;
constexpr int L_HIST = 0, L_CS = 65536, L_CI = 73728, L_MASK = 81920, L_STAT = 98304, L_SEG = 100352, L_B = 102400, L_QUOTA = 102528, L_ABOVE = 102656, L_TLO = 102784, L_THI = 102912,
              L_CC = 103040, L_FAIL = 103168  , L_QI = 103424  , L_W = 104448  , L_BYTES = 104480;
__device__ __forceinline__ int crow(int r, int hi) { return (r & 3) + 8 * (r >> 2) + 4 * hi; }
__device__ __forceinline__ void score_tile_k(f32x16& sc, const bf16x8 (&qf)[8][2], const float (&w)[8], const bf16x8 k0, const bf16x8 k1) {
#pragma unroll
    for (int r = 0; r < 16; ++r) sc[r] = 0.f;
#pragma unroll
    for (int hh = 0; hh < 8; hh += 4) {
        f32x16 x[4];
#pragma unroll
        for (int h = 0; h < 4; ++h) { x[h] = __builtin_amdgcn_mfma_f32_32x32x16_bf16(k0, qf[hh + h][0], (f32x16){}, 0, 0, 0); x[h] = __builtin_amdgcn_mfma_f32_32x32x16_bf16(k1, qf[hh + h][1], x[h], 0, 0, 0); }
#pragma unroll
        for (int h = 0; h < 4; ++h)
#pragma unroll
            for (int r = 0; r < 16; ++r) { const float xv = x[h][r]; const int xi = __float_as_int(xv); sc[r] = __builtin_fmaf(w[hh + h], __int_as_float(xi > 0 ? xi : 0), sc[r]); }
        __builtin_amdgcn_sched_barrier(0);
    }
}
__device__ __forceinline__ void score_tile(f32x16& sc, const bf16x8 (&qf)[8][2], const float (&w)[8], const bf16_t* kig, int r32, int hi) {
    const bf16x8 k0 = *(const bf16x8*)(kig + r32 * 32 + hi * 8), k1 = *(const bf16x8*)(kig + r32 * 32 + 16 + hi * 8);
    score_tile_k(sc, qf, w, k0, k1);
}
#define SEL_GLOOP_BEGIN() { const bf16_t* kp_ = kib + (size_t)wid * 1024 + r32 * 32 + hi * 8; bf16x8 kn0_ = *(const bf16x8*)kp_, kn1_ = *(const bf16x8*)(kp_ + 16); \
    for (int g = wid; g <= qblk; g += 8) { const bf16x8 kc0_ = kn0_, kc1_ = kn1_; kp_ += 8 * 1024; if (g + 8 <= qblk) { kn0_ = *(const bf16x8*)kp_; kn1_ = *(const bf16x8*)(kp_ + 16); } \
        score_tile_k(sc, qf, w, kc0_, kc1_);
#define SEL_GLOOP_END() } }
__device__ __forceinline__ int key18_of(float s, float iw, float c0) { const float f = __builtin_amdgcn_fmed3f(__builtin_fmaf(s, iw, c0), 0.f, 262143.f); return (int)f; }
__device__ __forceinline__ int bin10_of(float s, float iw1, float c1) { const float f = __builtin_amdgcn_fmed3f(__builtin_fmaf(s, iw1, c1), 0.f, 1023.99609375f); return (int)f; }
__device__ __forceinline__ void scan_top(const unsigned short* h16, int nseg, int* seg_s, const int* cum0_s, int* B_out, int* above_out, int* cnt_out, int tid) {
    { const int q = tid & 31, seg = tid >> 5; if (seg < nseg) { int s = 0;
#pragma unroll 8
        for (int i = 0; i < 64; ++i) s += h16[((seg * 64 + i) * 32) + q];
        seg_s[q * 16 + seg] = s; } }
    __syncthreads();
    if (tid < 32) {
        int cum = cum0_s ? cum0_s[tid] : 0;
        int cseg[16];
#pragma unroll
        for (int i = 0; i < 16; ++i) cseg[i] = (i < nseg) ? seg_s[tid * 16 + i] : 0;
        int sg = 0; bool found = false;
#pragma unroll
        for (int i = 15; i >= 1; --i) { if (i < nseg) { const bool hit = !found && (cum + cseg[i] >= 256); if (hit) { sg = i; found = true; } if (!found) cum += cseg[i]; } }
        int bb = -1, cb = 0; bool fb = false;
#pragma unroll 1
        for (int ch = 3; ch >= 0; --ch) {
            int cv[16];
#pragma unroll
            for (int i = 0; i < 16; ++i) cv[i] = h16[(sg * 64 + ch * 16 + i) * 32 + tid];
#pragma unroll
            for (int i = 15; i >= 0; --i) { const bool hit = !fb && (cum + cv[i] >= 256); if (hit) { bb = sg * 64 + ch * 16 + i; cb = cv[i]; fb = true; } if (!fb) cum += cv[i]; }
        }
        B_out[tid] = bb; above_out[tid] = cum; cnt_out[tid] = cb;
    }
    __syncthreads();
}

__device__ __forceinline__ unsigned sel_unit(const int b, const int qblk, const bf16_t* proj, const bf16_t* ki, const float* wi, u64* M64, unsigned char* smem, unsigned* qctr, volatile __attribute__((address_space(3))) unsigned* slot) {
    unsigned* hist = (unsigned*)(smem + L_HIST); float* cs = (float*)(smem + L_CS); int* ci = (int*)(smem + L_CI); u64* mask = (u64*)(smem + L_MASK); unsigned* mask32 = (unsigned*)(smem + L_MASK);
    float* stat = (float*)(smem + L_STAT); int* seg_s = (int*)(smem + L_SEG); int* B_s = (int*)(smem + L_B); int* quota_s = (int*)(smem + L_QUOTA); int* above_s = (int*)(smem + L_ABOVE);
    int* tlo_s = (int*)(smem + L_TLO); int* thi_s = (int*)(smem + L_THI); unsigned* cc = (unsigned*)(smem + L_CC); int* flag_s = (int*)(smem + L_FAIL); int* failq = (int*)(smem + L_FAIL + 16);
    int* cnt_s = (int*)(smem + L_STAT);
    int tid = threadIdx.x; asm volatile("" : "+v"(tid));
    const int lane = tid & 63, r32 = lane & 31, hi = lane >> 5; const int wid = __builtin_amdgcn_readfirstlane(tid >> 6);
    const size_t trow = (size_t)b * SEQ + qblk * 32 + r32;
    const bf16_t* kib = ki + (size_t)b * SEQ * 32;
    const int gend = (qblk | 7) + 1;
    const bool topk = qblk >= 8;
    for (int i = tid; i < gend * 32; i += NTHREADS) mask32[i] = 0u;
    unsigned zz = 0u; asm volatile("" : "+v"(zz));
    if (topk) for (int i = tid; i < 4096; i += NTHREADS) ((uint4*)hist)[i] = make_uint4(zz, zz, zz, zz);
    if (tid < 32) { cc[tid] = 0u; failq[tid] = 0; }
    if (tid < 4) flag_s[tid] = 0;
    bf16x8 qf[8][2]; float w[8];
#pragma unroll
    for (int h = 0; h < 8; ++h) { qf[h][0] = *(const bf16x8*)(proj + trow * NP + C_QI + h * 32 + hi * 8); qf[h][1] = *(const bf16x8*)(proj + trow * NP + C_QI + h * 32 + 16 + hi * 8); w[h] = wi[trow * 8 + h]; }
    float iw = 0.f, c0 = 0.f; int Tlo = 0x7fffffff, Thi = -1;
    f32x16 sc;
    const unsigned hadd = (r32 & 1) ? 0x10000u : 1u; const unsigned hoff = (unsigned)(r32 >> 1) * 4u;
    if (topk) {
        score_tile(sc, qf, w, kib + (size_t)wid * 32 * 32, r32, hi);
        float s1 = 0.f, s2 = 0.f;
#pragma unroll
        for (int r = 0; r < 16; ++r) { s1 += sc[r]; s2 = __builtin_fmaf(sc[r], sc[r], s2); }
        s1 += __shfl_xor(s1, 32); s2 += __shfl_xor(s2, 32);
        if (hi == 0) { stat[(wid * 32 + r32) * 2] = s1; stat[(wid * 32 + r32) * 2 + 1] = s2; }
        __syncthreads();
        { float a1 = 0.f, a2 = 0.f;
#pragma unroll
          for (int ww = 0; ww < 8; ++ww) { a1 += stat[(ww * 32 + r32) * 2]; a2 += stat[(ww * 32 + r32) * 2 + 1]; }
          const float mu = a1 * (1.f / 256.f); float var = a2 * (1.f / 256.f) - mu * mu; var = __builtin_fmaxf(var, 0.f);
          const float sd = __builtin_sqrtf(var); const float lo = mu - 6.f * sd; iw = sd > 0.f ? 262144.f / (12.f * sd) : 0.f; c0 = -lo * iw; }
        const float iw1 = iw * (1.f / 256.f), c1 = c0 * (1.f / 256.f);
        SEL_GLOOP_BEGIN()
            if (g == qblk) {
#pragma unroll
                for (int r = 0; r < 16; ++r) { const int bin = bin10_of(sc[r], iw1, c1); if (crow(r, hi) <= r32) atomicAdd((unsigned*)((unsigned char*)hist + (bin << 6) + hoff), hadd); }
            } else {
#pragma unroll
                for (int r = 0; r < 16; ++r) { const int bin = bin10_of(sc[r], iw1, c1); atomicAdd((unsigned*)((unsigned char*)hist + (bin << 6) + hoff), hadd); }
            }
        SEL_GLOOP_END()
        __syncthreads();
        scan_top((const unsigned short*)hist, 16, seg_s, nullptr, B_s, above_s, cnt_s, tid);
        if (tid < 32) {
            const int Bf = B_s[tid];
            quota_s[tid] = 256 - above_s[tid]; tlo_s[tid] = Bf * 256; thi_s[tid] = Bf * 256 + 255;
            if (Bf <= 0 || Bf >= 1023) { failq[tid] = 1; flag_s[1] = 1; }
            else if (cnt_s[tid] > CAP) flag_s[0] = 1;
        }
        __syncthreads();
        if (flag_s[0] != 0) {
            const int Bq = B_s[r32];
            __syncthreads();
            for (int i = tid; i < 1024; i += NTHREADS) ((uint4*)hist)[i] = make_uint4(zz, zz, zz, zz);
            __syncthreads();
            SEL_GLOOP_BEGIN()
                const bool diag = (g == qblk);
#pragma unroll
                for (int r = 0; r < 16; ++r) {
                    const bool valid = !diag || (crow(r, hi) <= r32);
                    const int k18 = key18_of(sc[r], iw, c0); const int sub = k18 & 255;
                    if (valid && (k18 >> 8) == Bq) atomicAdd((unsigned*)((unsigned char*)hist + (sub << 6) + hoff), hadd);
                }
            SEL_GLOOP_END()
            __syncthreads();
            scan_top((const unsigned short*)hist, 4, seg_s, above_s, tlo_s  , quota_s  , cnt_s, tid);
            if (tid < 32 && failq[tid] == 0) {
                const int B2 = tlo_s[tid], ab = quota_s[tid];
                if (B2 < 0 || cnt_s[tid] > CAP) { failq[tid] = 1; flag_s[1] = 1; }
                quota_s[tid] = 256 - ab; tlo_s[tid] = B_s[tid] * 256 + B2; thi_s[tid] = B_s[tid] * 256 + B2;
            }
            __syncthreads();
        }
        Tlo = tlo_s[r32]; Thi = thi_s[r32];
        if (failq[r32] != 0) { Tlo = 0x7fffffff; Thi = 0x7fffffff; }
    } else { __syncthreads(); }
    const unsigned twid = (unsigned)(Thi - Tlo);
#define SEL_P2_BODY(VALID) do { \
        _Pragma("unroll") for (int r = 0; r < 16; ++r) { \
            const int k16 = topk ? key18_of(sc[r], iw, c0) : 0; \
            const u64 m = __ballot((VALID) && k16 > Thi); \
            if (lane == r) mine = m; \
            if ((VALID) && (unsigned)(k16 - Tlo) <= twid) { const unsigned slot = atomicAdd(&cc[r32], 1u); if (slot < (unsigned)CAP) { cs[r32 * CAP + slot] = sc[r]; ci[r32 * CAP + slot] = g * 32 + crow(r, hi); } } \
        } } while (0)
    SEL_GLOOP_BEGIN()
        u64 mine = 0ull;
        if (g == qblk) SEL_P2_BODY(crow(r, hi) <= r32); else SEL_P2_BODY(true);
        if (lane < 16) mask[g * 16 + lane] = mine;
    SEL_GLOOP_END()
#undef SEL_P2_BODY
    __syncthreads();
    if (topk) {
        for (int qq = 0; qq < 4; ++qq) {
            const int q = wid * 4 + qq; int c = (int)cc[q]; c = c < CAP ? c : CAP; const int quo = quota_s[q];
            const float si = lane < c ? cs[q * CAP + lane] : 0.f; const int ii = lane < c ? ci[q * CAP + lane] : 0; int rank = 0;
            for (int j = 0; j < c; ++j) { const float sj = cs[q * CAP + j]; const int ij = ci[q * CAP + j]; rank += (sj > si || (sj == si && ij < ii)) ? 1 : 0; }
            if (lane < c && rank < quo) { const int g = ii >> 5, ko = ii & 31, r = (ko & 3) + 4 * (ko >> 3), hh = (ko >> 2) & 1; atomicOr(&mask32[(g * 16 + r) * 2 + hh], 1u << q); }
        }
        if (flag_s[1] != 0) {
            u64* keys = (u64*)smem; float* qi_s = (float*)(smem + L_QI); float* w_s = (float*)(smem + L_W);
            for (int qq = 0; qq < 32; ++qq) {
                if (failq[qq] == 0) continue;
                const size_t t = (size_t)b * SEQ + qblk * 32 + qq; const int n = qblk * 32 + qq + 1;
                __syncthreads();
                if (tid < 256) qi_s[tid] = bf2f(proj[t * NP + C_QI + tid]);
                if (tid < 8) w_s[tid] = wi[t * 8 + tid];
                __syncthreads();
                int Npad = 512; while (Npad < n) Npad <<= 1;
                for (int s = tid; s < Npad; s += NTHREADS) {
                    u64 key = 0;
                    if (s < n) {
                        const bf16_t* kr = kib + (size_t)s * 32; float kv[32];
#pragma unroll
                        for (int d = 0; d < 32; d += 8) { float f[8]; unpack8(*(const uint4*)(kr + d), f);
#pragma unroll
                            for (int i = 0; i < 8; ++i) kv[d + i] = f[i]; }
                        float scv = 0.f;
#pragma unroll
                        for (int h = 0; h < 8; ++h) { float d = 0.f;
#pragma unroll
                            for (int i = 0; i < 32; ++i) d = fmaf(qi_s[h * 32 + i], kv[i], d);
                            scv = fmaf(w_s[h], fmaxf(d, 0.f), scv); }
                        u32 ub = __float_as_uint(scv); ub = (ub & 0x80000000u) ? ~ub : (ub | 0x80000000u);
                        key = ((u64)ub << 32) | (u64)(0xFFFFFFFFu - (u32)s);
                    }
                    keys[s] = key;
                }
                __syncthreads();
                for (int kk = 2; kk <= Npad; kk <<= 1)
                    for (int j = kk >> 1; j > 0; j >>= 1) {
                        for (int i = tid; i < Npad; i += NTHREADS) {
                            const int ixj = i ^ j;
                            if (ixj > i) { const u64 a = keys[i], c = keys[ixj]; const bool desc = (i & kk) == 0; if (desc ? (a < c) : (a > c)) { keys[i] = c; keys[ixj] = a; } }
                        }
                        __syncthreads();
                    }
                if (tid < 256) { const int ii = (int)(0xFFFFFFFFu - (u32)(keys[tid] & 0xFFFFFFFFull)); const int g = ii >> 5, ko = ii & 31, r = (ko & 3) + 4 * (ko >> 3), hh = (ko >> 2) & 1; atomicOr(&mask32[(g * 16 + r) * 2 + hh], 1u << qq); }
            }
        }
    }
    __syncthreads();
    const unsigned tv = ticket_issue(qctr);
    u64* dst = M64 + (size_t)b * 128 * 128 * 16;
    for (int i = tid; i < gend * 16; i += NTHREADS) { const int g = i >> 4, r = i & 15; dst[((size_t)g * 128 + qblk) * 16 + r] = mask[i]; }
    return ticket_collect(tv, slot);
}
}

#define GAS __attribute__((address_space(1)))
#define LAS __attribute__((address_space(3)))
typedef GAS unsigned gu32;
typedef GAS unsigned long long gu64;
#define RLX_AGENT __ATOMIC_RELAXED, __HIP_MEMORY_SCOPE_AGENT
#define XB_TMO      128
#define XB_XCNT(j)  (256  + 64 * (j))
#define XB_XSUB(j)  (1280 + 64 * (j))
#define XB_XGEN(j)  (2304 + 64 * (j))
#define XB_TOP      3328
#define XB_TOPGEN   3392
#define XCD_BAR_WORDS 3456
#define XB_SPIN_CAP (1u << 18)

__device__ __forceinline__ unsigned xb_ld(unsigned* p)              { return __hip_atomic_load(p, __ATOMIC_RELAXED, __HIP_MEMORY_SCOPE_AGENT); }
__device__ __forceinline__ unsigned xb_add(unsigned* p, unsigned v) { return __hip_atomic_fetch_add(p, v, __ATOMIC_RELAXED, __HIP_MEMORY_SCOPE_AGENT); }
__device__ __forceinline__ unsigned xb_xcc_id() { return (unsigned)__builtin_amdgcn_s_getreg((3 << 11) | 20) & 0xFu; }
#define XB_SPIN(cond, bar) do { unsigned _sp = 0; while (cond) { __builtin_amdgcn_s_sleep(1); \
    if ((++_sp & 255u) == 0u) { if (xb_ld(&(bar)[XB_TMO])) break; if (_sp > XB_SPIN_CAP) { atomicAdd(&(bar)[XB_TMO], 1u); break; } } } } while (0)

struct XcdBarrier {
    unsigned* bar; unsigned x;
    volatile LAS unsigned* st;
};

__device__ __forceinline__ XcdBarrier xcd_barrier_post(unsigned* bar, volatile LAS unsigned* st) {
    XcdBarrier b; b.bar = bar; b.x = xb_xcc_id(); b.st = st;
    if (threadIdx.x == 0) (void)xb_add(&bar[XB_XCNT(b.x)], 1u);
    return b;
}
__device__ __forceinline__ void xcd_barrier_complete(unsigned* bar, unsigned x, unsigned& nloc, unsigned& nx) {
    const unsigned G = gridDim.x * gridDim.y * gridDim.z;
    unsigned sum, cnt, mine, sp = 0u;
    for (;;) {
        sum = 0u; cnt = 0u; mine = 0u;
#pragma unroll
        for (unsigned j = 0; j < 16; ++j) { const unsigned c = xb_ld(&bar[XB_XCNT(j)]); sum += c; cnt += (c > 0u) ? 1u : 0u; mine = (j == x) ? c : mine; }
        if (sum == G) break;
        __builtin_amdgcn_s_sleep(1);
        if ((++sp & 255u) == 0u) { if (xb_ld(&bar[XB_TMO])) break; if (sp > XB_SPIN_CAP) { atomicAdd(&bar[XB_TMO], 1u); break; } }
    }
    nloc = mine > 0u ? mine : 1u; nx = cnt > 0u ? cnt : 1u;
}

__device__ __forceinline__ void xcd_barrier(const XcdBarrier& b) {
    asm volatile("s_waitcnt vmcnt(0)" ::: "memory");
    __syncthreads();
    if (threadIdx.x == 0) {
        unsigned* bar = b.bar;
        __builtin_amdgcn_s_waitcnt(0);
        unsigned nloc = b.st[0], nx = b.st[1];
        if (nloc == 0u) { xcd_barrier_complete(bar, b.x, nloc, nx); b.st[0] = nloc; b.st[1] = nx; }
        const unsigned old = xb_add(&bar[XB_XSUB(b.x)], 1u);
        const unsigned gen = old / nloc;
        if (old + 1u == (gen + 1u) * nloc) {
            __builtin_amdgcn_fence(__ATOMIC_RELEASE, "agent");
            asm volatile("s_waitcnt vmcnt(0)" ::: "memory");
            const unsigned og = xb_add(&bar[XB_TOP], 1u);
            const unsigned tg = og / nx;
            if (og + 1u == (tg + 1u) * nx) xb_add(&bar[XB_TOPGEN], 1u);
            else XB_SPIN(xb_ld(&bar[XB_TOPGEN]) == tg, bar);
            __builtin_amdgcn_fence(__ATOMIC_ACQUIRE, "agent");
            xb_add(&bar[XB_XGEN(b.x)], 1u);
            asm volatile("s_waitcnt vmcnt(0)" ::: "memory");
        } else {
            XB_SPIN(xb_ld(&bar[XB_XGEN(b.x)]) == gen, bar);
            __builtin_amdgcn_fence(__ATOMIC_ACQUIRE, "agent");
            asm volatile("s_waitcnt vmcnt(0)" ::: "memory");
        }
    }
    __syncthreads();
}


template <bool PERMUTE>
__device__ __forceinline__ void transpose_item(const float* W, int ldw, int N, bf16_t* WT, int ldt, int koff, float* scr, int item, int lane) {
    const int nblk = N / 32, kb = item / nblk, nb = item % nblk, k0 = 64 * kb, n0 = 32 * nb;
    const int nn = n0 + (lane & 31); const int sc = PERMUTE ? oldcol(nn) : nn;
    float wv_[32];
#pragma unroll
    for (int i = 0; i < 32; ++i) { const int kk = 2 * i + (lane >> 5); wv_[i] = sc >= 0 ? W[(size_t)(k0 + kk) * ldw + sc] : 0.f; }
#pragma unroll
    for (int i = 0; i < 32; ++i) { const int kk = 2 * i + (lane >> 5); scr[kk * 33 + (lane & 31)] = wv_[i]; }
    asm volatile("s_waitcnt lgkmcnt(0)" ::: "memory");
    const int c = lane & 7;
#pragma unroll
    for (int j = 0; j < 4; ++j) { const int n = (lane >> 3) + 8 * j; const float* s = scr + (8 * c) * 33 + n;
        uint4 o; o.x = (u32)f2bf(s[0 * 33]) | ((u32)f2bf(s[1 * 33]) << 16); o.y = (u32)f2bf(s[2 * 33]) | ((u32)f2bf(s[3 * 33]) << 16);
        o.z = (u32)f2bf(s[4 * 33]) | ((u32)f2bf(s[5 * 33]) << 16); o.w = (u32)f2bf(s[6 * 33]) | ((u32)f2bf(s[7 * 33]) << 16);
        *(uint4*)(WT + (size_t)(n0 + n) * ldt + koff + k0 + 8 * c) = o; }
    asm volatile("s_waitcnt lgkmcnt(0)" ::: "memory");
}
__device__ __forceinline__ void late_weights(const Params& p, unsigned char* smem, int wg, int nwg) {
    const int tidx = opaque_tid(); const int lane_ = tidx & 63, wv = tidx >> 6;
    float* scr = (float*)(smem + wv * 8704);
    constexpr int I_BR = 8 * 32, I_OUT = 16 * 32, I_ALL = 2 * I_BR + I_OUT;
    for (int it = wg * 8 + wv; it < I_ALL; it += nwg * 8) {
        int r = it;
        if (r < I_BR) { transpose_item<false>(p.w_br_mla, 1024, 1024, (bf16_t*)(p.ws + OFF_WBR), 1024, 0, scr, r, lane_); continue; } r -= I_BR;
        if (r < I_BR) { transpose_item<false>(p.w_br_dsa, 1024, 1024, (bf16_t*)(p.ws + OFF_WBR), 1024, 512, scr, r, lane_); continue; } r -= I_BR;
        transpose_item<false>(p.w_out, 1024, 1024, (bf16_t*)(p.ws + OFF_WOUT), 1024, 0, scr, r, lane_);
    }
}
__device__ __forceinline__ void ph0(const Params& p, unsigned char* smem) {
    const int tidx = opaque_tid(); const int gtid = blockIdx.x * blockDim.x + tidx, gsz = gridDim.x * blockDim.x;
    const int lane = tidx & 63, gw = gtid >> 6, nw = gsz >> 6;
    float4 va[4][4], vb[4][4];
#define PH0_LOAD(V, t_) do { _Pragma("unroll") for (int u = 0; u < 4; ++u) { const float4* xr = (const float4*)(p.x + (size_t)((t_) + u) * DM); \
        _Pragma("unroll") for (int j = 0; j < 4; ++j) V[u][j] = xr[j * 64 + lane]; } } while (0)
    const int st = nw * 4; int t = gw * 4;
    if (t < NT) PH0_LOAD(va, t);
    if (t + st < NT) PH0_LOAD(vb, t + st);
    {
        const int wv = tidx >> 6;
        float* scr = (float*)(smem + wv * 8704);
        constexpr int I_IN = 16 * 144, I_UQ = 4 * 24, I_UKV = 2 * 32;
        for (int it = gw; it < I_IN + I_UQ + I_UKV; it += nw) {
            if (it < I_IN) transpose_item<true>(p.w_in, DIN, NP, (bf16_t*)(p.ws + OFF_WIN), DM, 0, scr, it, lane);
            else if (it < I_IN + I_UQ) transpose_item<false>(p.w_uq, 768, 768, (bf16_t*)(p.ws + OFF_WUQ), 256, 0, scr, it - I_IN, lane);
            else transpose_item<false>(p.w_ukv, 1024, 1024, (bf16_t*)(p.ws + OFF_WUKV), 128, 0, scr, it - I_IN - I_UQ, lane);
        }
    }
    float* rope = (float*)(p.ws + OFF_ROPE);
    for (int i = gtid; i < NT * 28; i += gsz) {
        const int tt = i / 28, j = i % 28;
        const float ang = (float)p.pos[tt] * c_inv_freq[j];
        double s, c; sincos_d((double)ang, s, c);
        *(float2*)(rope + 2 * i) = make_float2((float)c, (float)s);
    }
    bf16_t* H = (bf16_t*)(p.ws + OFF_H);
    float4 g[4];
#pragma unroll
    for (int j = 0; j < 4; ++j) g[j] = *(const float4*)(p.norm_gain + (j * 64 + lane) * 4);
#define PH0_PROC(V, t_) do { _Pragma("unroll") for (int u = 0; u < 4; ++u) { float ss = 0.f; \
        _Pragma("unroll") for (int j = 0; j < 4; ++j) ss += V[u][j].x * V[u][j].x + V[u][j].y * V[u][j].y + V[u][j].z * V[u][j].z + V[u][j].w * V[u][j].w; \
        ss = wave_sum(ss); const float r = rsqrtf(ss * (1.f / DM) + 1e-6f); \
        _Pragma("unroll") for (int j = 0; j < 4; ++j) { \
            uint2 o; o.x = (u32)f2bf(V[u][j].x * r * g[j].x) | ((u32)f2bf(V[u][j].y * r * g[j].y) << 16); o.y = (u32)f2bf(V[u][j].z * r * g[j].z) | ((u32)f2bf(V[u][j].w * r * g[j].w) << 16); \
            *(uint2*)(H + (size_t)((t_) + u) * DM + (j * 64 + lane) * 4) = o; } } } while (0)
    for (;;) {
        if (t >= NT) break;
        PH0_PROC(va, t); if (t + 2 * st < NT) PH0_LOAD(va, t + 2 * st); t += st;
        if (t >= NT) break;
        PH0_PROC(vb, t); if (t + 2 * st < NT) PH0_LOAD(vb, t + 2 * st); t += st;
    }
#undef PH0_LOAD
#undef PH0_PROC
}
__device__ __forceinline__ void ph1(const Params& p, PG8_LAS unsigned char* lds, unsigned* ctr) {
    pg8::Gemm g{(const bf16_t*)(p.ws + OFF_H), (const bf16_t*)(p.ws + OFF_WIN), NT, NP, DM, DM, DM}; pg8::ProjOrder S; S.init(NT, NP, gridDim.x, blockIdx.x); S.ctr = ctr;
    pg8::EpiProj E{(bf16_t*)(p.ws + OFF_PROJ), (bf16_t*)(p.ws + OFF_KI), (float*)(p.ws + OFF_WI), (const float*)(p.ws + OFF_ROPE), p.mla_q_norm, p.mla_kv_norm, p.dsa_k_gain,
                   (PG8_LAS float*)(lds + LDS_XCH)};
    pg8::gemm_phase<pg8::EpiProj, pg8::ProjOrder, true, true>(lds, g, S, E);
}
__device__ __forceinline__ void ph2b(const Params& p, PG8_LAS unsigned char* lds, const bool df) {
    const int bx = blockIdx.x, a = bx - 128;
    { pg8::Gemm g{(const bf16_t*)(p.ws + OFF_PROJ) + C_CQ, (const bf16_t*)(p.ws + OFF_WUQ), NT, 768, 256, NP, 256};
      pg8::ListOrder S{NT / 256, 3, df ? 0 : (int)gridDim.x, bx, a >= 0 ? a : -1, (a >= 0 && a < 64) ? 128 + a : -1};
      pg8::EpiBf16 E{(bf16_t*)((unsigned char*)p.out + OUT_QA), 768};
      pg8::gemm_phase<pg8::EpiBf16, pg8::ListOrder, true, true>(lds, g, S, E); }
    { pg8::Gemm g{(const bf16_t*)(p.ws + OFF_PROJ) + C_CKV, (const bf16_t*)(p.ws + OFF_WUKV), NT, 1024, 128, NP, 128};
      pg8::ListOrder S{NT / 256, 4, df ? 0 : (int)gridDim.x, bx, a >= 0 ? a : (bx < 64 ? 192 + bx : -1), a >= 64 ? 64 + a : -1};
      pg8::EpiKV E{(bf16_t*)((unsigned char*)p.out + OUT_KA), (bf16_t*)(p.ws + OFF_KVA), (const bf16_t*)(p.ws + OFF_PROJ), (const float*)(p.ws + OFF_ROPE), p.mla_k_gain, (PG8_LAS float*)(lds + LDS_XCH)};
      pg8::gemm_phase<pg8::EpiKV, pg8::ListOrder, true, true>(lds, g, S, E); }
}
__device__ __forceinline__ void ph3_sel(const Params& p, unsigned char* smem, volatile __attribute__((address_space(3))) unsigned* slot) {
    const bf16_t* proj = (const bf16_t*)(p.ws + OFF_PROJ); const bf16_t* ki = (const bf16_t*)(p.ws + OFF_KI); const float* wi = (const float*)(p.ws + OFF_WI); u64* M64 = (u64*)(p.ws + OFF_MASK);
    unsigned cnt = 0u;
    const unsigned base = gridDim.x < 512u ? gridDim.x : 512u;
    unsigned t = blockIdx.x;
#pragma unroll 1
    while (t < 512u) {
        const int b = t & 3, qblk = 127 - (int)(t >> 2);
        t = base + sel::sel_unit(b, qblk, proj, ki, wi, M64, smem, &g_bar[BAR_QSEL], slot); cnt += 1u << (8 * b);
    }
    asm volatile("s_waitcnt vmcnt(0)" ::: "memory");
    __syncthreads();
    if (threadIdx.x == 0) { __builtin_amdgcn_fence(__ATOMIC_RELEASE, "agent"); asm volatile("s_waitcnt vmcnt(0)" ::: "memory");
#pragma unroll
        for (int b = 0; b < 4; ++b) { const unsigned c = (cnt >> (8 * b)) & 255u; if (c) __hip_atomic_fetch_add(&g_bar[BAR_SEL + 16 * b], c, __ATOMIC_RELAXED, __HIP_MEMORY_SCOPE_AGENT); } }
}
__device__ __forceinline__ int attn_next(int& k, const int kmax, volatile __attribute__((address_space(3))) unsigned* slot) {
    while (k < kmax) { const int q = ((int)blockIdx.x + k) & 7; const int t = wg_ticket(&g_bar[BAR_QATT + 16 * q], 128u, slot); if (t >= 0) return q * 128 + t; ++k; }
    return -1;
}
struct AttnNext {
    int k, kmax, nxt, base; unsigned tv; bool inflight; volatile __attribute__((address_space(3))) unsigned* slot; const bf16_t* qa; const bf16_t* proj;
    __device__ __forceinline__ void issue() { inflight = k < kmax; if (inflight) tv = ticket_issue(&g_bar[BAR_QATT + 16 * (((int)blockIdx.x + k) & 7)]); }
    __device__ __forceinline__ void draw(const bf16_t*& qn, int& pqn, int& nd0n) {
        nxt = -1;
        if (inflight) { const unsigned v = ticket_collect(tv, slot) + (unsigned)base;
            if (v < 128u) nxt = ((((int)blockIdx.x + k) & 7) << 7) + (int)v; else { ++k; nxt = attn_next(k, kmax, slot); } }
        qn = nullptr; pqn = 768; nd0n = 6;
        if (nxt >= 0) { const int qln = nxt >> 7, in_ = nxt & 127, qbn = 15 - ((in_ & 63) >> 2), bn = qln >> 1, hn = 4 * (qln & 1) + (in_ & 3); const size_t rn = (size_t)bn * SEQ + (size_t)qbn * 256;
            if ((in_ >> 6) == 0) { qn = qa + rn * 768 + hn * 96; pqn = 768; nd0n = 6; } else { qn = proj + rn * NP + C_QB + hn * 64; pqn = NP; nd0n = 4; } }
    }
};
__device__ __forceinline__ void ph_attn(const Params& p, char* shm, const bool df, volatile __attribute__((address_space(3))) unsigned* slot) {
    const bf16_t* qa = (const bf16_t*)((unsigned char*)p.out + OUT_QA); const bf16_t* ka = (const bf16_t*)((unsigned char*)p.out + OUT_KA);
    const bf16_t* kva = (const bf16_t*)(p.ws + OFF_KVA); const bf16_t* proj = (const bf16_t*)(p.ws + OFF_PROJ); bf16_t* ao = (bf16_t*)(p.ws + OFF_AO); const float* rope = (const float*)(p.ws + OFF_ROPE);
    const u64* M64 = (const u64*)(p.ws + OFF_MASK);
    AttnNext nq; nq.k = 0; nq.kmax = (gridDim.x % 8 == 0 && gridDim.x <= 1024) ? 1 : 8; nq.slot = slot; nq.qa = qa; nq.proj = proj; nq.inflight = false; nq.tv = 0u;
    nq.base = nq.kmax == 1 ? (int)(gridDim.x >> 3) : 0;
    att::bf16x8 qpre[6];
    bool pre = false, p2ok = !df; unsigned selok = df ? 0u : 15u;
    int cur = nq.kmax == 1 ? (((int)blockIdx.x & 7) << 7) + ((int)blockIdx.x >> 3) : attn_next(nq.k, nq.kmax, slot);
#pragma unroll 1
    while (cur >= 0) {
        const int ql = cur >> 7, i_ = cur & 127, type = i_ >> 6, qb = 15 - ((i_ & 63) >> 2), b = ql >> 1, kvh = ql & 1, h = 4 * kvh + (i_ & 3); const size_t r0 = (size_t)b * SEQ;
        if (!p2ok) { wg_wait(&g_bar[BAR_P2B], gridDim.x); p2ok = true; }
        if (type == 0) {
            att::attn_unit<96, 768, 768, 1024, 1024, NP, 0>(qb, qa + r0 * 768 + h * 96, ka + r0 * 768 + h * 96, kva + r0 * 1024 + h * 128 + 64,
                                                            ao + r0 * 1024 + h * 64, proj + r0 * NP + C_GA + h * 64, shm, nullptr, rope + r0 * 56, p.mla_q_gain,
                                                            qpre, pre, nq);
        } else {
            if (!((selok >> b) & 1u)) { wg_wait(&g_bar[BAR_SEL + 16 * b], 128u); selok |= 1u << b; }
            att::attn_unit<64, NP, NP, NP, 1024, NP, 1>(qb, proj + r0 * NP + C_QB + h * 64, proj + r0 * NP + C_KB + kvh * 64, proj + r0 * NP + C_VB + kvh * 64,
                                                        ao + r0 * 1024 + 512 + h * 64, proj + r0 * NP + C_GB + h * 64, shm, M64 + (size_t)b * 128 * 128 * 16, rope + r0 * 56, p.dsa_q_gain,
                                                        qpre, pre, nq);
        }
        pre = nq.nxt >= 0; cur = nq.nxt;
    }
}
__device__ __forceinline__ void ph5(const Params& p, PG8_LAS unsigned char* lds) {
    const bf16_t* ao = (const bf16_t*)(p.ws + OFF_AO); const bf16_t* wbr = (const bf16_t*)(p.ws + OFF_WBR);
    pg8::Gemm g{ao, wbr, NT, DM, DM, 1024, 1024}; pg8::StaticOrder S; S.init(NT, DM, gridDim.x, blockIdx.x);
    pg8::EpiGate2 E{(bf16_t*)(p.ws + OFF_MERGED), (const bf16_t*)(p.ws + OFF_PROJ), p.b_merge};
    pg8::gemm_phase<pg8::EpiGate2, pg8::StaticOrder, true, true>(lds, g, S, E);
}
__device__ __forceinline__ void ph6(const Params& p, PG8_LAS unsigned char* lds) {
    pg8::Gemm g{(const bf16_t*)(p.ws + OFF_MERGED), (const bf16_t*)(p.ws + OFF_WOUT), NT, DM, DM, DM, DM}; pg8::StaticOrder S; S.init(NT, DM, gridDim.x, blockIdx.x);
    pg8::EpiResid E{p.out, p.x};
    pg8::gemm_phase<pg8::EpiResid, pg8::StaticOrder, true, true>(lds, g, S, E);
}

__global__ void __launch_bounds__(NTHREADS, 2) fwd_kernel(Params p) {
    extern __shared__ __attribute__((aligned(16))) unsigned char smem[];
    PG8_LAS unsigned char* lds = (PG8_LAS unsigned char*)smem;
    volatile LAS unsigned* misc = (volatile LAS unsigned*)(lds + LDS_MISC);
    if (threadIdx.x < 2) misc[threadIdx.x] = 0u;
    __syncthreads();
    const XcdBarrier bar = xcd_barrier_post(g_bar, misc);
    ph0(p, smem); xcd_barrier(bar);
    const bool df = gridDim.x == 256;
    ph1(p, lds, df ? &g_bar[BAR_P1] : nullptr);
    { const int lw = df ? (int)blockIdx.x - 128 : (int)blockIdx.x; if (lw >= 0) late_weights(p, smem, lw, df ? 128 : (int)gridDim.x); }
    if (df) wg_wait(&g_bar[BAR_P1], gridDim.x); else xcd_barrier(bar);
    ph2b(p, lds, df); if (df) wg_signal(&g_bar[BAR_P2B], 1u);
    ph3_sel(p, smem, misc + 4);
    if (!df) xcd_barrier(bar);
    ph_attn(p, (char*)smem, df, misc + 4); xcd_barrier(bar);
    ph5(p, lds); xcd_barrier(bar);
    ph6(p, lds);
    __syncthreads();
    if (threadIdx.x == 0) { const unsigned d = __hip_atomic_fetch_add(&g_bar[BAR_DONE], 1u, __ATOMIC_RELAXED, __HIP_MEMORY_SCOPE_AGENT); misc[2] = (d + 1u == gridDim.x) ? 1u : 0u; }
    __syncthreads();
    if (misc[2] != 0u) for (int i = threadIdx.x; i < BAR_WORDS; i += NTHREADS) __hip_atomic_store(&g_bar[i], 0u, __ATOMIC_RELAXED, __HIP_MEMORY_SCOPE_AGENT);
}

extern "C" void kernel_launch(void* const* d_in, const int* in_sizes, int n_in, void* d_out, int out_size, void* d_ws, size_t ws_size, hipStream_t stream) {
    static int grid_blocks = 0;
    if (!grid_blocks) {
        int dev = 0, cus = 0, per_cu = 0;
        hipGetDevice(&dev);
        hipDeviceGetAttribute(&cus, hipDeviceAttributeMultiprocessorCount, dev);
        hipFuncSetAttribute((const void*)fwd_kernel, hipFuncAttributeMaxDynamicSharedMemorySize, LDS_BYTES);
        hipOccupancyMaxActiveBlocksPerMultiprocessor(&per_cu, (const void*)fwd_kernel, NTHREADS, LDS_BYTES);
        if (per_cu < 1) per_cu = 1;
        grid_blocks = cus * per_cu;
    }
    Params p{};
    p.x = (const float*)d_in[0]; p.pos = (const int*)d_in[1]; p.norm_gain = (const float*)d_in[2]; p.w_in = (const float*)d_in[3]; p.b_merge = (const float*)d_in[4];
    p.mla_q_norm = (const float*)d_in[5]; p.w_uq = (const float*)d_in[6]; p.mla_kv_norm = (const float*)d_in[7]; p.w_ukv = (const float*)d_in[8];
    p.mla_q_gain = (const float*)d_in[9]; p.mla_k_gain = (const float*)d_in[10]; p.dsa_q_gain = (const float*)d_in[11]; p.dsa_k_gain = (const float*)d_in[12];
    p.w_br_mla = (const float*)d_in[13]; p.w_br_dsa = (const float*)d_in[14]; p.w_out = (const float*)d_in[15];
    p.out = (float*)d_out; p.ws = (unsigned char*)d_ws;
    void* args[] = {&p};
    hipError_t e = hipLaunchCooperativeKernel((const void*)fwd_kernel, dim3(grid_blocks), dim3(NTHREADS), args, LDS_BYTES, stream);
    if (e != hipSuccess) fprintf(stderr, "cooperative launch failed: %s (grid %d)\n", hipGetErrorString(e), grid_blocks);
}
```

```cpp
#include <hip/hip_runtime.h>
#include <cstdio>

typedef unsigned short bf16_t;
typedef unsigned int u32;
typedef unsigned long long u64;

constexpr int NB = 4, SEQ = 4096, NT = NB * SEQ, DM = 1024, DIN = 4552, NP = 4608;
constexpr int C_CQ = 0, C_CKV = 256, C_KPE = 384, C_KI = 416, C_WI = 448, C_GA = 512, C_QB = 1024, C_KB = 1536, C_VB = 1664,
              C_GB = 1792, C_QI = 2304, C_MA = 2560, C_MB = 3584;
constexpr size_t MiB = 1u << 20;
constexpr size_t OFF_WIN = 0, OFF_WUQ = 9 * MiB, OFF_WUKV = 9 * MiB + 512 * 1024, OFF_WBR = 10 * MiB, OFF_WOUT = 12 * MiB,
                 OFF_ROPE = 14 * MiB, OFF_WI = 17 * MiB + 512 * 1024, OFF_H = 18 * MiB, OFF_AO = 18 * MiB, OFF_PROJ = 50 * MiB,
                 OFF_KVA = 206 * MiB, OFF_MERGED = 206 * MiB, OFF_MASK = 238 * MiB, OFF_KI = 246 * MiB;
constexpr int BAR_WORDS = 4544, BAR_DONE = 3520;
constexpr int BAR_XSEL = 4032;
constexpr int BAR_XP1 = 4288;
constexpr int BAR_XP2B = 3776;
constexpr int BAR_QSEL = 3632, BAR_QATT = 3648;
constexpr int BAR_P1 = 3536, BAR_P2B = 3552, BAR_SEL = 3568;
__device__ __attribute__((aligned(16))) unsigned g_bar[BAR_WORDS];
constexpr int LDS_MISC = 131072 + 512;
constexpr int LDS_XCH = 131072 + 1024;
constexpr size_t OUT_QA = 0, OUT_KA = 24 * MiB;
constexpr int LDS_BYTES = 147456;
constexpr int NTHREADS = 512;

struct Params {
    const float* x; const int* pos; const float* norm_gain; const float* w_in; const float* b_merge;
    const float* mla_q_norm; const float* w_uq; const float* mla_kv_norm; const float* w_ukv;
    const float* mla_q_gain; const float* mla_k_gain; const float* dsa_q_gain; const float* dsa_k_gain;
    const float* w_br_mla; const float* w_br_dsa; const float* w_out;
    float* out; unsigned char* ws;
};

__device__ const float c_inv_freq[28] = {
    1.000000000e+00f, 4.403665960e-01f, 1.939227432e-01f, 8.539710194e-02f, 3.760603070e-02f, 1.656044088e-02f, 7.292664610e-03f, 3.211446106e-03f,
    1.414213562e-03f, 6.227724371e-04f, 2.742481884e-04f, 1.207697351e-04f, 5.318295734e-05f, 2.341999971e-05f, 1.031338525e-05f, 4.541670478e-06f,
    1.000000000e+00f, 1.939227432e-01f, 3.760603070e-02f, 7.292664610e-03f, 1.414213562e-03f, 2.742481884e-04f, 5.318295734e-05f, 1.031338525e-05f,
    1.000000000e+00f, 3.760603070e-02f, 1.414213562e-03f, 5.318295734e-05f};

__device__ __forceinline__ void wg_signal(unsigned* ctr, unsigned inc) {
    asm volatile("s_waitcnt vmcnt(0)" ::: "memory");
    __syncthreads();
    if (threadIdx.x == 0) { __builtin_amdgcn_fence(__ATOMIC_RELEASE, "agent"); asm volatile("s_waitcnt vmcnt(0)" ::: "memory");
        __hip_atomic_fetch_add(ctr, inc, __ATOMIC_RELAXED, __HIP_MEMORY_SCOPE_AGENT); }
}
__device__ __forceinline__ void wg_signal_xcc(unsigned* xcc_ctr, unsigned* ctr, unsigned nloc) {
    asm volatile("s_waitcnt vmcnt(0)" ::: "memory");
    __syncthreads();
    if (threadIdx.x == 0) {
        const unsigned old = __hip_atomic_fetch_add(xcc_ctr, 1u, __ATOMIC_RELAXED, __HIP_MEMORY_SCOPE_AGENT);
        if (old + 1u == nloc) { __builtin_amdgcn_fence(__ATOMIC_RELEASE, "agent"); asm volatile("s_waitcnt vmcnt(0)" ::: "memory");
            __hip_atomic_fetch_add(ctr, nloc, __ATOMIC_RELAXED, __HIP_MEMORY_SCOPE_AGENT); }
    }
}
__device__ __forceinline__ void wg_wait(unsigned* ctr, unsigned target) {
    if (threadIdx.x == 0) { unsigned sp = 0u;
        while (__hip_atomic_load(ctr, __ATOMIC_RELAXED, __HIP_MEMORY_SCOPE_AGENT) < target) { __builtin_amdgcn_s_sleep(2); if (++sp > (1u << 24)) break; }
        __builtin_amdgcn_fence(__ATOMIC_ACQUIRE, "agent"); asm volatile("s_waitcnt vmcnt(0)" ::: "memory"); }
    __syncthreads();
}
__device__ __forceinline__ int wg_ticket(unsigned* ctr, unsigned limit, volatile __attribute__((address_space(3))) unsigned* slot) {
    __syncthreads();
    if (threadIdx.x == 0) *slot = __hip_atomic_fetch_add(ctr, 1u, __ATOMIC_RELAXED, __HIP_MEMORY_SCOPE_AGENT);
    __syncthreads();
    const unsigned v = (unsigned)__builtin_amdgcn_readfirstlane((int)*slot);
    return v < limit ? (int)v : -1;
}
__device__ __forceinline__ unsigned ticket_issue(unsigned* ctr) {
    unsigned tv = 0u; if (threadIdx.x == 0) tv = __hip_atomic_fetch_add(ctr, 1u, __ATOMIC_RELAXED, __HIP_MEMORY_SCOPE_AGENT);
    return tv;
}
__device__ __forceinline__ unsigned ticket_collect(unsigned tv, volatile __attribute__((address_space(3))) unsigned* slot) {
    if (threadIdx.x == 0) *slot = tv;
    __syncthreads();
    return (unsigned)__builtin_amdgcn_readfirstlane((int)*slot);
}
__device__ __forceinline__ int opaque_tid() { int t = threadIdx.x; asm volatile("" : "+v"(t)); return t; }
__device__ __forceinline__ float bf2f(bf16_t v) { return __uint_as_float(((u32)v) << 16); }
__device__ __forceinline__ bf16_t f2bf(float f) { u32 u = __float_as_uint(f); return (bf16_t)((u + 0x7fffu + ((u >> 16) & 1u)) >> 16); }
__device__ __forceinline__ float wave_sum(float v) {
#pragma unroll
    for (int o = 1; o < 64; o <<= 1) v += __shfl_xor(v, o);
    return v;
}
__device__ __forceinline__ float wave_max(float v) {
#pragma unroll
    for (int o = 1; o < 64; o <<= 1) v = fmaxf(v, __shfl_xor(v, o));
    return v;
}
__device__ __forceinline__ int oldcol(int n) {
    if (n < 416) return n;
    if (n < 448) return 2464 + (n - 416);
    if (n < 456) return 2496 + (n - 448);
    if (n < 512) return -1;
    if (n < 1024) return 416 + (n - 512);
    if (n < 1536) return 928 + (n - 1024);
    if (n < 1664) return 1440 + (n - 1536);
    if (n < 1792) return 1568 + (n - 1664);
    if (n < 2304) return 1696 + (n - 1792);
    if (n < 2560) return 2208 + (n - 2304);
    if (n < 3584) return 2504 + (n - 2560);
    return 3528 + (n - 3584);
}
__device__ __forceinline__ void sincos_d(double x, double& s, double& c) {
    const double two_over_pi = 0.63661977236758134308, pio2_hi = 1.57079632679489655800e+00, pio2_lo = 6.12323399573676603587e-17;
    const double q = rint(x * two_over_pi);
    double r = fma(-q, pio2_hi, x); r = fma(-q, pio2_lo, r);
    const double r2 = r * r;
    double sp = 1.0 / 1307674368000.0;
    sp = fma(sp, r2, -1.0 / 6227020800.0);
    sp = fma(sp, r2, 1.0 / 39916800.0);
    sp = fma(sp, r2, -1.0 / 362880.0);
    sp = fma(sp, r2, 1.0 / 5040.0);
    sp = fma(sp, r2, -1.0 / 120.0);
    sp = fma(sp, r2, 1.0 / 6.0);
    sp = fma(sp, -r2, 1.0);
    const double sr = sp * r;
    double cp = 1.0 / 20922789888000.0;
    cp = fma(cp, r2, -1.0 / 87178291200.0);
    cp = fma(cp, r2, 1.0 / 479001600.0);
    cp = fma(cp, r2, -1.0 / 3628800.0);
    cp = fma(cp, r2, 1.0 / 40320.0);
    cp = fma(cp, r2, -1.0 / 720.0);
    cp = fma(cp, r2, 1.0 / 24.0);
    cp = fma(cp, r2, -0.5);
    const double cr = fma(cp, r2, 1.0);
    const int n = ((int)q) & 3;
    s = (n == 0) ? sr : (n == 1) ? cr : (n == 2) ? -sr : -cr;
    c = (n == 0) ? cr : (n == 1) ? -sr : (n == 2) ? -cr : sr;
}

__device__ __forceinline__ void unpack8(const uint4 w, float (&f)[8]) {
    f[0] = __uint_as_float(w.x << 16); f[1] = __uint_as_float(w.x & 0xffff0000u);
    f[2] = __uint_as_float(w.y << 16); f[3] = __uint_as_float(w.y & 0xffff0000u);
    f[4] = __uint_as_float(w.z << 16); f[5] = __uint_as_float(w.z & 0xffff0000u);
    f[6] = __uint_as_float(w.w << 16); f[7] = __uint_as_float(w.w & 0xffff0000u);
}

namespace pg8 {
#define PG8_LAS __attribute__((address_space(3)))
typedef unsigned short bf16_t;
typedef short bf16x8 __attribute__((ext_vector_type(8)));
typedef float f32x4 __attribute__((ext_vector_type(4)));
typedef unsigned u32x4 __attribute__((ext_vector_type(4)));
constexpr int BM = 256, BK = 64, HALF = 128, HTB = HALF * BK * 2  , STAGE_BYTES = 8 * HTB, NXCD = 8, WGM = 8;

__host__ __device__ __forceinline__ int lds_byte(int r, int c) { const int st = (r >> 4) * 2 + (c >> 5), rr = r & 15, cc = c & 31, ob = rr * 64 + cc * 2; return st * 1024 + (ob ^ (((ob >> 9) & 1) << 5)); }
__host__ __device__ __forceinline__ void stage_rc(int b, int& R, int& C) { const int st = b / 1024, sb = b % 1024, swz = sb ^ (((sb >> 9) & 1) << 5); R = (st >> 1) * 16 + swz / 64; C = (st & 1) * 32 + (swz % 64) / 2; }
__host__ __device__ __forceinline__ int perm32(int rho) { const int n = rho >> 4, i = rho & 15; return 8 * (i >> 2) + 4 * n + (i & 3); }

struct Unit { int pm, pn; };
struct Gemm { const bf16_t* A; const bf16_t* Bt; int M, N, K, lda, ldb; };

struct StaticOrder {
    int nM, nN, nwg, G, c;
    __host__ __device__ void init(int M, int N, int G_, int c_) { nM = M / BM; nN = N / BM; nwg = nM * nN; G = G_; c = c_; }
    __host__ __device__ bool next(int i, Unit& u) const {
        const long L = (long)i * G + c; if (L >= nwg) return false;
        int wgid = (int)L; { const int q = nwg / NXCD, r = nwg % NXCD, xcd = wgid % NXCD, off = wgid / NXCD; wgid = (xcd < r ? xcd * (q + 1) : r * (q + 1) + (xcd - r) * q) + off; }
        const int nig = WGM * nN, gid = wgid / nig, fm = gid * WGM, gsz = (nM - fm) < WGM ? (nM - fm) : WGM;
        u.pm = fm + ((wgid % nig) % gsz); u.pn = (wgid % nig) / gsz; return true;
    }
    __device__ __forceinline__ void a_ready(const Unit&) const {}
    __device__ __forceinline__ void done(const Unit&) const {}
};
struct ProjOrder : StaticOrder {
    unsigned* ctr; unsigned* xctr; unsigned nloc;
    __device__ __forceinline__ void done(const Unit& u) const { if (ctr && (u.pn == 0 || u.pn == 9)) wg_signal_xcc(xctr, ctr, nloc); }
};
struct ListOrder {
    int nM, nN, G, c, id0, id1;
    __host__ __device__ bool next(int i, Unit& u) const {
        int L; if (G > 0) { L = i * G + c; if (L >= nM * nN) return false; } else { L = i == 0 ? id0 : (i == 1 ? id1 : -1); if (L < 0) return false; }
        u.pm = L / nN; u.pn = L % nN; return true;
    }
    __device__ __forceinline__ void a_ready(const Unit&) const {}
    __device__ __forceinline__ void done(const Unit&) const {}
};


__device__ __forceinline__ unsigned cvt_pk_bf16(float lo, float hi) { unsigned r; asm volatile("v_cvt_pk_bf16_f32 %0, %1, %2" : "=v"(r) : "v"(lo), "v"(hi)); return r; }
struct EpiBf16 {
    static constexpr bool PERM = true, AFTER_DRAIN = false, MID = false;
    bf16_t* O; int ldc;
    __device__ __forceinline__ void operator()(const f32x4 (&acc)[2][2][4][2], const Unit& u, int wr, int wc, int fr, int fq) const {
        const int row0 = u.pm * BM + wr * 64 + fr, col0 = u.pn * BM + wc * 32 + 8 * fq;
#pragma unroll
        for (int ai = 0; ai < 2; ++ai)
#pragma unroll
            for (int m = 0; m < 4; ++m) { bf16_t* rowp = O + (size_t)(row0 + ai * HALF + m * 16) * ldc + col0;
#pragma unroll
                for (int bj = 0; bj < 2; ++bj) { const f32x4 v0 = acc[ai][bj][m][0], v1 = acc[ai][bj][m][1];
                    u32x4 w; w.x = cvt_pk_bf16(v0[0], v0[1]); w.y = cvt_pk_bf16(v0[2], v0[3]); w.z = cvt_pk_bf16(v1[0], v1[1]); w.w = cvt_pk_bf16(v1[2], v1[3]);
                    *(u32x4*)(rowp + bj * HALF) = w; } }
    }
};
struct EpiProj {
    static constexpr bool PERM = true, AFTER_DRAIN = false, MID = false;
    bf16_t* proj; bf16_t* kic; float* wi; const float* rope; const float* gq; const float* gkv; const float* gkb; PG8_LAS float* xch; const float* bm;
    __device__ __forceinline__ static unsigned q8x4(const f32x4 v) { unsigned w = 0u;
#pragma unroll
        for (int j = 0; j < 4; ++j) w = __builtin_amdgcn_cvt_pk_u8_f32(__builtin_floorf(__builtin_fmaf(v[j], 21.25f, 128.0f)), j, w);
        return w; }
    __device__ __forceinline__ static void st8v(bf16_t* p, const f32x4 a, const f32x4 b) {
        u32x4 w; w.x = cvt_pk_bf16(a[0], a[1]); w.y = cvt_pk_bf16(a[2], a[3]); w.z = cvt_pk_bf16(b[0], b[1]); w.w = cvt_pk_bf16(b[2], b[3]); *(u32x4*)p = w; }
    __device__ __forceinline__ void operator()(const f32x4 (&acc)[2][2][4][2], const Unit& u, int wr, int wc, int fr, int fq) const {
        const int pn = u.pn; const int rowb = u.pm * BM + wr * 64 + fr;
        const bool normt = (pn == 0) | (pn == 1) | (pn == 6);
        if (normt) {
#pragma unroll
            for (int ai = 0; ai < 2; ++ai)
#pragma unroll
                for (int m = 0; m < 4; ++m) {
                    float s = 0.f;
#pragma unroll
                    for (int n = 0; n < 2; ++n)
#pragma unroll
                        for (int j = 0; j < 4; ++j) { s = __builtin_fmaf(acc[ai][0][m][n][j], acc[ai][0][m][n][j], s); if (pn == 0) s = __builtin_fmaf(acc[ai][1][m][n][j], acc[ai][1][m][n][j], s); }
                    s += __shfl_xor(s, 16); s += __shfl_xor(s, 32);
                    if (fq == 0) xch[(ai * HALF + wr * 64 + m * 16 + fr) * 4 + wc] = s;
                }
            asm volatile("s_waitcnt lgkmcnt(0)" ::: "memory"); __builtin_amdgcn_s_barrier(); asm volatile("" ::: "memory");
        }
#pragma unroll
        for (int am = 0; am < 4; ++am) { const int ai = am >> 1;
            f32x4 rc[4][4];
            if (pn == 1 || pn == 9) {
#pragma unroll
                for (int mm = 0; mm < 2; ++mm) { const int m = 2 * (am & 1) + mm; const float* cs_ = rope + (size_t)(rowb + ai * HALF + m * 16) * 56; rc[m][0] = *(const f32x4*)(cs_ + 48); rc[m][1] = *(const f32x4*)(cs_ + 52); }
            } else if (pn == 6) {
#pragma unroll
                for (int mm = 0; mm < 2; ++mm) { const int m = 2 * (am & 1) + mm; const float* cs_ = rope + (size_t)(rowb + ai * HALF + m * 16) * 56;
#pragma unroll
                    for (int i = 0; i < 4; ++i) rc[m][i] = *(const f32x4*)(cs_ + 32 + 4 * i); }
            }
#pragma unroll
            for (int mm = 0; mm < 2; ++mm) { const int m = 2 * (am & 1) + mm;
                const int rl = ai * HALF + wr * 64 + m * 16 + fr; const size_t row = (size_t)(rowb + ai * HALF + m * 16);
                bf16_t* prow = proj + row * NP;
                f32x4 a0 = acc[ai][0][m][0], a1 = acc[ai][0][m][1], b0 = acc[ai][1][m][0], b1 = acc[ai][1][m][1];
                const int c = wc * 32 + 8 * fq;
                if (pn == 0) {
                    const f32x4 pp = *(const PG8_LAS f32x4*)(xch + rl * 4); const float r = rsqrtf(((pp[0] + pp[1]) + (pp[2] + pp[3])) * (1.f / 256.f) + 1e-6f);
                    const f32x4 g0 = *(const f32x4*)(gq + c), g1 = *(const f32x4*)(gq + c + 4), g2 = *(const f32x4*)(gq + 128 + c), g3 = *(const f32x4*)(gq + 128 + c + 4);
                    st8v(prow + C_CQ + c, a0 * r * g0, a1 * r * g1); st8v(prow + C_CQ + 128 + c, b0 * r * g2, b1 * r * g3);
                } else if (pn == 1) {
                    const f32x4 pp = *(const PG8_LAS f32x4*)(xch + rl * 4); const float r = rsqrtf(((pp[0] + pp[1]) + (pp[2] + pp[3])) * (1.f / 128.f) + 1e-6f);
                    const f32x4 g0 = *(const f32x4*)(gkv + c), g1 = *(const f32x4*)(gkv + c + 4);
                    st8v(prow + C_CKV + c, a0 * r * g0, a1 * r * g1);
                    if (wc == 0) st8v(prow + C_KPE + 8 * fq, b0, b1);
                    else if (wc == 1) {
                        if (fq == 0) { const f32x4 c0 = rc[m][0], c1 = rc[m][1];
                            const f32x4 x1 = b0, x2 = b1;
                            b0[0] = x1[0] * c0[0] - x2[0] * c0[1]; b1[0] = x2[0] * c0[0] + x1[0] * c0[1]; b0[1] = x1[1] * c0[2] - x2[1] * c0[3]; b1[1] = x2[1] * c0[2] + x1[1] * c0[3];
                            b0[2] = x1[2] * c1[0] - x2[2] * c1[1]; b1[2] = x2[2] * c1[0] + x1[2] * c1[1]; b0[3] = x1[3] * c1[2] - x2[3] * c1[3]; b1[3] = x2[3] * c1[2] + x1[3] * c1[3]; }
                        st8v(kic + row * 32 + 8 * fq, b0, b1);
                    } else if (wc == 2 && fq == 0) { *(f32x4*)(wi + row * 8) = b0 * 0.0625f; *(f32x4*)(wi + row * 8 + 4) = b1 * 0.0625f; }
                } else if (pn == 6) {
                    const f32x4 pp = *(const PG8_LAS f32x4*)(xch + rl * 4); const float tot = (wc & 2) ? (pp[2] + pp[3]) : (pp[0] + pp[1]); const float r = rsqrtf(tot * (1.f / 64.f) + 1e-6f);
                    const int d = (wc & 1) * 32 + 8 * fq;
                    const f32x4 g0 = *(const f32x4*)(gkb + d), g1 = *(const f32x4*)(gkb + d + 4);
                    a0 = a0 * r * g0; a1 = a1 * r * g1;
                    {
                        f32x4 p0, p1;
#pragma unroll
                        for (int j = 0; j < 4; ++j) { p0[j] = __shfl_xor(a0[j], 16); p1[j] = __shfl_xor(a1[j], 16); }
                        if ((wc & 1) == 0 && fq < 2) {
                            const f32x4 c0 = rc[m][0], c1 = rc[m][1], c2 = rc[m][2], c3 = rc[m][3];
                            const float sg = fq == 0 ? -1.f : 1.f;
                            a0[0] = a0[0] * c0[0] + sg * p0[0] * c0[1]; a0[1] = a0[1] * c0[2] + sg * p0[1] * c0[3]; a0[2] = a0[2] * c1[0] + sg * p0[2] * c1[1]; a0[3] = a0[3] * c1[2] + sg * p0[3] * c1[3];
                            a1[0] = a1[0] * c2[0] + sg * p1[0] * c2[1]; a1[1] = a1[1] * c2[2] + sg * p1[1] * c2[3]; a1[2] = a1[2] * c3[0] + sg * p1[2] * c3[1]; a1[3] = a1[3] * c3[2] + sg * p1[3] * c3[3];
                        }
                    }
                    st8v(prow + C_KB + (wc >> 1) * 64 + d, a0, a1);
                    st8v(prow + C_VB + c, b0, b1);
                } else if (pn == 9) {
                    if (fq == 0) { const f32x4 c0 = rc[m][0], c1 = rc[m][1];
#pragma unroll
                        for (int hb = 0; hb < 2; ++hb) { f32x4& x1r = hb ? b0 : a0; f32x4& x2r = hb ? b1 : a1; const f32x4 x1 = x1r, x2 = x2r;
                            x1r[0] = x1[0] * c0[0] - x2[0] * c0[1]; x2r[0] = x2[0] * c0[0] + x1[0] * c0[1]; x1r[1] = x1[1] * c0[2] - x2[1] * c0[3]; x2r[1] = x2[1] * c0[2] + x1[1] * c0[3];
                            x1r[2] = x1[2] * c1[0] - x2[2] * c1[1]; x2r[2] = x2[2] * c1[0] + x1[2] * c1[1]; x1r[3] = x1[3] * c1[2] - x2[3] * c1[3]; x2r[3] = x2[3] * c1[2] + x1[3] * c1[3]; } }
                    st8v(prow + C_QI + c, a0, a1); st8v(prow + C_QI + 128 + c, b0, b1);
                } else {
                    if (pn >= 10) {
                        const int gc = (pn - 10) * 256 + c; unsigned char* grow = (unsigned char*)prow + 2 * C_MA;
                        uint2 w0; w0.x = q8x4(a0); w0.y = q8x4(a1); uint2 w1; w1.x = q8x4(b0); w1.y = q8x4(b1);
                        *(uint2*)(grow + gc) = w0; *(uint2*)(grow + gc + 128) = w1;
                    } else { st8v(prow + pn * 256 + c, a0, a1); st8v(prow + pn * 256 + 128 + c, b0, b1); }
                }
            }
        }
    }
};
__device__ __forceinline__ size_t ka_img(const size_t row, const int h, const int d) {
    const size_t b = row >> 12, sq = row & 4095;
    return ((((b * 8 + h) * 64 + (sq >> 6)) * 12 + (size_t)(d >> 3)) * 64 + (sq & 63)) * 8;
}
struct EpiKV {
    static constexpr bool PERM = true, AFTER_DRAIN = false, MID = false, INIT = false;
    bf16_t* ka; bf16_t* kva; const bf16_t* proj; const float* rope; const float* gk; PG8_LAS float* xch;
    __device__ __forceinline__ void operator()(const f32x4 (&acc)[2][2][4][2], const Unit& u, int wr, int wc, int fr, int fq) const {
        const int pn = u.pn; const int rowb = u.pm * BM + wr * 64 + fr;
        u32x4 kpe[2]; f32x4 cr[2][4];
#pragma unroll
        for (int ai = 0; ai < 2; ++ai) { const size_t row_ = (size_t)(rowb + ai * HALF + wc * 16);
            kpe[ai] = *(const u32x4*)(proj + row_ * NP + C_KPE + 8 * fq);
            const float* cs = rope + row_ * 56 + (fq & 1) * 16;
#pragma unroll
            for (int i = 0; i < 4; ++i) cr[ai][i] = *(const f32x4*)(cs + 4 * i); }
#pragma unroll
        for (int ai = 0; ai < 2; ++ai)
#pragma unroll
            for (int m = 0; m < 4; ++m) {
                const int rl = ai * HALF + wr * 64 + m * 16 + fr;
                if (wc < 2) {
#pragma unroll
                    for (int bj = 0; bj < 2; ++bj) { float s = 0.f;
#pragma unroll
                        for (int n = 0; n < 2; ++n)
#pragma unroll
                            for (int j = 0; j < 4; ++j) s = __builtin_fmaf(acc[ai][bj][m][n][j], acc[ai][bj][m][n][j], s);
                        s += __shfl_xor(s, 16); s += __shfl_xor(s, 32);
                        if (fq == 0) xch[(rl * 2 + bj) * 4 + wc] = s; }
                }
            }
#pragma unroll
        for (int ai = 0; ai < 2; ++ai) {
            const int rl = ai * HALF + wr * 64 + wc * 16 + fr; const u32x4 w = kpe[ai];
            const f32x4 q0 = (f32x4){__uint_as_float(w.x << 16), __uint_as_float(w.x & 0xffff0000u), __uint_as_float(w.y << 16), __uint_as_float(w.y & 0xffff0000u)};
            const f32x4 q1 = (f32x4){__uint_as_float(w.z << 16), __uint_as_float(w.z & 0xffff0000u), __uint_as_float(w.w << 16), __uint_as_float(w.w & 0xffff0000u)};
            float s = 0.f;
#pragma unroll
            for (int j = 0; j < 4; ++j) { s = __builtin_fmaf(q0[j], q0[j], s); s = __builtin_fmaf(q1[j], q1[j], s); }
            s += __shfl_xor(s, 16); s += __shfl_xor(s, 32);
            if (fq == 0) { xch[(rl * 2 + 0) * 4 + 2] = s; xch[(rl * 2 + 1) * 4 + 2] = s; }
        }
        asm volatile("s_waitcnt lgkmcnt(0)" ::: "memory"); __builtin_amdgcn_s_barrier(); asm volatile("" ::: "memory");
#pragma unroll
        for (int ai = 0; ai < 2; ++ai)
#pragma unroll
            for (int m = 0; m < 4; ++m) {
                const int rl = ai * HALF + wr * 64 + m * 16 + fr; const size_t row = (size_t)(rowb + ai * HALF + m * 16);
#pragma unroll
                for (int bj = 0; bj < 2; ++bj) {
                    const int h = 2 * pn + bj;
                    const f32x4 a0 = acc[ai][bj][m][0], a1 = acc[ai][bj][m][1];
                    if (wc >= 2) EpiProj::st8v(kva + row * 1024 + h * 128 + 64 + (wc - 2) * 32 + 8 * fq, a0, a1);
                    else {
                        const f32x4 pp = *(const PG8_LAS f32x4*)(xch + (rl * 2 + bj) * 4); const float r = rsqrtf((pp[0] + pp[1] + pp[2]) * (1.f / 96.f) + 1e-6f);
                        const int d = wc * 32 + 8 * fq; const f32x4 g0 = *(const f32x4*)(gk + d), g1 = *(const f32x4*)(gk + d + 4);
                        EpiProj::st8v(ka + ka_img(row, h, d), a0 * r * g0, a1 * r * g1);
                    }
                }
            }
#pragma unroll
        for (int ai = 0; ai < 2; ++ai) {
            const int rl = ai * HALF + wr * 64 + wc * 16 + fr; const size_t row = (size_t)(rowb + ai * HALF + wc * 16); const u32x4 w = kpe[ai];
            const f32x4 pe0 = (f32x4){__uint_as_float(w.x << 16), __uint_as_float(w.x & 0xffff0000u), __uint_as_float(w.y << 16), __uint_as_float(w.y & 0xffff0000u)};
            const f32x4 pe1 = (f32x4){__uint_as_float(w.z << 16), __uint_as_float(w.z & 0xffff0000u), __uint_as_float(w.w << 16), __uint_as_float(w.w & 0xffff0000u)};
            const int d = 64 + 8 * fq; const f32x4 g0 = *(const f32x4*)(gk + d), g1 = *(const f32x4*)(gk + d + 4);
            const f32x4 c0 = cr[ai][0], c1 = cr[ai][1], c2 = cr[ai][2], c3 = cr[ai][3];
            const float sg = fq < 2 ? -1.f : 1.f;
#pragma unroll
            for (int bj = 0; bj < 2; ++bj) {
                const int h = 2 * pn + bj;
                const f32x4 pp = *(const PG8_LAS f32x4*)(xch + (rl * 2 + bj) * 4); const float r = rsqrtf((pp[0] + pp[1] + pp[2]) * (1.f / 96.f) + 1e-6f);
                f32x4 y0 = pe0 * r * g0, y1 = pe1 * r * g1, p0, p1;
#pragma unroll
                for (int j = 0; j < 4; ++j) { p0[j] = __shfl_xor(y0[j], 32); p1[j] = __shfl_xor(y1[j], 32); }
                y0[0] = y0[0] * c0[0] + sg * p0[0] * c0[1]; y0[1] = y0[1] * c0[2] + sg * p0[1] * c0[3]; y0[2] = y0[2] * c1[0] + sg * p0[2] * c1[1]; y0[3] = y0[3] * c1[2] + sg * p0[3] * c1[3];
                y1[0] = y1[0] * c2[0] + sg * p1[0] * c2[1]; y1[1] = y1[1] * c2[2] + sg * p1[1] * c2[3]; y1[2] = y1[2] * c3[0] + sg * p1[2] * c3[1]; y1[3] = y1[3] * c3[2] + sg * p1[3] * c3[3];
                EpiProj::st8v(ka + ka_img(row, h, d), y0, y1);
            }
        }
    }
};
__device__ __forceinline__ float expneg_c(float v) { return __expf(-__builtin_fminf(__builtin_fmaxf(v, -80.f), 80.f)); }
struct EpiGate2 {
    static constexpr bool PERM = true, AFTER_DRAIN = false, MID = true;
    bf16_t* O; const bf16_t* proj; const float* bias;
    __device__ __forceinline__ static float eg(unsigned w, int j, float kb) { return __builtin_amdgcn_exp2f(__builtin_fmaf((float)((w >> (8 * j)) & 0xffu), -(12.f / 255.f) * 1.44269504f, kb)); }
    __device__ __forceinline__ void mid(f32x4 (&acc)[2][2][4][2], const Unit& u, int wr, int wc, int fr, int fq) const {
        int row0 = u.pm * BM + wr * 64 + fr, col0 = u.pn * BM + wc * 32 + 8 * fq;
        asm volatile("" : "+v"(row0), "+v"(col0));
        uint2 wa[2][8], wb[2][8];
#pragma unroll
        for (int bj = 0; bj < 2; ++bj)
#pragma unroll
            for (int q = 0; q < 8; ++q) { const unsigned char* g = (const unsigned char*)(proj + (size_t)(row0 + (q >> 2) * HALF + (q & 3) * 16) * NP) + 2 * C_MA + col0 + bj * HALF;
                wa[bj][q] = *(const uint2*)g; wb[bj][q] = *(const uint2*)(g + 1024); }
#pragma unroll
        for (int bj = 0; bj < 2; ++bj) { const int col = col0 + bj * HALF;
            f32x4 ba[2], bb[2];
#pragma unroll
            for (int n = 0; n < 2; ++n) { ba[n] = (6.f - *(const f32x4*)(bias + col + 4 * n)) * 1.44269504f; bb[n] = (6.f - *(const f32x4*)(bias + 1024 + col + 4 * n)) * 1.44269504f; }
#pragma unroll
            for (int q = 0; q < 8; ++q)
#pragma unroll
                for (int j = 0; j < 4; ++j) {
                    acc[q >> 2][bj][q & 3][0][j] *= (1.f + eg(wb[bj][q].x, j, bb[0][j])) * __builtin_amdgcn_rcpf(1.f + eg(wa[bj][q].x, j, ba[0][j]));
                    acc[q >> 2][bj][q & 3][1][j] *= (1.f + eg(wb[bj][q].y, j, bb[1][j])) * __builtin_amdgcn_rcpf(1.f + eg(wa[bj][q].y, j, ba[1][j])); }
        }
        asm volatile("" ::: "memory");
    }
    __device__ __forceinline__ void operator()(const f32x4 (&acc)[2][2][4][2], const Unit& u, int wr, int wc, int fr, int fq) const {
        const int row0 = u.pm * BM + wr * 64 + fr, col0 = u.pn * BM + wc * 32 + 8 * fq;
#pragma unroll
        for (int bj = 0; bj < 2; ++bj) { const int col = col0 + bj * HALF;
            f32x4 bb[2];
#pragma unroll
            for (int n = 0; n < 2; ++n) bb[n] = (6.f - *(const f32x4*)(bias + 1024 + col + 4 * n)) * 1.44269504f;
            uint2 wbq[8];
#pragma unroll
            for (int q = 0; q < 8; ++q) { const size_t row = (size_t)(row0 + (q >> 2) * HALF + (q & 3) * 16); wbq[q] = *(const uint2*)((const unsigned char*)(proj + row * NP) + 2 * C_MA + 1024 + col); }
#pragma unroll
            for (int q = 0; q < 8; ++q) { const size_t row = (size_t)(row0 + (q >> 2) * HALF + (q & 3) * 16); const uint2 wb = wbq[q]; u32x4 w;
#define EG2_G(word, j, n) __builtin_amdgcn_rcpf(1.f + eg(word, j, bb[n][j]))
                w[0] = cvt_pk_bf16(acc[q >> 2][bj][q & 3][0][0] * EG2_G(wb.x, 0, 0), acc[q >> 2][bj][q & 3][0][1] * EG2_G(wb.x, 1, 0));
                w[1] = cvt_pk_bf16(acc[q >> 2][bj][q & 3][0][2] * EG2_G(wb.x, 2, 0), acc[q >> 2][bj][q & 3][0][3] * EG2_G(wb.x, 3, 0));
                w[2] = cvt_pk_bf16(acc[q >> 2][bj][q & 3][1][0] * EG2_G(wb.y, 0, 1), acc[q >> 2][bj][q & 3][1][1] * EG2_G(wb.y, 1, 1));
                w[3] = cvt_pk_bf16(acc[q >> 2][bj][q & 3][1][2] * EG2_G(wb.y, 2, 1), acc[q >> 2][bj][q & 3][1][3] * EG2_G(wb.y, 3, 1));
#undef EG2_G
                *(u32x4*)(O + row * 1024 + col) = w; }
        }
    }
};
struct EpiResid {
    static constexpr bool PERM = true, AFTER_DRAIN = false, MID = false;
    float* out; const float* x;
    __device__ __forceinline__ void operator()(const f32x4 (&acc)[2][2][4][2], const Unit& u, int wr, int wc, int fr, int fq) const {
        const int row0 = u.pm * BM + wr * 64 + fr, col0 = u.pn * BM + wc * 32 + 8 * fq;
#pragma unroll
        for (int ai = 0; ai < 2; ++ai)
#pragma unroll
            for (int m = 0; m < 4; ++m) { const size_t row = (size_t)(row0 + ai * HALF + m * 16);
#pragma unroll
                for (int bj = 0; bj < 2; ++bj) { const size_t o = row * 1024 + col0 + bj * HALF;
                    *(f32x4*)(out + o) = *(const f32x4*)(x + o) + acc[ai][bj][m][0];
                    *(f32x4*)(out + o + 4) = *(const f32x4*)(x + o + 4) + acc[ai][bj][m][1]; } }
    }
};

template <class Epi, class Sched, bool ALIGN_EPI = false, bool SP2 = false>
__device__ __forceinline__ void gemm_phase(PG8_LAS unsigned char* lds, const Gemm g, const Sched& S, const Epi& E) {
    const int tid = opaque_tid(), wid = __builtin_amdgcn_readfirstlane(tid >> 6), lane = tid & 63, wr = wid >> 2, wc = wid & 3, fr = lane & 15, fq = lane >> 4;
    int K = g.K; asm volatile("" : "+s"(K));
    const int nt = K / BK;
    unsigned voffA[2], voffB[2];
#pragma unroll
    for (int i = 0; i < 2; ++i) { int R, C; stage_rc(tid * 16 + i * 8192, R, C); const int Rb = Epi::PERM ? ((R & ~31) + perm32(R & 31)) : R;
        voffA[i] = (unsigned)(R * g.lda + C) * 2u; voffB[i] = (unsigned)(Rb * g.ldb + C) * 2u; }
    const size_t kstep = (size_t)(BK * 2);
    const size_t hstepA = (size_t)HALF * g.lda * 2, hstepB = (size_t)HALF * g.ldb * 2;
    const size_t tstepA = 2 * hstepA, tstepB = 2 * hstepB;
    const unsigned ldsw = (unsigned)wid * 1024u;
    const int aoff = lds_byte(wr * 64 + fr, fq * 8), boff = lds_byte(wc * 32 + fr, fq * 8);
#define PG8_SA(b, h) (((b) * 2 + (h)) * HTB)
#define PG8_SB(b, h) ((4 + (b) * 2 + (h)) * HTB)
#define PG8_STAGE(bufoff, gbase, voff) do { _Pragma("unroll") for (int _i = 0; _i < 2; ++_i) \
        __builtin_amdgcn_global_load_lds((const unsigned*)((const char*)(gbase) + (voff)[_i]), (PG8_LAS unsigned*)(lds + (bufoff) + ldsw + _i * 8192), 16, 0, 0); } while (0)
#define PG8_LDA(dst, b, h) do { _Pragma("unroll") for (int m = 0; m < 4; ++m) _Pragma("unroll") for (int k = 0; k < 2; ++k) dst[m][k] = *(const PG8_LAS bf16x8*)(lds + PG8_SA(b, h) + aoff + m * 2048 + k * 1024); } while (0)
#define PG8_LDB(dst, b, h) do { _Pragma("unroll") for (int n = 0; n < 2; ++n) _Pragma("unroll") for (int k = 0; k < 2; ++k) dst[n][k] = *(const PG8_LAS bf16x8*)(lds + PG8_SB(b, h) + boff + n * 2048 + k * 1024); } while (0)
#define PG8_MMA(ai, bj, At, Bt) do { __builtin_amdgcn_s_setprio(1); _Pragma("unroll") for (int m = 0; m < 4; ++m) _Pragma("unroll") for (int n = 0; n < 2; ++n) _Pragma("unroll") for (int k = 0; k < 2; ++k) \
        acc[ai][bj][m][n] = __builtin_amdgcn_mfma_f32_16x16x32_bf16(Bt[n][k], At[m][k], acc[ai][bj][m][n], 0, 0, 0); __builtin_amdgcn_s_setprio(0); } while (0)
#define PG8_WAIT_V(n) asm volatile("s_waitcnt vmcnt(" #n ")" ::: "memory")
#define PG8_WAIT_L(n) asm volatile("s_waitcnt lgkmcnt(" #n ")" ::: "memory")
#define PG8_BAR __builtin_amdgcn_s_barrier()
#define PG8_SCHED __builtin_amdgcn_sched_barrier(0)
    Unit cur, nxt; int ui = 0;
    if (!S.next(0, cur)) return;
    f32x4 acc[2][2][4][2];
#pragma unroll
    for (int a = 0; a < 2; ++a)
#pragma unroll
        for (int b = 0; b < 2; ++b)
#pragma unroll
            for (int m = 0; m < 4; ++m)
#pragma unroll
                for (int n = 0; n < 2; ++n) acc[a][b][m][n] = (f32x4){0.f, 0.f, 0.f, 0.f};
    bf16x8 At[4][2], B0[2][2], B1[2][2];
    const char* cA = (const char*)g.A + (size_t)cur.pm * tstepA; const char* cB = (const char*)g.Bt + (size_t)cur.pn * tstepB;
    S.a_ready(cur);
    if constexpr (SP2) {
        PG8_STAGE(PG8_SB(0, 0), cB, voffB); PG8_STAGE(PG8_SB(0, 1), cB + hstepB, voffB); PG8_STAGE(PG8_SA(0, 0), cA, voffA); PG8_STAGE(PG8_SA(0, 1), cA + hstepA, voffA);
        if (wr == 1) PG8_BAR;
        PG8_WAIT_V(2); PG8_BAR;
        PG8_STAGE(PG8_SB(1, 0), cB + kstep, voffB); PG8_STAGE(PG8_SA(1, 0), cA + kstep, voffA); PG8_STAGE(PG8_SB(1, 1), cB + hstepB + kstep, voffB);
        PG8_WAIT_V(6); PG8_BAR;
    } else {
        PG8_STAGE(PG8_SB(0, 0), cB, voffB); PG8_STAGE(PG8_SA(0, 0), cA, voffA); PG8_STAGE(PG8_SB(0, 1), cB + hstepB, voffB); PG8_STAGE(PG8_SA(0, 1), cA + hstepA, voffA);
        if (wr == 1) PG8_BAR;
        PG8_WAIT_V(4); PG8_BAR;
        PG8_STAGE(PG8_SB(1, 0), cB + kstep, voffB); PG8_STAGE(PG8_SA(1, 0), cA + kstep, voffA); PG8_STAGE(PG8_SB(1, 1), cB + hstepB + kstep, voffB);
        PG8_WAIT_V(6); PG8_BAR;
    }
    for (;;) {
        const bool has_next = S.next(ui + 1, nxt);
        const char* nA = has_next ? (const char*)g.A + (size_t)nxt.pm * tstepA : cA; const char* nB = has_next ? (const char*)g.Bt + (size_t)nxt.pn * tstepB : cB;
        for (int t = 0; t < nt; t += 2) {
            if constexpr (Epi::MID) { if (t == (nt >> 1)) E.mid(acc, cur, wr, wc, fr, fq); }
            const bool last = (t == nt - 2);
            const char* a1 = cA + (size_t)(t + 1) * kstep;
            const char* a2 = last ? nA : cA + (size_t)(t + 2) * kstep; const char* b2 = last ? nB : cB + (size_t)(t + 2) * kstep;
            const char* a3 = a2 + kstep; const char* b3 = b2 + kstep;
            if (last && has_next) S.a_ready(nxt);
            if constexpr (SP2) {
            PG8_LDB(B0, 0, 0); PG8_LDB(B1, 0, 1); PG8_SCHED; PG8_LDA(At, 0, 0); PG8_STAGE(PG8_SA(1, 1), a1 + hstepA, voffA);
            PG8_WAIT_V(8); PG8_WAIT_L(0); PG8_BAR; PG8_MMA(0, 0, At, B0); PG8_MMA(0, 1, At, B1); PG8_BAR; PG8_SCHED;
            PG8_LDA(At, 0, 1); PG8_STAGE(PG8_SB(0, 0), b2, voffB); PG8_STAGE(PG8_SB(0, 1), b2 + hstepB, voffB); PG8_STAGE(PG8_SA(0, 0), a2, voffA);
            PG8_WAIT_V(8); PG8_WAIT_L(0); PG8_BAR; PG8_MMA(1, 0, At, B0); PG8_MMA(1, 1, At, B1); PG8_BAR; PG8_SCHED;
            PG8_LDB(B0, 1, 0); PG8_LDB(B1, 1, 1); PG8_SCHED; PG8_LDA(At, 1, 0); PG8_STAGE(PG8_SA(0, 1), a2 + hstepA, voffA);
            PG8_WAIT_V(8); PG8_WAIT_L(0); PG8_BAR; PG8_MMA(0, 0, At, B0); PG8_MMA(0, 1, At, B1); PG8_BAR; PG8_SCHED;
            PG8_LDA(At, 1, 1); PG8_STAGE(PG8_SB(1, 0), b3, voffB); PG8_STAGE(PG8_SB(1, 1), b3 + hstepB, voffB); PG8_STAGE(PG8_SA(1, 0), a3, voffA);
            PG8_WAIT_V(8); PG8_WAIT_L(0); PG8_BAR; PG8_MMA(1, 0, At, B0); PG8_MMA(1, 1, At, B1); PG8_BAR; PG8_SCHED;
            } else {
            PG8_LDB(B0, 0, 0); PG8_SCHED; PG8_LDA(At, 0, 0); PG8_STAGE(PG8_SA(1, 1), a1 + hstepA, voffA);
            PG8_WAIT_L(8); PG8_BAR; PG8_WAIT_L(0); PG8_MMA(0, 0, At, B0); PG8_BAR; PG8_SCHED;
            PG8_LDB(B1, 0, 1); PG8_STAGE(PG8_SB(0, 0), b2, voffB);
            PG8_BAR; PG8_WAIT_L(0); PG8_MMA(0, 1, At, B1); PG8_BAR;
            PG8_LDA(At, 0, 1); PG8_STAGE(PG8_SA(0, 0), a2, voffA);
            PG8_BAR; PG8_WAIT_L(0); PG8_MMA(1, 0, At, B0); PG8_BAR; PG8_SCHED;
            PG8_STAGE(PG8_SB(0, 1), b2 + hstepB, voffB);
            PG8_WAIT_V(6); PG8_BAR; PG8_MMA(1, 1, At, B1); PG8_BAR;
            PG8_LDB(B0, 1, 0); PG8_SCHED; PG8_LDA(At, 1, 0); PG8_STAGE(PG8_SA(0, 1), a2 + hstepA, voffA);
            PG8_WAIT_L(8); PG8_BAR; PG8_WAIT_L(0); PG8_MMA(0, 0, At, B0); PG8_BAR; PG8_SCHED;
            PG8_LDB(B1, 1, 1); PG8_STAGE(PG8_SB(1, 0), b3, voffB);
            PG8_BAR; PG8_WAIT_L(0); PG8_MMA(0, 1, At, B1); PG8_BAR;
            PG8_LDA(At, 1, 1); PG8_STAGE(PG8_SA(1, 0), a3, voffA);
            PG8_BAR; PG8_WAIT_L(0); PG8_MMA(1, 0, At, B0); PG8_BAR; PG8_SCHED;
            PG8_STAGE(PG8_SB(1, 1), b3 + hstepB, voffB);
            PG8_WAIT_V(6); PG8_BAR; PG8_MMA(1, 1, At, B1); PG8_BAR;
            }
        }
        if constexpr (ALIGN_EPI) { if (wr == 0) PG8_BAR; }
        if constexpr (!Epi::AFTER_DRAIN) { E(acc, cur, wr, wc, fr, fq); S.done(cur); }
        if (!has_next) break;
#pragma unroll
        for (int a = 0; a < 2; ++a)
#pragma unroll
            for (int b = 0; b < 2; ++b)
#pragma unroll
                for (int m = 0; m < 4; ++m)
#pragma unroll
                    for (int n = 0; n < 2; ++n) acc[a][b][m][n] = (f32x4){0.f, 0.f, 0.f, 0.f};
        cur = nxt; cA = nA; cB = nB; ++ui;
        if constexpr (ALIGN_EPI) { if (wr == 1) PG8_BAR; }
    }
    PG8_WAIT_V(0);
    if constexpr (!ALIGN_EPI) { if (wr == 0) PG8_BAR; }
    PG8_BAR;
    if constexpr (Epi::AFTER_DRAIN) { E.fused(acc, cur, wr, wc, fr, fq, lds, wid, lane); S.done(cur); }
#undef PG8_SA
#undef PG8_SB
#undef PG8_STAGE
#undef PG8_LDA
#undef PG8_LDB
#undef PG8_MMA
#undef PG8_WAIT_V
#undef PG8_WAIT_L
#undef PG8_BAR
#undef PG8_SCHED
}
}

namespace att {
typedef short bf16x8 __attribute__((ext_vector_type(8)));
typedef short s16x4 __attribute__((ext_vector_type(4)));
typedef float f32x16 __attribute__((ext_vector_type(16)));
typedef unsigned u32x4 __attribute__((ext_vector_type(4)));
typedef float f32x2_t __attribute__((ext_vector_type(2))); typedef __bf16 bf16x2_t __attribute__((ext_vector_type(2)));
typedef __attribute__((address_space(3))) const char* lds_cptr;
typedef short v4i16_t __attribute__((ext_vector_type(4)));
#define ASBAR() __builtin_amdgcn_sched_barrier(0)
#define APIN(x) asm volatile("" : "+v"(x))
#define AMFMA(a, b, c) __builtin_amdgcn_mfma_f32_32x32x16_bf16(a, b, c, 0, 0, 0)
#define AWAIT_BAR(N) asm volatile("s_waitcnt vmcnt(" #N ") lgkmcnt(0)\n\ts_barrier" ::: "memory")
#define AMX3(a, b, c) __builtin_fmaxf(__builtin_fmaxf((a), (b)), (c))
__device__ __forceinline__ int crow(int r, int hi) { return (r & 3) + 8 * (r >> 2) + 4 * hi; }
__device__ __forceinline__ void glds16(const void* gsrc, unsigned lds_dst) { unsigned keep;
    asm volatile("s_mov_b32 %0, m0\n\ts_mov_b32 m0, %2\n\ts_nop 0\n\tglobal_load_lds_dwordx4 %1, off\n\ts_mov_b32 m0, %0" : "=&s"(keep) : "v"(gsrc), "s"(lds_dst) : "memory"); }
__device__ __forceinline__ unsigned cvtpk_s(float lo, float hi) { f32x2_t v = {lo, hi}; bf16x2_t b = __builtin_convertvector(v, bf16x2_t); return __builtin_bit_cast(unsigned, b); }
__device__ __forceinline__ void kload2(bf16x8* kf, lds_cptr kp, int j) { kf[2 * j] = *(const __attribute__((address_space(3))) bf16x8*)(kp + j * 2048); kf[2 * j + 1] = *(const __attribute__((address_space(3))) bf16x8*)(kp + j * 2048 + 512); }
__device__ __forceinline__ bf16x8 kfrag(lds_cptr kp, int f) { return *(const __attribute__((address_space(3))) bf16x8*)(kp + (f >> 1) * 2048 + (f & 1) * 512); }
__device__ __forceinline__ s16x4 vtr(lds_cptr p) { return __builtin_bit_cast(s16x4, __builtin_amdgcn_ds_read_tr16_b64_v4i16((__attribute__((address_space(3))) v4i16_t*)p)); }
__device__ __forceinline__ void wait_bar_n(int n) {
    if (n <= 0) AWAIT_BAR(0); else if (n == 1) AWAIT_BAR(1); else if (n == 2) AWAIT_BAR(2); else if (n == 3) AWAIT_BAR(3); else if (n == 4) AWAIT_BAR(4); else AWAIT_BAR(5);
}
__device__ __forceinline__ void cmask(f32x16& p0, f32x16& p1, int jb, int qrel, int hi) {
    const int kb = 64 * jb + 4 * hi;
#pragma unroll
    for (int r = 0; r < 16; ++r) { const int kv = kb + (r & 3) + 8 * (r >> 2); if (kv > qrel) p0[r] = -INFINITY; if (kv + 32 > qrel) p1[r] = -INFINITY; } }
__device__ __forceinline__ float silu_f(float g) { return g * __builtin_amdgcn_rcpf(1.f + __expf(-g)); }

template <int DQK> struct Geo {
    static constexpr int ND0 = DQK / 16, NKF = 2 * ND0, KSLOT = (DQK / 8) * 1024, VSLOT = 8192;
    static constexpr int LDS_K = 0, LDS_V = 4 * KSLOT, LDS_WS = LDS_V + 3 * VSLOT, LDS_OST = LDS_WS + 2048, LDS_BYTES = LDS_OST + 8 * 4096;
};
typedef const __attribute__((address_space(4))) u64* cu64p;
#define exp2_msel2(A, B, MA, MB) do { float a_ = (A), b_ = (B); \
    asm("v_exp_f32 %0, %0\n\tv_exp_f32 %1, %1\n\tv_cndmask_b32 %0, 0, %0, %2\n\tv_cndmask_b32 %1, 0, %1, %3" : "+v"(a_), "+v"(b_) : "s"(MA), "s"(MB)); (A) = a_; (B) = b_; } while (0)
template <int DQK, int PQ, int PK, int PV, int PO, int PG, int MODE, bool TRK, class NextQ>
__device__ __forceinline__ void attn_unit(const int qb, const bf16_t* Qb, const bf16_t* Kb, const bf16_t* Vb, bf16_t* Ob, const bf16_t* Gb, char* shm, const u64* Mb, const float* rope_b, const float* qgain,
                                          bf16x8 (&qpre)[6], const bool use_pre, NextQ& nq) {
    typedef Geo<DQK> G;
    constexpr int ND0 = G::ND0, KSLOT = G::KSLOT, VSLOT = G::VSLOT, LDS_K = G::LDS_K, LDS_V = G::LDS_V, LDS_WS = G::LDS_WS, LDS_OST = G::LDS_OST;
    constexpr float THRL = 8.f;
    int tid = threadIdx.x; asm volatile("" : "+v"(tid));
    const int lane = tid & 63, r32 = lane & 31, hi = lane >> 5; const int wid = __builtin_amdgcn_readfirstlane(tid >> 6);
    const int q0 = qb * 256, NT = (q0 + 256) / 64;
    const bf16_t* Qw = Qb + (long)(q0 + wid * 32) * PQ;
    const unsigned lds0 = (unsigned)(uintptr_t)shm;
    float* wsf = (float*)(shm + LDS_WS) + wid * 64;
    const int nkp = (DQK == 96 && wid < 4) ? 2 : 1;
    constexpr long KT = (MODE == 0) ? 6144 : 64l * PK, K2 = (MODE == 0) ? 4096 : 64;
    const bf16_t* ksrc = (MODE == 0) ? Kb + wid * 512 + lane * 8 : Kb + (long)lane * PK + wid * 8;
    const bf16_t* vsrc = Vb + (long)(16 * (wid & 3) + (lane >> 2)) * PV + (wid >> 2) * 32 + (lane & 3) * 8;
    const unsigned kdst = lds0 + LDS_K + wid * 1024, vdst = lds0 + LDS_V + wid * 1024;
#define DMA_K(t, sl) do { glds16(ksrc + (long)(t) * KT, (unsigned)__builtin_amdgcn_readfirstlane(kdst + (sl) * KSLOT)); \
        if (nkp == 2) glds16(ksrc + (long)(t) * KT + K2, (unsigned)__builtin_amdgcn_readfirstlane(kdst + (sl) * KSLOT + 8192)); } while (0)
#define DMA_V(t, sl) glds16(vsrc + (long)(t) * 64 * PV, (unsigned)__builtin_amdgcn_readfirstlane(vdst + (sl) * VSLOT))
    const lds_cptr shm3 = (lds_cptr)shm;
    const lds_cptr kp0 = shm3 + LDS_K + hi * 1024 + r32 * 16;
    const lds_cptr vp0 = shm3 + LDS_V + ((lane >> 4) & 1) * 32 + (lane & 3) * 8 + (4 * hi + ((lane & 15) >> 2)) * 64;
    DMA_K(0, 0); DMA_V(0, 0); DMA_K(1, 1);
    bf16x8 qr[ND0]; constexpr bool chk = TRK;
#pragma unroll
    for (int d0 = 0; d0 < ND0; ++d0) qr[d0] = use_pre ? qpre[d0] : *reinterpret_cast<const bf16x8*>(&Qw[(long)r32 * PQ + d0 * 16 + hi * 8]);
    {
        float v[ND0][8]; float ss = 0.f;
#pragma unroll
        for (int d0 = 0; d0 < ND0; ++d0)
#pragma unroll
            for (int e = 0; e < 8; ++e) { v[d0][e] = __uint_as_float(((unsigned)(unsigned short)qr[d0][e]) << 16); ss = __builtin_fmaf(v[d0][e], v[d0][e], ss); }
        ss += __shfl_xor(ss, 32);
        const float rn = rsqrtf(ss * (1.f / DQK) + 1e-6f);
        constexpr float QS = (DQK == 96) ? 0.14724445f : 0.18033688f;
#pragma unroll
        for (int d0 = 0; d0 < ND0; ++d0)
#pragma unroll
            for (int e = 0; e < 8; ++e) v[d0][e] = v[d0][e] * rn * qgain[16 * d0 + 8 * hi + e] * QS;
        const float* cs = rope_b + (size_t)(q0 + wid * 32 + r32) * 56;
        if (DQK == 96) {
            float4 c4[4];
#pragma unroll
            for (int i = 0; i < 4; ++i) c4[i] = *(const float4*)(cs + hi * 16 + 4 * i);
            const float cc[8] = {c4[0].x, c4[0].z, c4[1].x, c4[1].z, c4[2].x, c4[2].z, c4[3].x, c4[3].z}, sn[8] = {c4[0].y, c4[0].w, c4[1].y, c4[1].w, c4[2].y, c4[2].w, c4[3].y, c4[3].w};
#pragma unroll
            for (int e = 0; e < 8; ++e) { const float a = v[ND0 - 2][e], bb = v[ND0 - 1][e]; v[ND0 - 2][e] = a * cc[e] - bb * sn[e]; v[ND0 - 1][e] = bb * cc[e] + a * sn[e]; }
        } else {
            float4 c4[4];
#pragma unroll
            for (int i = 0; i < 4; ++i) c4[i] = *(const float4*)(cs + 32 + 4 * i);
            const float cc[8] = {c4[0].x, c4[0].z, c4[1].x, c4[1].z, c4[2].x, c4[2].z, c4[3].x, c4[3].z}, sn[8] = {c4[0].y, c4[0].w, c4[1].y, c4[1].w, c4[2].y, c4[2].w, c4[3].y, c4[3].w};
#pragma unroll
            for (int e = 0; e < 8; ++e) { const float pr = __shfl_xor(v[0][e], 32); v[0][e] = hi == 0 ? v[0][e] * cc[e] - pr * sn[e] : v[0][e] * cc[e] + pr * sn[e]; }
        }
#pragma unroll
        for (int d0 = 0; d0 < ND0; ++d0)
#pragma unroll
            for (int e = 0; e < 8; e += 2) { const unsigned pk = cvtpk_s(v[d0][e], v[d0][e + 1]); qr[d0][e] = (short)(pk & 0xffffu); qr[d0][e + 1] = (short)(pk >> 16); }
    }
    float mhat = 0.f, l_reg = 0.f; f32x16 o[2], negm;
    { float z = 0.f; asm volatile("" : "+v"(z));
#pragma unroll
      for (int r = 0; r < 16; ++r) { o[0][r] = z; o[1][r] = z; negm[r] = z; } asm volatile("" : "+v"(negm)); }
    const int qrel = wid * 32 + r32; bool resc = false; float rescf = 1.f;
    const cu64p mwave = (cu64p)(uintptr_t)(Mb + (size_t)(qb * 8 + wid) * 16);
#define MLOAD(m0, m1, t) do { if (MODE == 1) { const cu64p mp_ = mwave + (size_t)(2 * (t)) * 2048; \
        _Pragma("unroll") for (int r = 0; r < 16; ++r) { m0[r] = mp_[r]; m1[r] = mp_[2048 + r]; } } } while (0)
    f32x16 pA0, pA1, pB0, pB1; bf16x8 kf[2 * ND0]; s16x4 vlo[8], vhi[8]; u32x4 pw[4];
    int sl_prev = 0, sl_cur = 0, sl_next = 1;
#define ROT() do { sl_prev = sl_cur; sl_cur = sl_next; sl_next = (sl_next == 2) ? 0 : sl_next + 1; } while (0)
#define RESC() do { if (resc) { \
        _Pragma("unroll") for (int d_ = 0; d_ < 2; ++d_) _Pragma("unroll") for (int r = 0; r < 16; ++r) o[d_][r] *= rescf; } } while (0)
#define CMASKT(C0, C1, t) do { if (MODE == 0) { const int jb_ = (t) - (NT - 4); if (jb_ >= 0) cmask(C0, C1, jb_, qrel, hi); } } while (0)
#define DECIDE(C0, C1) do { resc = false; if (!chk && MODE == 1) asm volatile("s_nop 15\n\ts_nop 3" : "+v"(C0), "+v"(C1));     \
        if (chk) { float a_ = AMX3(C0[0], C0[1], C1[0]), b_ = AMX3(C0[2], C0[3], C1[1]); a_ = AMX3(a_, C1[2], C1[3]); \
        _Pragma("unroll") for (int r = 4; r < 16; r += 4) { a_ = AMX3(a_, C0[r], C0[r + 1]); b_ = AMX3(b_, C0[r + 2], C0[r + 3]); a_ = AMX3(a_, C1[r], C1[r + 1]); b_ = AMX3(b_, C1[r + 2], C1[r + 3]); } \
        float rm_ = __builtin_fmaxf(a_, b_); { auto rr_ = __builtin_amdgcn_permlane32_swap(__float_as_uint(rm_), __float_as_uint(rm_), false, false); rm_ = __builtin_fmaxf(__uint_as_float(rr_[0]), __uint_as_float(rr_[1])); } \
        resc = false; \
        if (__builtin_expect(__any(rm_ > THRL), 0)) { const float dl_ = __builtin_fmaxf(rm_, 0.f); mhat += dl_; \
            _Pragma("unroll") for (int r = 0; r < 16; ++r) { C0[r] -= dl_; C1[r] -= dl_; } \
            _Pragma("unroll") for (int r = 0; r < 16; ++r) negm[r] = -mhat; asm volatile("" : "+v"(negm)); \
            const float f_ = __builtin_amdgcn_exp2f(-dl_); l_reg *= f_; rescf = f_; resc = true; } } } while (0)
    DMA_K(2, 2);
    wait_bar_n(1 + 2 * nkp);
    {
        const lds_cptr kb = kp0;
#pragma unroll
        for (int d0 = 0; d0 < ND0; ++d0) {
            const bf16x8 b0 = *(const __attribute__((address_space(3))) bf16x8*)(kb + d0 * 2048);
            const bf16x8 b1 = *(const __attribute__((address_space(3))) bf16x8*)(kb + d0 * 2048 + 512);
            if (d0 == 0) { pA0 = AMFMA(b0, qr[0], negm); pA1 = AMFMA(b1, qr[0], negm); }
            else { pA0 = AMFMA(b0, qr[d0], pA0); pA1 = AMFMA(b1, qr[d0], pA1); }
        }
    }
    CMASKT(pA0, pA1, 0);
    DECIDE(pA0, pA1);
    if (MODE == 1) { u64 m0[16], m1[16]; MLOAD(m0, m1, 0);
#pragma unroll
        for (int r = 0; r < 16; r += 2) { exp2_msel2(pA0[r], pA0[r + 1], m0[r], m0[r + 1]); exp2_msel2(pA1[r], pA1[r + 1], m1[r], m1[r + 1]); } }
    else {
#pragma unroll
        for (int r = 0; r < 16; ++r) { pA0[r] = __builtin_amdgcn_exp2f(pA0[r]); pA1[r] = __builtin_amdgcn_exp2f(pA1[r]); } }
    wait_bar_n(0);
    RESC();
    DMA_K(3, 3); DMA_V(1, 1);
    ROT();
#pragma unroll
    for (int f = 0; f < 4; ++f) kf[f] = kfrag(kp0 + 1 * KSLOT, f);
#define PELM(P0, P1, i) (((i) < 16) ? P0[(i) & 15] : P1[(i) & 15])
#define VFR(i) (bf16x8){vlo[i][0], vlo[i][1], vlo[i][2], vlo[i][3], vhi[i][0], vhi[i][1], vhi[i][2], vhi[i][3]}
#define VRD(i) do { vlo[i] = vtr(vp_ + (((i) >> 2) * 4096 + ((i) & 3) * 1024)); vhi[i] = vtr(vp_ + (((i) >> 2) * 4096 + ((i) & 3) * 1024 + 512)); } while (0)
#define STEP(C0, C1, P0, P1, t, GK, GV, GL) do { ASBAR(); \
        const lds_cptr vp_ = vp0 + sl_prev * VSLOT; const lds_cptr kpc_ = kp0 + ((t) & 3) * KSLOT; const lds_cptr kpn_ = kp0 + (((t) + 1) & 3) * KSLOT; \
        float sacc = P0[0] + P0[1]; u64 m0_[16], m1_[16]; MLOAD(m0_, m1_, t); \
        _Pragma("unroll") for (int g = 0; g < 2 * ND0; ++g) { \
            if (g < 8) { VRD(((g) >> 1) + 4 * ((g) & 1)); } \
            if (g + 4 < 2 * ND0) { kf[g + 4] = kfrag(kpc_, g + 4); } \
            ASBAR(); \
            if ((g & 1) == 0) { C0 = AMFMA(kf[g], qr[g >> 1], (g < 2) ? negm : C0); } else { C1 = AMFMA(kf[g], qr[g >> 1], (g < 2) ? negm : C1); } \
            if (g < 8) { sacc += PELM(P0, P1, 4 * g + 2); sacc += PELM(P0, P1, 4 * g + 3); if (g < 7) { sacc += PELM(P0, P1, 4 * g + 4); sacc += PELM(P0, P1, 4 * g + 5); } APIN(sacc); \
                pw[g >> 1][2 * (g & 1)] = cvtpk_s(PELM(P0, P1, 4 * g), PELM(P0, P1, 4 * g + 1)); pw[g >> 1][2 * (g & 1) + 1] = cvtpk_s(PELM(P0, P1, 4 * g + 2), PELM(P0, P1, 4 * g + 3)); APIN(pw[g >> 1]); } \
            ASBAR(); } \
        l_reg += sacc; \
        if (GK) { DMA_K((t) + 3, ((t) + 3) & 3); } if (GV) { DMA_V((t) + 1, sl_next); } \
        CMASKT(C0, C1, t); \
        DECIDE(C0, C1); \
        ASBAR(); \
        _Pragma("unroll") for (int i = 0; i < 8; ++i) { \
            if ((GL) && i >= 4) { kf[i - 4] = kfrag(kpn_, i - 4); ASBAR(); } \
            o[i & 1] = AMFMA(VFR((i >> 1) + 4 * (i & 1)), __builtin_bit_cast(bf16x8, pw[i >> 1]), o[i & 1]); \
            if (MODE == 1) { if (i < 4) { exp2_msel2(C0[4 * i], C0[4 * i + 1], m0_[4 * i], m0_[4 * i + 1]); exp2_msel2(C0[4 * i + 2], C0[4 * i + 3], m0_[4 * i + 2], m0_[4 * i + 3]); APIN(C0); } \
                             else { exp2_msel2(C1[4 * i - 16], C1[4 * i - 15], m1_[4 * i - 16], m1_[4 * i - 15]); exp2_msel2(C1[4 * i - 14], C1[4 * i - 13], m1_[4 * i - 14], m1_[4 * i - 13]); APIN(C1); } } \
            else if (i < 4) { _Pragma("unroll") for (int e = 0; e < 4; ++e) { C0[4 * i + e] = __builtin_amdgcn_exp2f(C0[4 * i + e]); } APIN(C0); } \
            else { _Pragma("unroll") for (int e = 0; e < 4; ++e) { C1[4 * i - 16 + e] = __builtin_amdgcn_exp2f(C1[4 * i - 16 + e]); } APIN(C1); } \
            ASBAR(); } \
    } while (0)
#define ENDW(tt) do { if ((tt) + 3 < NT) wait_bar_n(nkp + 1); else if ((tt) + 2 < NT) wait_bar_n(1); else wait_bar_n(0); } while (0)
    int t = 1;
    for (; t + 5 < NT; t += 2) {
        STEP(pB0, pB1, pA0, pA1, t, true, true, true);     wait_bar_n(nkp + 1); RESC(); ROT();
        STEP(pA0, pA1, pB0, pB1, t + 1, true, true, true); wait_bar_n(nkp + 1); RESC(); ROT();
    }
    for (; t + 1 < NT; t += 2) {
        STEP(pB0, pB1, pA0, pA1, t, (t + 3 < NT), (t + 1 < NT), (t + 1 < NT));       ENDW(t);     RESC(); ROT();
        STEP(pA0, pA1, pB0, pB1, t + 1, (t + 4 < NT), (t + 2 < NT), (t + 2 < NT));   ENDW(t + 1); RESC(); ROT();
    }
    u32x4 gq[4];
    { const bf16_t* Gw_ = Gb + (long)(q0 + wid * 32) * PG;
#pragma unroll
      for (int i = 0; i < 4; ++i) gq[i] = *(const u32x4*)(Gw_ + (long)r32 * PG + i * 16 + hi * 8); }
    nq.issue();
    STEP(pB0, pB1, pA0, pA1, NT - 1, false, false, false); RESC();
    const bf16_t* qnext; int pqn, nd0n; nq.draw(qnext, pqn, nd0n);
    if (qnext) { const bf16_t* qn_ = qnext + (long)(wid * 32 + r32) * pqn + hi * 8;
#pragma unroll
        for (int d0 = 0; d0 < 6; ++d0) if (d0 < nd0n) qpre[d0] = *reinterpret_cast<const bf16x8*>(qn_ + d0 * 16); }
    {
        float sacc = pB0[0] + pB0[1];
#pragma unroll
        for (int r = 2; r < 16; ++r) sacc += pB0[r];
#pragma unroll
        for (int r = 0; r < 16; ++r) sacc += pB1[r];
        l_reg += sacc;
#pragma unroll
        for (int g = 0; g < 8; ++g) { pw[g >> 1][2 * (g & 1)] = cvtpk_s(PELM(pB0, pB1, 4 * g), PELM(pB0, pB1, 4 * g + 1)); pw[g >> 1][2 * (g & 1) + 1] = cvtpk_s(PELM(pB0, pB1, 4 * g + 2), PELM(pB0, pB1, 4 * g + 3)); }
        const lds_cptr vp_ = vp0 + sl_cur * VSLOT;
#pragma unroll
        for (int i = 0; i < 8; ++i) VRD(i);
#pragma unroll
        for (int i = 0; i < 8; ++i) o[i & 1] = AMFMA(VFR((i >> 1) + 4 * (i & 1)), __builtin_bit_cast(bf16x8, pw[i >> 1]), o[i & 1]);
    }
    { auto rr = __builtin_amdgcn_permlane32_swap(__float_as_uint(l_reg), __float_as_uint(l_reg), false, false); l_reg = __uint_as_float(rr[0]) + __uint_as_float(rr[1]); }
    {
        const float rl = __builtin_amdgcn_rcpf(l_reg);
        bf16_t* Ow = Ob + (long)(q0 + wid * 32 + r32) * PO + hi * 8;
#pragma unroll
        for (int d0 = 0; d0 < 2; ++d0)
#pragma unroll
            for (int kp = 0; kp < 2; ++kp) {
                unsigned ax = cvtpk_s(o[d0][8 * kp + 0] * rl, o[d0][8 * kp + 1] * rl), ay = cvtpk_s(o[d0][8 * kp + 2] * rl, o[d0][8 * kp + 3] * rl);
                unsigned bx = cvtpk_s(o[d0][8 * kp + 4] * rl, o[d0][8 * kp + 5] * rl), by = cvtpk_s(o[d0][8 * kp + 6] * rl, o[d0][8 * kp + 7] * rl);
                { auto r_ = __builtin_amdgcn_permlane32_swap(ax, bx, false, false); ax = r_[0]; bx = r_[1]; }
                { auto r_ = __builtin_amdgcn_permlane32_swap(ay, by, false, false); ay = r_[0]; by = r_[1]; }
                const u32x4 v = {ax, ay, bx, by}; const u32x4 g = gq[d0 * 2 + kp]; u32x4 w;
#pragma unroll
                for (int e = 0; e < 4; ++e) { const float lo = __uint_as_float(v[e] << 16) * silu_f(__uint_as_float(g[e] << 16)), hh = __uint_as_float(v[e] & 0xffff0000u) * silu_f(__uint_as_float(g[e] & 0xffff0000u)); w[e] = cvtpk_s(lo, hh); }
                *(u32x4*)(Ow + d0 * 32 + kp * 16) = w;
            }
    }
    asm volatile("s_waitcnt lgkmcnt(0)\n\ts_barrier" ::: "memory");
#undef MLOAD
#undef DMA_K
#undef DMA_V
#undef ROT
#undef RESC
#undef CMASKT
#undef DECIDE
#undef PELM
#undef VFR
#undef VRD
#undef STEP
#undef ENDW
}
}

namespace sel {
typedef short bf16x8 __attribute__((ext_vector_type(8)));
typedef float f32x16 __attribute__((ext_vector_type(16)));
constexpr int CAP = 64;
constexpr int L_HIST = 0, L_CS = 65536, L_CI = 73728, L_MASK = 81920, L_STAT = 98304, L_SEG = 100352, L_B = 102400, L_QUOTA = 102528, L_ABOVE = 102656, L_TLO = 102784, L_THI = 102912,
              L_CC = 103040, L_FAIL = 103168  , L_QI = 103424  , L_W = 104448  , L_BYTES = 104480;
__device__ __forceinline__ int crow(int r, int hi) { return (r & 3) + 8 * (r >> 2) + 4 * hi; }
__device__ __forceinline__ void score_tile_k(f32x16& sc, const bf16x8 (&qf)[8][2], const float (&w)[8], const bf16x8 k0, const bf16x8 k1) {
#pragma unroll
    for (int r = 0; r < 16; ++r) sc[r] = 0.f;
#pragma unroll
    for (int hh = 0; hh < 8; hh += 4) {
        f32x16 x[4];
#pragma unroll
        for (int h = 0; h < 4; ++h) { x[h] = __builtin_amdgcn_mfma_f32_32x32x16_bf16(k0, qf[hh + h][0], (f32x16){}, 0, 0, 0); x[h] = __builtin_amdgcn_mfma_f32_32x32x16_bf16(k1, qf[hh + h][1], x[h], 0, 0, 0); }
#pragma unroll
        for (int h = 0; h < 4; ++h)
#pragma unroll
            for (int r = 0; r < 16; ++r) { const float xv = x[h][r]; const int xi = __float_as_int(xv); sc[r] = __builtin_fmaf(w[hh + h], __int_as_float(xi > 0 ? xi : 0), sc[r]); }
        __builtin_amdgcn_sched_barrier(0);
    }
}
__device__ __forceinline__ void score_tile(f32x16& sc, const bf16x8 (&qf)[8][2], const float (&w)[8], const bf16_t* kig, int r32, int hi) {
    const bf16x8 k0 = *(const bf16x8*)(kig + r32 * 32 + hi * 8), k1 = *(const bf16x8*)(kig + r32 * 32 + 16 + hi * 8);
    score_tile_k(sc, qf, w, k0, k1);
}
#define SEL_GLOOP_BEGIN() { const bf16_t* kp_ = kib + (size_t)wid * 1024 + r32 * 32 + hi * 8; bf16x8 kn0_ = *(const bf16x8*)kp_, kn1_ = *(const bf16x8*)(kp_ + 16); \
    for (int g = wid; g <= qblk; g += 8) { const bf16x8 kc0_ = kn0_, kc1_ = kn1_; kp_ += 8 * 1024; if (g + 8 <= qblk) { kn0_ = *(const bf16x8*)kp_; kn1_ = *(const bf16x8*)(kp_ + 16); } \
        score_tile_k(sc, qf, w, kc0_, kc1_);
#define SEL_GLOOP_END() } }
__device__ __forceinline__ int key18_of(float s, float iw, float c0) { const float f = __builtin_amdgcn_fmed3f(__builtin_fmaf(s, iw, c0), 0.f, 262143.f); return (int)f; }
__device__ __forceinline__ int bin10_of(float s, float iw1, float c1) { const float f = __builtin_amdgcn_fmed3f(__builtin_fmaf(s, iw1, c1), 0.f, 1023.99609375f); return (int)f; }
__device__ __forceinline__ void scan_top(const unsigned short* h16, int nseg, int* seg_s, const int* cum0_s, int* B_out, int* above_out, int* cnt_out, int* tmp, int tid) {
    const int q = tid & 31, j = tid >> 5;
    if (j < nseg) { int s = 0;
#pragma unroll 8
        for (int i = 0; i < 64; ++i) s += h16[((j * 64 + i) * 32) + q];
        seg_s[q * 16 + j] = s; }
    __syncthreads();
    if (j < nseg) {
        int above = cum0_s ? cum0_s[q] : 0;
#pragma unroll
        for (int i = 1; i < 16; ++i) above += (i > j && i < nseg) ? seg_s[q * 16 + i] : 0;
        const int own = seg_s[q * 16 + j];
        if (above < 256 && (j == 0 || above + own >= 256)) { tmp[q] = j; tmp[32 + q] = above; }
    }
    __syncthreads();
    const int sg = tmp[q], cum0 = tmp[32 + q];
    int cv[4];
#pragma unroll
    for (int i = 0; i < 4; ++i) cv[i] = h16[(sg * 64 + j * 4 + i) * 32 + q];
    const int part = cv[0] + cv[1] + cv[2] + cv[3];
    seg_s[q * 16 + j] = part;
    __syncthreads();
    {
        int above = cum0;
#pragma unroll
        for (int i = 1; i < 16; ++i) above += (i > j) ? seg_s[q * 16 + i] : 0;
        if (above < 256 && (j == 0 || above + part >= 256)) {
            int bb = -1, cb = 0; bool fb = false;
#pragma unroll
            for (int i = 3; i >= 0; --i) { const bool hit = !fb && (above + cv[i] >= 256); if (hit) { bb = sg * 64 + j * 4 + i; cb = cv[i]; fb = true; } if (!fb) above += cv[i]; }
            B_out[q] = bb; above_out[q] = above; cnt_out[q] = cb;
        }
    }
    __syncthreads();
}

__device__ __forceinline__ unsigned sel_unit(const int b, const int qblk, const bf16_t* proj, const bf16_t* ki, const float* wi, u64* M64, unsigned char* smem, unsigned* qctr, volatile __attribute__((address_space(3))) unsigned* slot) {
    unsigned* hist = (unsigned*)(smem + L_HIST); float* cs = (float*)(smem + L_CS); int* ci = (int*)(smem + L_CI); u64* mask = (u64*)(smem + L_MASK); unsigned* mask32 = (unsigned*)(smem + L_MASK);
    float* stat = (float*)(smem + L_STAT); int* seg_s = (int*)(smem + L_SEG); int* B_s = (int*)(smem + L_B); int* quota_s = (int*)(smem + L_QUOTA); int* above_s = (int*)(smem + L_ABOVE);
    int* tlo_s = (int*)(smem + L_TLO); int* thi_s = (int*)(smem + L_THI); unsigned* cc = (unsigned*)(smem + L_CC); int* flag_s = (int*)(smem + L_FAIL); int* failq = (int*)(smem + L_FAIL + 16);
    int* cnt_s = (int*)(smem + L_STAT);
    int tid = threadIdx.x; asm volatile("" : "+v"(tid));
    const int lane = tid & 63, r32 = lane & 31, hi = lane >> 5; const int wid = __builtin_amdgcn_readfirstlane(tid >> 6);
    const size_t trow = (size_t)b * SEQ + qblk * 32 + r32;
    const bf16_t* kib = ki + (size_t)b * SEQ * 32;
    const int gend = (qblk | 7) + 1;
    const bool topk = qblk >= 8;
    for (int i = tid; i < gend * 32; i += NTHREADS) mask32[i] = 0u;
    unsigned zz = 0u; asm volatile("" : "+v"(zz));
    if (topk) for (int i = tid; i < 4096; i += NTHREADS) ((uint4*)hist)[i] = make_uint4(zz, zz, zz, zz);
    if (tid < 32) { cc[tid] = 0u; failq[tid] = 0; }
    if (tid < 4) flag_s[tid] = 0;
    bf16x8 qf[8][2]; float w[8];
#pragma unroll
    for (int h = 0; h < 8; ++h) { qf[h][0] = *(const bf16x8*)(proj + trow * NP + C_QI + h * 32 + hi * 8); qf[h][1] = *(const bf16x8*)(proj + trow * NP + C_QI + h * 32 + 16 + hi * 8); w[h] = wi[trow * 8 + h]; }
    float iw = 0.f, c0 = 0.f; int Tlo = 0x7fffffff, Thi = -1;
    f32x16 sc;
    const unsigned hadd = (r32 & 1) ? 0x10000u : 1u; const unsigned hoff = (unsigned)(r32 >> 1) * 4u;
    if (topk) {
        score_tile(sc, qf, w, kib + (size_t)wid * 32 * 32, r32, hi);
        float s1 = 0.f, s2 = 0.f;
#pragma unroll
        for (int r = 0; r < 16; ++r) { s1 += sc[r]; s2 = __builtin_fmaf(sc[r], sc[r], s2); }
        s1 += __shfl_xor(s1, 32); s2 += __shfl_xor(s2, 32);
        if (hi == 0) { stat[(wid * 32 + r32) * 2] = s1; stat[(wid * 32 + r32) * 2 + 1] = s2; }
        __syncthreads();
        { float a1 = 0.f, a2 = 0.f;
#pragma unroll
          for (int ww = 0; ww < 8; ++ww) { a1 += stat[(ww * 32 + r32) * 2]; a2 += stat[(ww * 32 + r32) * 2 + 1]; }
          const float mu = a1 * (1.f / 256.f); float var = a2 * (1.f / 256.f) - mu * mu; var = __builtin_fmaxf(var, 0.f);
          const float sd = __builtin_sqrtf(var); const float lo = mu - 6.f * sd; iw = sd > 0.f ? 262144.f / (12.f * sd) : 0.f; c0 = -lo * iw; }
        const float iw1 = iw * (1.f / 256.f), c1 = c0 * (1.f / 256.f);
        SEL_GLOOP_BEGIN()
            if (g == qblk) {
#pragma unroll
                for (int r = 0; r < 16; ++r) { const int bin = bin10_of(sc[r], iw1, c1); if (crow(r, hi) <= r32) atomicAdd((unsigned*)((unsigned char*)hist + (bin << 6) + hoff), hadd); }
            } else {
#pragma unroll
                for (int r = 0; r < 16; ++r) { const int bin = bin10_of(sc[r], iw1, c1); atomicAdd((unsigned*)((unsigned char*)hist + (bin << 6) + hoff), hadd); }
            }
        SEL_GLOOP_END()
        __syncthreads();
        scan_top((const unsigned short*)hist, 16, seg_s, nullptr, B_s, above_s, cnt_s, (int*)(smem + L_STAT + 1024), tid);
        if (tid < 32) {
            const int Bf = B_s[tid];
            quota_s[tid] = 256 - above_s[tid]; tlo_s[tid] = Bf * 256; thi_s[tid] = Bf * 256 + 255;
            if (Bf <= 0 || Bf >= 1023) { failq[tid] = 1; flag_s[1] = 1; }
            else if (cnt_s[tid] > CAP) flag_s[0] = 1;
        }
        __syncthreads();
        if (flag_s[0] != 0) {
            const int Bq = B_s[r32];
            __syncthreads();
            for (int i = tid; i < 1024; i += NTHREADS) ((uint4*)hist)[i] = make_uint4(zz, zz, zz, zz);
            __syncthreads();
            SEL_GLOOP_BEGIN()
                const bool diag = (g == qblk);
#pragma unroll
                for (int r = 0; r < 16; ++r) {
                    const bool valid = !diag || (crow(r, hi) <= r32);
                    const int k18 = key18_of(sc[r], iw, c0); const int sub = k18 & 255;
                    if (valid && (k18 >> 8) == Bq) atomicAdd((unsigned*)((unsigned char*)hist + (sub << 6) + hoff), hadd);
                }
            SEL_GLOOP_END()
            __syncthreads();
            scan_top((const unsigned short*)hist, 4, seg_s, above_s, tlo_s  , quota_s  , cnt_s, (int*)(smem + L_STAT + 1024), tid);
            if (tid < 32 && failq[tid] == 0) {
                const int B2 = tlo_s[tid], ab = quota_s[tid];
                if (B2 < 0 || cnt_s[tid] > CAP) { failq[tid] = 1; flag_s[1] = 1; }
                quota_s[tid] = 256 - ab; tlo_s[tid] = B_s[tid] * 256 + B2; thi_s[tid] = B_s[tid] * 256 + B2;
            }
            __syncthreads();
        }
        Tlo = tlo_s[r32]; Thi = thi_s[r32];
        if (failq[r32] != 0) { Tlo = 0x7fffffff; Thi = 0x7fffffff; }
    } else { __syncthreads(); }
    const unsigned twid = (unsigned)(Thi - Tlo);
#define SEL_P2_BODY(VALID) do { \
        _Pragma("unroll") for (int r = 0; r < 16; ++r) { \
            const int k16 = topk ? key18_of(sc[r], iw, c0) : 0; \
            const u64 m = __ballot((VALID) && k16 > Thi); \
            if (lane == r) mine = m; \
            if ((VALID) && (unsigned)(k16 - Tlo) <= twid) { const unsigned slot = atomicAdd(&cc[r32], 1u); if (slot < (unsigned)CAP) { cs[r32 * CAP + slot] = sc[r]; ci[r32 * CAP + slot] = g * 32 + crow(r, hi); } } \
        } } while (0)
    SEL_GLOOP_BEGIN()
        u64 mine = 0ull;
        if (g == qblk) SEL_P2_BODY(crow(r, hi) <= r32); else SEL_P2_BODY(true);
        if (lane < 16) mask[g * 16 + lane] = mine;
    SEL_GLOOP_END()
#undef SEL_P2_BODY
    __syncthreads();
    if (topk) {
        for (int qq = 0; qq < 4; ++qq) {
            const int q = wid * 4 + qq; int c = __builtin_amdgcn_readfirstlane((int)cc[q]); c = c < CAP ? c : CAP; const int quo = quota_s[q];
            const float si = lane < c ? cs[q * CAP + lane] : 0.f; const int ii = lane < c ? ci[q * CAP + lane] : 0; int rank = 0;
            for (int j = 0; j < c; ++j) {
                const float sj = __int_as_float(__builtin_amdgcn_readlane(__float_as_int(si), j)); const int ij = __builtin_amdgcn_readlane(ii, j);
                rank += (sj > si || (sj == si && ij < ii)) ? 1 : 0; }
            if (lane < c && rank < quo) { const int g = ii >> 5, ko = ii & 31, r = (ko & 3) + 4 * (ko >> 3), hh = (ko >> 2) & 1; atomicOr(&mask32[(g * 16 + r) * 2 + hh], 1u << q); }
        }
        if (flag_s[1] != 0) {
            u64* keys = (u64*)smem; float* qi_s = (float*)(smem + L_QI); float* w_s = (float*)(smem + L_W);
            for (int qq = 0; qq < 32; ++qq) {
                if (failq[qq] == 0) continue;
                const size_t t = (size_t)b * SEQ + qblk * 32 + qq; const int n = qblk * 32 + qq + 1;
                __syncthreads();
                if (tid < 256) qi_s[tid] = bf2f(proj[t * NP + C_QI + tid]);
                if (tid < 8) w_s[tid] = wi[t * 8 + tid];
                __syncthreads();
                int Npad = 512; while (Npad < n) Npad <<= 1;
                for (int s = tid; s < Npad; s += NTHREADS) {
                    u64 key = 0;
                    if (s < n) {
                        const bf16_t* kr = kib + (size_t)s * 32; float kv[32];
#pragma unroll
                        for (int d = 0; d < 32; d += 8) { float f[8]; unpack8(*(const uint4*)(kr + d), f);
#pragma unroll
                            for (int i = 0; i < 8; ++i) kv[d + i] = f[i]; }
                        float scv = 0.f;
#pragma unroll
                        for (int h = 0; h < 8; ++h) { float d = 0.f;
#pragma unroll
                            for (int i = 0; i < 32; ++i) d = fmaf(qi_s[h * 32 + i], kv[i], d);
                            scv = fmaf(w_s[h], fmaxf(d, 0.f), scv); }
                        u32 ub = __float_as_uint(scv); ub = (ub & 0x80000000u) ? ~ub : (ub | 0x80000000u);
                        key = ((u64)ub << 32) | (u64)(0xFFFFFFFFu - (u32)s);
                    }
                    keys[s] = key;
                }
                __syncthreads();
                for (int kk = 2; kk <= Npad; kk <<= 1)
                    for (int j = kk >> 1; j > 0; j >>= 1) {
                        for (int i = tid; i < Npad; i += NTHREADS) {
                            const int ixj = i ^ j;
                            if (ixj > i) { const u64 a = keys[i], c = keys[ixj]; const bool desc = (i & kk) == 0; if (desc ? (a < c) : (a > c)) { keys[i] = c; keys[ixj] = a; } }
                        }
                        __syncthreads();
                    }
                if (tid < 256) { const int ii = (int)(0xFFFFFFFFu - (u32)(keys[tid] & 0xFFFFFFFFull)); const int g = ii >> 5, ko = ii & 31, r = (ko & 3) + 4 * (ko >> 3), hh = (ko >> 2) & 1; atomicOr(&mask32[(g * 16 + r) * 2 + hh], 1u << qq); }
            }
        }
    }
    __syncthreads();
    const unsigned tv = ticket_issue(qctr);
    u64* dst = M64 + (size_t)b * 128 * 128 * 16;
    for (int i = tid; i < gend * 16; i += NTHREADS) { const int g = i >> 4, r = i & 15; dst[((size_t)g * 128 + qblk) * 16 + r] = mask[i]; }
    return ticket_collect(tv, slot);
}
}

#define GAS __attribute__((address_space(1)))
#define LAS __attribute__((address_space(3)))
typedef GAS unsigned gu32;
typedef GAS unsigned long long gu64;
#define RLX_AGENT __ATOMIC_RELAXED, __HIP_MEMORY_SCOPE_AGENT
#define XB_TMO      128
#define XB_XCNT(j)  (256  + 64 * (j))
#define XB_XSUB(j)  (1280 + 64 * (j))
#define XB_XGEN(j)  (2304 + 64 * (j))
#define XB_TOP      3328
#define XB_TOPGEN   3392
#define XCD_BAR_WORDS 3456
#define XB_SPIN_CAP (1u << 18)

__device__ __forceinline__ unsigned xb_ld(unsigned* p)              { return __hip_atomic_load(p, __ATOMIC_RELAXED, __HIP_MEMORY_SCOPE_AGENT); }
__device__ __forceinline__ unsigned xb_add(unsigned* p, unsigned v) { return __hip_atomic_fetch_add(p, v, __ATOMIC_RELAXED, __HIP_MEMORY_SCOPE_AGENT); }
__device__ __forceinline__ unsigned xb_xcc_id() { return (unsigned)__builtin_amdgcn_s_getreg((3 << 11) | 20) & 0xFu; }
#define XB_SPIN(cond, bar) do { unsigned _sp = 0; while (cond) { __builtin_amdgcn_s_sleep(1); \
    if ((++_sp & 255u) == 0u) { if (xb_ld(&(bar)[XB_TMO])) break; if (_sp > XB_SPIN_CAP) { atomicAdd(&(bar)[XB_TMO], 1u); break; } } } } while (0)

struct XcdBarrier {
    unsigned* bar; unsigned x;
    volatile LAS unsigned* st;
};

__device__ __forceinline__ XcdBarrier xcd_barrier_post(unsigned* bar, volatile LAS unsigned* st) {
    XcdBarrier b; b.bar = bar; b.x = xb_xcc_id(); b.st = st;
    if (threadIdx.x == 0) (void)xb_add(&bar[XB_XCNT(b.x)], 1u);
    return b;
}
__device__ __forceinline__ void xcd_barrier_complete(unsigned* bar, unsigned x, unsigned& nloc, unsigned& nx) {
    const unsigned G = gridDim.x * gridDim.y * gridDim.z;
    unsigned sum, cnt, mine, sp = 0u;
    for (;;) {
        sum = 0u; cnt = 0u; mine = 0u;
#pragma unroll
        for (unsigned j = 0; j < 16; ++j) { const unsigned c = xb_ld(&bar[XB_XCNT(j)]); sum += c; cnt += (c > 0u) ? 1u : 0u; mine = (j == x) ? c : mine; }
        if (sum == G) break;
        __builtin_amdgcn_s_sleep(1);
        if ((++sp & 255u) == 0u) { if (xb_ld(&bar[XB_TMO])) break; if (sp > XB_SPIN_CAP) { atomicAdd(&bar[XB_TMO], 1u); break; } }
    }
    nloc = mine > 0u ? mine : 1u; nx = cnt > 0u ? cnt : 1u;
}

__device__ __forceinline__ void xcd_barrier(const XcdBarrier& b) {
    asm volatile("s_waitcnt vmcnt(0)" ::: "memory");
    __syncthreads();
    if (threadIdx.x == 0) {
        unsigned* bar = b.bar;
        __builtin_amdgcn_s_waitcnt(0);
        unsigned nloc = b.st[0], nx = b.st[1];
        if (nloc == 0u) { xcd_barrier_complete(bar, b.x, nloc, nx); b.st[0] = nloc; b.st[1] = nx; }
        const unsigned old = xb_add(&bar[XB_XSUB(b.x)], 1u);
        const unsigned gen = old / nloc;
        if (old + 1u == (gen + 1u) * nloc) {
            __builtin_amdgcn_fence(__ATOMIC_RELEASE, "agent");
            asm volatile("s_waitcnt vmcnt(0)" ::: "memory");
            const unsigned og = xb_add(&bar[XB_TOP], 1u);
            const unsigned tg = og / nx;
            if (og + 1u == (tg + 1u) * nx) xb_add(&bar[XB_TOPGEN], 1u);
            else XB_SPIN(xb_ld(&bar[XB_TOPGEN]) == tg, bar);
            __builtin_amdgcn_fence(__ATOMIC_ACQUIRE, "agent");
            xb_add(&bar[XB_XGEN(b.x)], 1u);
            asm volatile("s_waitcnt vmcnt(0)" ::: "memory");
        } else {
            XB_SPIN(xb_ld(&bar[XB_XGEN(b.x)]) == gen, bar);
            __builtin_amdgcn_fence(__ATOMIC_ACQUIRE, "agent");
            asm volatile("s_waitcnt vmcnt(0)" ::: "memory");
        }
    }
    __syncthreads();
}


template <bool PERMUTE>
__device__ __forceinline__ void transpose_item(const float* W, int ldw, int N, bf16_t* WT, int ldt, int koff, float* scr, int item, int lane) {
    const int nblk = N / 32, kb = item / nblk, nb = item % nblk, k0 = 64 * kb, n0 = 32 * nb;
    const int nn = n0 + (lane & 31); const int sc = PERMUTE ? oldcol(nn) : nn;
    float wv_[32];
#pragma unroll
    for (int i = 0; i < 32; ++i) { const int kk = 2 * i + (lane >> 5); wv_[i] = sc >= 0 ? W[(size_t)(k0 + kk) * ldw + sc] : 0.f; }
#pragma unroll
    for (int i = 0; i < 32; ++i) { const int kk = 2 * i + (lane >> 5); scr[kk * 33 + (lane & 31)] = wv_[i]; }
    asm volatile("s_waitcnt lgkmcnt(0)" ::: "memory");
    const int c = lane & 7;
#pragma unroll
    for (int j = 0; j < 4; ++j) { const int n = (lane >> 3) + 8 * j; const float* s = scr + (8 * c) * 33 + n;
        uint4 o; o.x = (u32)f2bf(s[0 * 33]) | ((u32)f2bf(s[1 * 33]) << 16); o.y = (u32)f2bf(s[2 * 33]) | ((u32)f2bf(s[3 * 33]) << 16);
        o.z = (u32)f2bf(s[4 * 33]) | ((u32)f2bf(s[5 * 33]) << 16); o.w = (u32)f2bf(s[6 * 33]) | ((u32)f2bf(s[7 * 33]) << 16);
        *(uint4*)(WT + (size_t)(n0 + n) * ldt + koff + k0 + 8 * c) = o; }
    asm volatile("s_waitcnt lgkmcnt(0)" ::: "memory");
}
__device__ __forceinline__ void late_weights(const Params& p, unsigned char* smem, int wg, int nwg) {
    const int tidx = opaque_tid(); const int lane_ = tidx & 63, wv = tidx >> 6;
    float* scr = (float*)(smem + wv * 8704);
    constexpr int I_BR = 8 * 32, I_OUT = 16 * 32, I_ALL = 2 * I_BR + I_OUT;
    for (int it = wg * 8 + wv; it < I_ALL; it += nwg * 8) {
        int r = it;
        if (r < I_BR) { transpose_item<false>(p.w_br_mla, 1024, 1024, (bf16_t*)(p.ws + OFF_WBR), 1024, 0, scr, r, lane_); continue; } r -= I_BR;
        if (r < I_BR) { transpose_item<false>(p.w_br_dsa, 1024, 1024, (bf16_t*)(p.ws + OFF_WBR), 1024, 512, scr, r, lane_); continue; } r -= I_BR;
        transpose_item<false>(p.w_out, 1024, 1024, (bf16_t*)(p.ws + OFF_WOUT), 1024, 0, scr, r, lane_);
    }
}
__device__ __forceinline__ void ph0(const Params& p, unsigned char* smem) {
    const int tidx = opaque_tid(); const int gtid = blockIdx.x * blockDim.x + tidx, gsz = gridDim.x * blockDim.x;
    const int lane = tidx & 63, gw = gtid >> 6, nw = gsz >> 6;
    float4 va[4][4], vb[4][4];
#define PH0_LOAD(V, t_) do { _Pragma("unroll") for (int u = 0; u < 4; ++u) { const float4* xr = (const float4*)(p.x + (size_t)((t_) + u) * DM); \
        _Pragma("unroll") for (int j = 0; j < 4; ++j) V[u][j] = xr[j * 64 + lane]; } } while (0)
    const int st = nw * 4; int t = gw * 4;
    if (t < NT) PH0_LOAD(va, t);
    if (t + st < NT) PH0_LOAD(vb, t + st);
    {
        const int wv = tidx >> 6;
        float* scr = (float*)(smem + wv * 8704);
        constexpr int I_IN = 16 * 144, I_UQ = 4 * 24, I_UKV = 2 * 32;
        for (int it = gw; it < I_IN + I_UQ + I_UKV; it += nw) {
            if (it < I_IN) transpose_item<true>(p.w_in, DIN, NP, (bf16_t*)(p.ws + OFF_WIN), DM, 0, scr, it, lane);
            else if (it < I_IN + I_UQ) transpose_item<false>(p.w_uq, 768, 768, (bf16_t*)(p.ws + OFF_WUQ), 256, 0, scr, it - I_IN, lane);
            else transpose_item<false>(p.w_ukv, 1024, 1024, (bf16_t*)(p.ws + OFF_WUKV), 128, 0, scr, it - I_IN - I_UQ, lane);
        }
    }
    float* rope = (float*)(p.ws + OFF_ROPE);
    for (int i = gtid; i < NT * 28; i += gsz) {
        const int tt = i / 28, j = i % 28;
        const float ang = (float)p.pos[tt] * c_inv_freq[j];
        double s, c; sincos_d((double)ang, s, c);
        *(float2*)(rope + 2 * i) = make_float2((float)c, (float)s);
    }
    bf16_t* H = (bf16_t*)(p.ws + OFF_H);
    float4 g[4];
#pragma unroll
    for (int j = 0; j < 4; ++j) g[j] = *(const float4*)(p.norm_gain + (j * 64 + lane) * 4);
#define PH0_PROC(V, t_) do { _Pragma("unroll") for (int u = 0; u < 4; ++u) { float ss = 0.f; \
        _Pragma("unroll") for (int j = 0; j < 4; ++j) ss += V[u][j].x * V[u][j].x + V[u][j].y * V[u][j].y + V[u][j].z * V[u][j].z + V[u][j].w * V[u][j].w; \
        ss = wave_sum(ss); const float r = rsqrtf(ss * (1.f / DM) + 1e-6f); \
        _Pragma("unroll") for (int j = 0; j < 4; ++j) { \
            uint2 o; o.x = (u32)f2bf(V[u][j].x * r * g[j].x) | ((u32)f2bf(V[u][j].y * r * g[j].y) << 16); o.y = (u32)f2bf(V[u][j].z * r * g[j].z) | ((u32)f2bf(V[u][j].w * r * g[j].w) << 16); \
            *(uint2*)(H + (size_t)((t_) + u) * DM + (j * 64 + lane) * 4) = o; } } } while (0)
    for (;;) {
        if (t >= NT) break;
        PH0_PROC(va, t); if (t + 2 * st < NT) PH0_LOAD(va, t + 2 * st); t += st;
        if (t >= NT) break;
        PH0_PROC(vb, t); if (t + 2 * st < NT) PH0_LOAD(vb, t + 2 * st); t += st;
    }
#undef PH0_LOAD
#undef PH0_PROC
}
__device__ __forceinline__ void ph1(const Params& p, PG8_LAS unsigned char* lds, unsigned* ctr, unsigned* xctr, unsigned nloc) {
    pg8::Gemm g{(const bf16_t*)(p.ws + OFF_H), (const bf16_t*)(p.ws + OFF_WIN), NT, NP, DM, DM, DM}; pg8::ProjOrder S; S.init(NT, NP, gridDim.x, blockIdx.x); S.ctr = ctr; S.xctr = xctr; S.nloc = nloc;
    pg8::EpiProj E{(bf16_t*)(p.ws + OFF_PROJ), (bf16_t*)(p.ws + OFF_KI), (float*)(p.ws + OFF_WI), (const float*)(p.ws + OFF_ROPE), p.mla_q_norm, p.mla_kv_norm, p.dsa_k_gain,
                   (PG8_LAS float*)(lds + LDS_XCH), p.b_merge};
    pg8::gemm_phase<pg8::EpiProj, pg8::ProjOrder, true, true>(lds, g, S, E);
}
__device__ __forceinline__ void ph2b(const Params& p, PG8_LAS unsigned char* lds, const bool df) {
    const int bx = blockIdx.x, a = bx - 128;
    { pg8::Gemm g{(const bf16_t*)(p.ws + OFF_PROJ) + C_CQ, (const bf16_t*)(p.ws + OFF_WUQ), NT, 768, 256, NP, 256};
      pg8::ListOrder S{NT / 256, 3, df ? 0 : (int)gridDim.x, bx, a >= 0 ? a : -1, (a >= 0 && a < 64) ? 128 + a : -1};
      pg8::EpiBf16 E{(bf16_t*)((unsigned char*)p.out + OUT_QA), 768};
      pg8::gemm_phase<pg8::EpiBf16, pg8::ListOrder, true, true>(lds, g, S, E); }
    { pg8::Gemm g{(const bf16_t*)(p.ws + OFF_PROJ) + C_CKV, (const bf16_t*)(p.ws + OFF_WUKV), NT, 1024, 128, NP, 128};
      pg8::ListOrder S{NT / 256, 4, df ? 0 : (int)gridDim.x, bx, a >= 0 ? a : (bx < 64 ? 192 + bx : -1), a >= 64 ? 64 + a : -1};
      pg8::EpiKV E{(bf16_t*)((unsigned char*)p.out + OUT_KA), (bf16_t*)(p.ws + OFF_KVA), (const bf16_t*)(p.ws + OFF_PROJ), (const float*)(p.ws + OFF_ROPE), p.mla_k_gain, (PG8_LAS float*)(lds + LDS_XCH)};
      pg8::gemm_phase<pg8::EpiKV, pg8::ListOrder, true, true>(lds, g, S, E); }
}
__device__ __forceinline__ void ph3_sel(const Params& p, unsigned char* smem, volatile __attribute__((address_space(3))) unsigned* slot, const unsigned xcc, const unsigned nloc) {
    const bf16_t* proj = (const bf16_t*)(p.ws + OFF_PROJ); const bf16_t* ki = (const bf16_t*)(p.ws + OFF_KI); const float* wi = (const float*)(p.ws + OFF_WI); u64* M64 = (u64*)(p.ws + OFF_MASK);
    unsigned cnt = 0u;
    const unsigned base = gridDim.x < 512u ? gridDim.x : 512u;
    unsigned t = (gridDim.x == 256u && blockIdx.x < 128u) ? (blockIdx.x ^ 64u) : blockIdx.x;
#pragma unroll 1
    while (t < 512u) {
        const int b = t & 3, qblk = 127 - (int)(t >> 2);
        t = base + sel::sel_unit(b, qblk, proj, ki, wi, M64, smem, &g_bar[BAR_QSEL], slot); cnt += 1u << (8 * b);
    }
    asm volatile("s_waitcnt vmcnt(0)" ::: "memory");
    __syncthreads();
    if (threadIdx.x == 0) {
        const u64 mine = 1ull | ((u64)(cnt & 255u) << 16) | ((u64)((cnt >> 8) & 255u) << 28) | ((u64)((cnt >> 16) & 255u) << 40) | ((u64)((cnt >> 24) & 255u) << 52);
        const u64 old = __hip_atomic_fetch_add((u64*)__builtin_assume_aligned(&g_bar[BAR_XSEL + 16 * xcc], 8), mine, __ATOMIC_RELAXED, __HIP_MEMORY_SCOPE_AGENT);
        if ((unsigned)(old & 0xffffull) + 1u == nloc) { const u64 tot = old + mine;
            __builtin_amdgcn_fence(__ATOMIC_RELEASE, "agent"); asm volatile("s_waitcnt vmcnt(0)" ::: "memory");
#pragma unroll
            for (int b = 0; b < 4; ++b) { const unsigned c = (unsigned)((tot >> (16 + 12 * b)) & 0xfffull); if (c) __hip_atomic_fetch_add(&g_bar[BAR_SEL + 16 * b], c, __ATOMIC_RELAXED, __HIP_MEMORY_SCOPE_AGENT); } }
    }
}
__device__ __forceinline__ int attn_next(int& k, const int kmax, volatile __attribute__((address_space(3))) unsigned* slot) {
    while (k < kmax) { const int q = ((int)blockIdx.x + k) & 7; const int t = wg_ticket(&g_bar[BAR_QATT + 16 * q], 128u, slot); if (t >= 0) return q * 128 + t; ++k; }
    return -1;
}
__device__ __forceinline__ bool logit_bound_ok(const float* qg, const float* kg, const int D, const float qs) {
    const int lane = threadIdx.x & 63; float a = 0.f, c = 0.f;
    for (int i = lane; i < D; i += 64) { a = __builtin_fmaxf(a, __builtin_fabsf(qg[i])); c = __builtin_fmaxf(c, __builtin_fabsf(kg[i])); }
#pragma unroll
    for (int m_ = 32; m_ > 0; m_ >>= 1) { a = __builtin_fmaxf(a, __shfl_xor(a, m_)); c = __builtin_fmaxf(c, __shfl_xor(c, m_)); }
    const float bnd = (float)D * qs * a * c * 1.05f;
    return __builtin_amdgcn_readfirstlane((int)(bnd < 60.f)) != 0;
}
struct AttnNext {
    int k, kmax, nxt, base; unsigned tv; bool inflight; volatile __attribute__((address_space(3))) unsigned* slot; const bf16_t* qa; const bf16_t* proj;
    __device__ __forceinline__ void issue() { inflight = k < kmax; if (inflight) tv = ticket_issue(&g_bar[BAR_QATT + 16 * (((int)blockIdx.x + k) & 7)]); }
    __device__ __forceinline__ void draw(const bf16_t*& qn, int& pqn, int& nd0n) {
        nxt = -1;
        if (inflight) { const unsigned v = ticket_collect(tv, slot) + (unsigned)base;
            if (v < 128u) nxt = ((((int)blockIdx.x + k) & 7) << 7) + (int)v; else { ++k; nxt = attn_next(k, kmax, slot); } }
        qn = nullptr; pqn = 768; nd0n = 6;
        if (nxt >= 0) { const int qln = nxt >> 7, in_ = nxt & 127, qbn = 15 - ((in_ & 63) >> 2), bn = qln >> 1, hn = 4 * (qln & 1) + (in_ & 3); const size_t rn = (size_t)bn * SEQ + (size_t)qbn * 256;
            if ((in_ >> 6) == 0) { qn = qa + rn * 768 + hn * 96; pqn = 768; nd0n = 6; } else { qn = proj + rn * NP + C_QB + hn * 64; pqn = NP; nd0n = 4; } }
    }
};
template <bool TRK>
__device__ __forceinline__ void ph_attn(const Params& p, char* shm, const bool df, volatile __attribute__((address_space(3))) unsigned* slot) {
    const bf16_t* qa = (const bf16_t*)((unsigned char*)p.out + OUT_QA); const bf16_t* ka = (const bf16_t*)((unsigned char*)p.out + OUT_KA);
    const bf16_t* kva = (const bf16_t*)(p.ws + OFF_KVA); const bf16_t* proj = (const bf16_t*)(p.ws + OFF_PROJ); bf16_t* ao = (bf16_t*)(p.ws + OFF_AO); const float* rope = (const float*)(p.ws + OFF_ROPE);
    const u64* M64 = (const u64*)(p.ws + OFF_MASK);
    AttnNext nq; nq.k = 0; nq.kmax = (gridDim.x % 8 == 0 && gridDim.x <= 1024) ? 1 : 8; nq.slot = slot; nq.qa = qa; nq.proj = proj; nq.inflight = false; nq.tv = 0u;
    nq.base = nq.kmax == 1 ? (int)(gridDim.x >> 3) : 0;
    att::bf16x8 qpre[6];
    bool pre = false, p2ok = !df; unsigned selok = df ? 0u : 15u;
    int cur = nq.kmax == 1 ? (((int)blockIdx.x & 7) << 7) + ((int)blockIdx.x >> 3) : attn_next(nq.k, nq.kmax, slot);
#pragma unroll 1
    while (cur >= 0) {
        const int ql = cur >> 7, i_ = cur & 127, type = i_ >> 6, qb = 15 - ((i_ & 63) >> 2), b = ql >> 1, kvh = ql & 1, h = 4 * kvh + (i_ & 3); const size_t r0 = (size_t)b * SEQ;
        if (!p2ok) { wg_wait(&g_bar[BAR_P2B], gridDim.x); p2ok = true; }
#define ATT_MLA(T) att::attn_unit<96, 768, 768, 1024, 1024, NP, 0, T>(qb, qa + r0 * 768 + h * 96, ka + (size_t)(b * 8 + h) * (64 * 6144), kva + r0 * 1024 + h * 128 + 64, \
            ao + r0 * 1024 + h * 64, proj + r0 * NP + C_GA + h * 64, shm, nullptr, rope + r0 * 56, p.mla_q_gain, qpre, pre, nq)
#define ATT_DSA(T) att::attn_unit<64, NP, NP, NP, 1024, NP, 1, T>(qb, proj + r0 * NP + C_QB + h * 64, proj + r0 * NP + C_KB + kvh * 64, proj + r0 * NP + C_VB + kvh * 64, \
            ao + r0 * 1024 + 512 + h * 64, proj + r0 * NP + C_GB + h * 64, shm, M64 + (size_t)b * 128 * 128 * 16, rope + r0 * 56, p.dsa_q_gain, qpre, pre, nq)
        if (type == 0) {
            ATT_MLA(TRK);
        } else {
            if (!((selok >> b) & 1u)) { wg_wait(&g_bar[BAR_SEL + 16 * b], 128u); selok |= 1u << b; }
            ATT_DSA(TRK);
        }
#undef ATT_MLA
#undef ATT_DSA
        pre = nq.nxt >= 0; cur = nq.nxt;
    }
}
__device__ __forceinline__ void ph5(const Params& p, PG8_LAS unsigned char* lds) {
    const bf16_t* ao = (const bf16_t*)(p.ws + OFF_AO); const bf16_t* wbr = (const bf16_t*)(p.ws + OFF_WBR);
    pg8::Gemm g{ao, wbr, NT, DM, DM, 1024, 1024}; pg8::StaticOrder S; S.init(NT, DM, gridDim.x, blockIdx.x);
    pg8::EpiGate2 E{(bf16_t*)(p.ws + OFF_MERGED), (const bf16_t*)(p.ws + OFF_PROJ), p.b_merge};
    pg8::gemm_phase<pg8::EpiGate2, pg8::StaticOrder, true, true>(lds, g, S, E);
}
__device__ __forceinline__ void ph6(const Params& p, PG8_LAS unsigned char* lds) {
    pg8::Gemm g{(const bf16_t*)(p.ws + OFF_MERGED), (const bf16_t*)(p.ws + OFF_WOUT), NT, DM, DM, DM, DM}; pg8::StaticOrder S; S.init(NT, DM, gridDim.x, blockIdx.x);
    pg8::EpiResid E{p.out, p.x};
    pg8::gemm_phase<pg8::EpiResid, pg8::StaticOrder, true, true>(lds, g, S, E);
}

__global__ void __launch_bounds__(NTHREADS, 2) fwd_kernel(Params p) {
    extern __shared__ __attribute__((aligned(16))) unsigned char smem[];
    PG8_LAS unsigned char* lds = (PG8_LAS unsigned char*)smem;
    volatile LAS unsigned* misc = (volatile LAS unsigned*)(lds + LDS_MISC);
    if (threadIdx.x < 2) misc[threadIdx.x] = 0u;
    __syncthreads();
    const XcdBarrier bar = xcd_barrier_post(g_bar, misc);
    {
        const bool fast = logit_bound_ok(p.mla_q_gain, p.mla_k_gain, 96, 0.14724445f) && logit_bound_ok(p.dsa_q_gain, p.dsa_k_gain, 64, 0.18033688f);
        if (threadIdx.x == 0) misc[6] = fast ? 1u : 0u;
    }
    ph0(p, smem); xcd_barrier(bar);
    const bool df = gridDim.x == 256;
    if (df && blockIdx.x >= 128u) wg_signal_xcc(&g_bar[BAR_XP1 + 16 * bar.x], &g_bar[BAR_P1], misc[0]);
    ph1(p, lds, (df && blockIdx.x < 128u) ? &g_bar[BAR_P1] : nullptr, &g_bar[BAR_XP1 + 16 * bar.x], misc[0]);
    { const int lw = df ? (int)blockIdx.x - 128 : (int)blockIdx.x; if (lw >= 0) late_weights(p, smem, lw, df ? 128 : (int)gridDim.x); }
    if (df) wg_wait(&g_bar[BAR_P1], gridDim.x); else xcd_barrier(bar);
    ph2b(p, lds, df); if (df) wg_signal_xcc(&g_bar[BAR_XP2B + 16 * bar.x], &g_bar[BAR_P2B], misc[0]);
    ph3_sel(p, smem, misc + 4, bar.x, misc[0]);
    if (!df) xcd_barrier(bar);
    if (misc[6] != 0u) ph_attn<false>(p, (char*)smem, df, misc + 4);
    else ph_attn<true>(p, (char*)smem, df, misc + 4);
    xcd_barrier(bar);
    ph5(p, lds); xcd_barrier(bar);
    ph6(p, lds);
    __syncthreads();
    if (threadIdx.x == 0) { const unsigned d = __hip_atomic_fetch_add(&g_bar[BAR_DONE], 1u, __ATOMIC_RELAXED, __HIP_MEMORY_SCOPE_AGENT); misc[2] = (d + 1u == gridDim.x) ? 1u : 0u; }
    __syncthreads();
    if (misc[2] != 0u) for (int i = threadIdx.x; i < BAR_WORDS; i += NTHREADS) __hip_atomic_store(&g_bar[i], 0u, __ATOMIC_RELAXED, __HIP_MEMORY_SCOPE_AGENT);
}

extern "C" void kernel_launch(void* const* d_in, const int* in_sizes, int n_in, void* d_out, int out_size, void* d_ws, size_t ws_size, hipStream_t stream) {
    static int grid_blocks = 0;
    if (!grid_blocks) {
        int dev = 0, cus = 0, per_cu = 0;
        hipGetDevice(&dev);
        hipDeviceGetAttribute(&cus, hipDeviceAttributeMultiprocessorCount, dev);
        hipFuncSetAttribute((const void*)fwd_kernel, hipFuncAttributeMaxDynamicSharedMemorySize, LDS_BYTES);
        hipOccupancyMaxActiveBlocksPerMultiprocessor(&per_cu, (const void*)fwd_kernel, NTHREADS, LDS_BYTES);
        if (per_cu < 1) per_cu = 1;
        grid_blocks = cus * per_cu;
    }
    Params p{};
    p.x = (const float*)d_in[0]; p.pos = (const int*)d_in[1]; p.norm_gain = (const float*)d_in[2]; p.w_in = (const float*)d_in[3]; p.b_merge = (const float*)d_in[4];
    p.mla_q_norm = (const float*)d_in[5]; p.w_uq = (const float*)d_in[6]; p.mla_kv_norm = (const float*)d_in[7]; p.w_ukv = (const float*)d_in[8];
    p.mla_q_gain = (const float*)d_in[9]; p.mla_k_gain = (const float*)d_in[10]; p.dsa_q_gain = (const float*)d_in[11]; p.dsa_k_gain = (const float*)d_in[12];
    p.w_br_mla = (const float*)d_in[13]; p.w_br_dsa = (const float*)d_in[14]; p.w_out = (const float*)d_in[15];
    p.out = (float*)d_out; p.ws = (unsigned char*)d_ws;
    void* args[] = {&p};
    hipError_t e = hipLaunchCooperativeKernel((const void*)fwd_kernel, dim3(grid_blocks), dim3(NTHREADS), args, LDS_BYTES, stream);
    if (e != hipSuccess) fprintf(stderr, "cooperative launch failed: %s (grid %d)\n", hipGetErrorString(e), grid_blocks);
}
```
